# Optimizing an MI355X kernel written in HIP

```python
import math
import jax, jax.numpy as jnp
from jax import lax
import numpy as np

D_MODEL = 2048
BATCH = 1
SEQ = 16384
DEPTH = 1

N_HEADS = 8
HEAD_DIM = 128
ATTN_W = N_HEADS * HEAD_DIM
MOBA_BLOCK = 256
MOBA_TOPK = 3
Q_CHUNK = 64
POOL_WINDOWS = (2, 4, 8, 16)
POOL_GROUPS = len(POOL_WINDOWS)
POOL_W = 1024
POOL_GW = POOL_W // POOL_GROUPS
IN_W = 3 * ATTN_W + POOL_W
N_BRANCH = 2
D_FF = 5632
CONV_W = 3
ROPE_THETA = 10000.0
EPS = 1e-6
NEG = -1e30

kernel_name = "hybrid_moba_pool_convffn_block"


def rmsnorm(x, g):
    x32 = x.astype(jnp.float32)
    y = x32 * lax.rsqrt(jnp.mean(x32 * x32, axis=-1, keepdims=True) + EPS)
    return (y * g.astype(jnp.float32)).astype(x.dtype)


def modulate(h, shift, scale):
    return h * (1 + scale[:, None, :]) + shift[:, None, :]


def rope(t, pos):
    half = t.shape[-1] // 2
    inv = ROPE_THETA ** (-jnp.arange(half, dtype=jnp.float32) / half)
    ang = pos.astype(jnp.float32)[:, None] * inv[None, :]
    cos, sin = jnp.cos(ang), jnp.sin(ang)
    t32 = t.astype(jnp.float32)
    t1, t2 = t32[..., :half], t32[..., half:]
    return jnp.concatenate([t1 * cos - t2 * sin, t2 * cos + t1 * sin], axis=-1).astype(t.dtype)


def moba_attention(q, k, v):
    B, H, S, hd = q.shape
    nb = -(-S // MOBA_BLOCK)
    pad = nb * MOBA_BLOCK - S
    k_blk = jnp.pad(k, ((0, 0), (0, 0), (0, pad), (0, 0))).reshape(B, H, nb, MOBA_BLOCK, hd)
    v_blk = jnp.pad(v, ((0, 0), (0, 0), (0, pad), (0, 0))).reshape(B, H, nb, MOBA_BLOCK, hd)
    k_mean = jnp.mean(k_blk.astype(jnp.float32), axis=3)
    topk = min(MOBA_TOPK, nb)
    n_chunks = S // Q_CHUNK
    scale = hd ** -0.5
    b_idx = jnp.arange(B)[:, None, None, None]
    h_idx = jnp.arange(H)[None, :, None, None]
    blk_ids = jnp.arange(nb)

    def one_chunk(ci):
        q0 = ci * Q_CHUNK
        own = q0 // MOBA_BLOCK
        qc = lax.dynamic_slice_in_dim(q, q0, Q_CHUNK, axis=2).astype(jnp.float32) * scale
        qpos = q0 + jnp.arange(Q_CHUNK)
        gate = jnp.einsum('bhqd,bhnd->bhqn', qc, k_mean)
        gate = jnp.where(blk_ids[None, None, None, :] < own, gate, NEG)
        _, sel = lax.top_k(gate, topk)
        valid = sel < own
        k_sel = k_blk[b_idx, h_idx, sel].astype(jnp.float32)
        v_sel = v_blk[b_idx, h_idx, sel].astype(jnp.float32)
        s_sel = jnp.einsum('bhqd,bhqjkd->bhqjk', qc, k_sel)
        s_sel = jnp.where(valid[..., None], s_sel, NEG).reshape(B, H, Q_CHUNK, topk * MOBA_BLOCK)
        k_own = lax.dynamic_index_in_dim(k_blk, own, axis=2, keepdims=False).astype(jnp.float32)
        v_own = lax.dynamic_index_in_dim(v_blk, own, axis=2, keepdims=False).astype(jnp.float32)
        s_own = jnp.einsum('bhqd,bhkd->bhqk', qc, k_own)
        kpos = own * MOBA_BLOCK + jnp.arange(MOBA_BLOCK)
        s_own = jnp.where(kpos[None, :] <= qpos[:, None], s_own, NEG)
        p = jax.nn.softmax(jnp.concatenate([s_sel, s_own], axis=-1), axis=-1)
        p_sel = p[..., :topk * MOBA_BLOCK].reshape(B, H, Q_CHUNK, topk, MOBA_BLOCK)
        p_own = p[..., topk * MOBA_BLOCK:]
        o = (jnp.einsum('bhqjk,bhqjkd->bhqd', p_sel, v_sel)
             + jnp.einsum('bhqk,bhkd->bhqd', p_own, v_own))
        return o.astype(q.dtype)

    out = lax.map(one_chunk, jnp.arange(n_chunks))
    return out.transpose(1, 2, 0, 3, 4).reshape(B, H, S, hd)


def multiscale_pool(u, w_grp, ls):
    B, S, C = u.shape
    u32 = u.astype(jnp.float32)
    cs0 = jnp.concatenate([jnp.zeros((B, 1, C), jnp.float32), jnp.cumsum(u32, axis=1)], axis=1)
    t = jnp.arange(S)
    pooled = []
    for g, w in enumerate(POOL_WINDOWS):
        sl = cs0[..., g * POOL_GW:(g + 1) * POOL_GW]
        lag = jnp.concatenate([jnp.zeros((B, w - 1, POOL_GW), jnp.float32), sl[:, :S - w + 1]], axis=1)
        cnt = jnp.minimum(t + 1, w).astype(jnp.float32)[None, :, None]
        pooled.append((sl[:, 1:] - lag) / cnt)
    d = (jnp.concatenate(pooled, axis=-1) - u32).astype(u.dtype).reshape(B, S, POOL_GROUPS, POOL_GW)
    mixed = jnp.einsum('bsgc,gcd->bsgd', d, w_grp).reshape(B, S, C)
    return mixed * ls


def hybrid_mixer(h, pos, w_in, q_norm_g, k_norm_g, w_pool_grp, pool_scale,
                 w_attn_br, w_pool_br, w_gate, b_gate, w_o):
    B, S, _ = h.shape
    proj = h @ w_in
    q = proj[..., :ATTN_W]
    k = proj[..., ATTN_W:2 * ATTN_W]
    v = proj[..., 2 * ATTN_W:3 * ATTN_W]
    u = proj[..., 3 * ATTN_W:]
    to_heads = lambda t: t.reshape(B, S, N_HEADS, HEAD_DIM).transpose(0, 2, 1, 3)
    q = rope(rmsnorm(to_heads(q), q_norm_g), pos)
    k = rope(rmsnorm(to_heads(k), k_norm_g), pos)
    v = to_heads(v)
    attn = moba_attention(q, k, v).transpose(0, 2, 1, 3).reshape(B, S, ATTN_W)
    y_attn = attn @ w_attn_br
    y_pool = multiscale_pool(u, w_pool_grp, pool_scale) @ w_pool_br
    gates = jax.nn.sigmoid(h @ w_gate + b_gate)
    merged = gates[..., :D_MODEL] * y_attn + gates[..., D_MODEL:] * y_pool
    return merged @ w_o


def conv_glu_ffn(h, w_up, conv_w, conv_b, w_down):
    S = h.shape[1]
    up = h @ w_up
    up_pad = jnp.pad(up, ((0, 0), (CONV_W - 1, 0), (0, 0)))
    conv = conv_b + sum(conv_w[j] * up_pad[:, j:j + S] for j in range(CONV_W))
    a, b = conv[..., :D_FF], conv[..., D_FF:]
    return (jax.nn.silu(a) * b) @ w_down


def setup_inputs(seed: int = 0) -> dict:
    key = jax.random.key(seed)
    ks = jax.random.split(key, 20)
    nrm = lambda k, shape, s: jax.random.normal(k, shape, jnp.float32) * s
    L = DEPTH
    return {
        "x": nrm(ks[0], (BATCH, SEQ, D_MODEL), 1.0),
        "c": nrm(ks[1], (BATCH, D_MODEL), 1.0),
        "w_ada": nrm(ks[2], (L, D_MODEL, 6 * D_MODEL), 0.1 * D_MODEL ** -0.5),
        "b_ada": nrm(ks[3], (L, 6 * D_MODEL), 0.02),
        "norm_mix_g": 1.0 + nrm(ks[4], (L, D_MODEL), 0.02),
        "w_in": nrm(ks[5], (L, D_MODEL, IN_W), D_MODEL ** -0.5),
        "q_norm_g": 1.0 + nrm(ks[6], (L, HEAD_DIM), 0.02),
        "k_norm_g": 1.0 + nrm(ks[7], (L, HEAD_DIM), 0.02),
        "w_pool_grp": nrm(ks[8], (L, POOL_GROUPS, POOL_GW, POOL_GW), POOL_GW ** -0.5),
        "pool_scale": 1.0 + nrm(ks[9], (L, POOL_W), 0.02),
        "w_attn_br": nrm(ks[10], (L, ATTN_W, D_MODEL), ATTN_W ** -0.5),
        "w_pool_br": nrm(ks[11], (L, POOL_W, D_MODEL), POOL_W ** -0.5),
        "w_gate": nrm(ks[12], (L, D_MODEL, N_BRANCH * D_MODEL), D_MODEL ** -0.5),
        "b_gate": nrm(ks[13], (L, N_BRANCH * D_MODEL), 0.02),
        "w_o": nrm(ks[14], (L, D_MODEL, D_MODEL), D_MODEL ** -0.5),
        "norm_ffn_g": 1.0 + nrm(ks[15], (L, D_MODEL), 0.02),
        "w_up": nrm(ks[16], (L, D_MODEL, 2 * D_FF), D_MODEL ** -0.5),
        "conv_w": nrm(ks[17], (L, CONV_W, 2 * D_FF), CONV_W ** -0.5),
        "conv_b": nrm(ks[18], (L, 2 * D_FF), 0.02),
        "w_down": nrm(ks[19], (L, D_FF, D_MODEL), D_FF ** -0.5),
    }


def reference(x, c, w_ada, b_ada, norm_mix_g, w_in, q_norm_g, k_norm_g, w_pool_grp,
              pool_scale, w_attn_br, w_pool_br, w_gate, b_gate, w_o, norm_ffn_g,
              w_up, conv_w, conv_b, w_down):
    S = x.shape[1]
    pos = jnp.arange(S)
    for l in range(DEPTH):
        mod = jax.nn.silu(c) @ w_ada[l] + b_ada[l]
        sh1, sc1, g1, sh2, sc2, g2 = jnp.split(mod, 6, axis=-1)
        h = modulate(rmsnorm(x, norm_mix_g[l]), sh1, sc1)
        x = x + g1[:, None, :] * hybrid_mixer(
            h, pos, w_in[l], q_norm_g[l], k_norm_g[l], w_pool_grp[l], pool_scale[l],
            w_attn_br[l], w_pool_br[l], w_gate[l], b_gate[l], w_o[l])
        h = modulate(rmsnorm(x, norm_ffn_g[l]), sh2, sc2)
        x = x + g2[:, None, :] * conv_glu_ffn(h, w_up[l], conv_w[l], conv_b[l], w_down[l])
    return x
```

```cpp
#include <hip/hip_runtime.h>
#include <hip/hip_cooperative_groups.h>
#include <cstdio>
#include <cstdint>
namespace cg = cooperative_groups;

#define LAS __attribute__((address_space(3)))
#define DI __device__ __forceinline__
typedef unsigned short bf16_t;
typedef short bf16x8 __attribute__((ext_vector_type(8)));
typedef short s16x4 __attribute__((ext_vector_type(4)));
typedef float f32x2 __attribute__((ext_vector_type(2)));
typedef float f32x4 __attribute__((ext_vector_type(4)));
typedef float f32x16 __attribute__((ext_vector_type(16)));
typedef unsigned u32x2 __attribute__((ext_vector_type(2)));
typedef unsigned u32x4 __attribute__((ext_vector_type(4)));
typedef __bf16 bf16x2_t __attribute__((ext_vector_type(2)));

constexpr int S = 16384, DM = 2048, NH = 8, HD = 128, AW = 1024, PW = 1024, DFF = 5632, NUP = 2 * DFF, N1 = 8192;
constexpr float EPS = 1e-6f;
constexpr int NWAVES = 8, NTHR = 512;
constexpr int LDS_BYTES = 147456;
constexpr int XL_OFF = 131072;

constexpr size_t MiB = 1u << 20;
constexpr size_t WS_ZERO = 0, ZERO_BYTES = 1 * MiB;
constexpr size_t WS_CNT = 0, WS_KMEAN = 65536, WS_BAR = 524288;
constexpr size_t WS_MODP = 1 * MiB;
constexpr size_t WS_MODF = 2 * MiB;
constexpr size_t WS_BIASUP = 2 * MiB + 65536;
constexpr size_t WS_ROWSS = 3 * MiB;
constexpr size_t WS_LSUM = 5 * MiB;
constexpr size_t WS_LIST = 8 * MiB;
constexpr size_t WS_W1 = 40 * MiB;
constexpr size_t WS_WY = 72 * MiB;
constexpr size_t WS_WO = 80 * MiB;
constexpr size_t WS_WG = 88 * MiB;
constexpr size_t WS_WD = 90 * MiB;
constexpr size_t WS_WU = 112 * MiB;
constexpr size_t WS_HB = 156 * MiB;
constexpr size_t WS_Q = 220 * MiB, WS_K = 252 * MiB, WS_V = 284 * MiB, WS_U = 316 * MiB;
constexpr size_t WS_GATES = 348 * MiB;
constexpr size_t WS_DB = 476 * MiB;
constexpr size_t WS_AM = WS_HB;
constexpr size_t WS_MERGED = 284 * MiB;
constexpr size_t WS_XG = WS_HB;
constexpr size_t WS_ACT = 220 * MiB;
constexpr size_t WS_EDGE = 400 * MiB;
constexpr size_t WS_END = 508 * MiB;

__constant__ double ROPE_C[64] = {
1.59154943091895346e-01, 1.37822502603982849e-01, 1.19349370211248862e-01, 1.03352296618434064e-01,
8.94994016088910133e-02, 7.75032887553740585e-02, 6.71150830052272551e-02, 5.81192674418762462e-02,
5.03292121044870353e-02, 4.35833021053073297e-02, 3.77415847174197711e-02, 3.26828658723569976e-02,
2.83022014470915797e-02, 2.45087088680224316e-02, 2.12236869570126724e-02, 1.83789788427912383e-02,
1.59154943091895346e-02, 1.37822502603982859e-02, 1.19349370211248869e-02, 1.03352296618434061e-02,
8.94994016088910168e-03, 7.75032887553740620e-03, 6.71150830052272551e-03, 5.81192674418762497e-03,
5.03292121044870353e-03, 4.35833021053073314e-03, 3.77415847174197694e-03, 3.26828658723569993e-03,
2.83022014470915797e-03, 2.45087088680224316e-03, 2.12236869570126715e-03, 1.83789788427912387e-03,
1.59154943091895346e-03, 1.37822502603982855e-03, 1.19349370211248860e-03, 1.03352296618434065e-03,
8.94994016088910125e-04, 7.75032887553740577e-04, 6.71150830052272594e-04, 5.81192674418762454e-04,
5.03292121044870353e-04, 4.35833021053073336e-04, 3.77415847174197716e-04, 3.26828658723569971e-04,
2.83022014470915775e-04, 2.45087088680224327e-04, 2.12236869570126726e-04, 1.83789788427912376e-04,
1.59154943091895335e-04, 1.37822502603982850e-04, 1.19349370211248865e-04, 1.03352296618434062e-04,
8.94994016088910179e-05, 7.75032887553740523e-05, 6.71150830052272540e-05, 5.81192674418762481e-05,
5.03292121044870380e-05, 4.35833021053073309e-05, 3.77415847174197689e-05, 3.26828658723569984e-05,
2.83022014470915789e-05, 2.45087088680224307e-05, 2.12236869570126719e-05, 1.83789788427912390e-05 };

DI unsigned pk2(float lo, float hi) { f32x2 v = {lo, hi}; bf16x2_t b = __builtin_convertvector(v, bf16x2_t); return __builtin_bit_cast(unsigned, b); }
DI float bflo(unsigned w) { return __uint_as_float(w << 16); }
DI float bfhi(unsigned w) { return __uint_as_float(w & 0xffff0000u); }
DI void unpack8(const u32x4 w, float* f) { f[0] = bflo(w.x); f[1] = bfhi(w.x); f[2] = bflo(w.y); f[3] = bfhi(w.y); f[4] = bflo(w.z); f[5] = bfhi(w.z); f[6] = bflo(w.w); f[7] = bfhi(w.w); }
DI u32x4 pack8(const f32x4 a, const f32x4 b) { u32x4 w; w.x = pk2(a[0], a[1]); w.y = pk2(a[2], a[3]); w.z = pk2(b[0], b[1]); w.w = pk2(b[2], b[3]); return w; }
DI float wave_sum(float v) {
#pragma unroll
    for (int o = 1; o < 64; o <<= 1) v += __shfl_xor(v, o);
    return v;
}
DI float sigmoidf_(float x) { return __builtin_amdgcn_rcpf(1.0f + __builtin_amdgcn_exp2f(x * -1.4426950408889634f)); }
#define LDS_WAIT() asm volatile("s_waitcnt lgkmcnt(0)" ::: "memory")
#define FENCE() do { asm volatile("" ::: "memory"); __builtin_amdgcn_sched_barrier(0); } while (0)
#define TIE(var, dep) asm volatile("" : "+v"(var) : "v"(dep))
#define RAW_BAR() do { asm volatile("s_waitcnt lgkmcnt(0)" ::: "memory"); __builtin_amdgcn_s_barrier(); asm volatile("" ::: "memory"); } while (0)

#ifndef PG8_USE_SP2
#define PG8_USE_SP2 1
#endif
namespace pg8 {
constexpr int BM = 256, BK = 64, HALF = 128, HTB = HALF * BK * 2, STAGE_BYTES = 8 * HTB, NXCD = 8, WGM = 8;
__host__ __device__ __forceinline__ int lds_byte(int r, int c) { const int st = (r >> 4) * 2 + (c >> 5), rr = r & 15, cc = c & 31, ob = rr * 64 + cc * 2; return st * 1024 + (ob ^ (((ob >> 9) & 1) << 5)); }
__host__ __device__ __forceinline__ void stage_rc(int b, int& R, int& C) { const int st = b / 1024, sb = b % 1024, swz = sb ^ (((sb >> 9) & 1) << 5); R = (st >> 1) * 16 + swz / 64; C = (st & 1) * 32 + (swz % 64) / 2; }
__host__ __device__ __forceinline__ int perm32(int rho) { const int n = rho >> 4, i = rho & 15; return 8 * (i >> 2) + 4 * n + (i & 3); }

struct Unit { int pm, pn, ka, kb, aux; };
struct Gemm { const bf16_t* A; const bf16_t* Bt; int lda, ldb, K; };

template <int mode> struct Sched {
    int nM, nN, nwg, G, c;
    __device__ void init(int M, int N, int G_, int c_) { nM = M / BM; nN = N / BM; nwg = nM * nN; G = G_; c = c_; }
    __device__ bool next(int i, Unit& u) const {
        const int ii = (mode == 1) ? (i >> 1) : i;
        const long L = (long)ii * G + c; if (L >= nwg) return false;
        int wgid = (int)L; { const int q = nwg / NXCD, r = nwg % NXCD, xcd = wgid % NXCD, off = wgid / NXCD; wgid = (xcd < r ? xcd * (q + 1) : r * (q + 1) + (xcd - r) * q) + off; }
        const int nig = WGM * nN, gid = wgid / nig, fm = gid * WGM, gsz = (nM - fm) < WGM ? (nM - fm) : WGM;
        u.pm = fm + ((wgid % nig) % gsz); u.pn = (wgid % nig) / gsz;
        u.aux = (mode == 1) ? (i & 1) : 0; u.ka = (mode == 1) ? 1024 * (i & 1) : ((mode == 2) ? 256 * u.pn : 0); u.kb = (mode == 1) ? 1024 * (i & 1) : 0;
        return true;
    }
};

template <class Epi, class SchedT>
DI void gemm_phase(LAS unsigned char* lds, const Gemm g, const SchedT& S, const Epi& E) {
    int tid_ = threadIdx.x; asm volatile("" : "+v"(tid_));
    const int tid = tid_, wid = __builtin_amdgcn_readfirstlane(tid >> 6), lane = tid & 63, wr = wid >> 2, wc = wid & 3, fr = lane & 15, fq = lane >> 4;
    const int nt = g.K / BK;
    unsigned voffA, voffB;
    { int R, C; stage_rc(tid * 16, R, C); const int Rb = (R & ~31) + perm32(R & 31);
      voffA = (unsigned)(R * g.lda + C) * 2u; voffB = (unsigned)(Rb * g.ldb + C) * 2u; }
    const size_t dvoffA = (size_t)64 * g.lda * 2, dvoffB = (size_t)64 * g.ldb * 2;
    const size_t kstep = (size_t)(BK * 2);
    const size_t hstepA = (size_t)HALF * g.lda * 2, hstepB = (size_t)HALF * g.ldb * 2;
    const size_t tstepA = 2 * hstepA, tstepB = 2 * hstepB;
    const unsigned ldsw = (unsigned)wid * 1024u;
    const int aoff = lds_byte(wr * 64 + fr, fq * 8), boff = lds_byte(wc * 32 + fr, fq * 8);
#define PG8_SA(b, h) (((b) * 2 + (h)) * HTB)
#define PG8_SB(b, h) ((4 + (b) * 2 + (h)) * HTB)
#define PG8_STAGE(bufoff, gbase, voff) do { _Pragma("unroll") for (int _i = 0; _i < 2; ++_i) \
        __builtin_amdgcn_global_load_lds((const unsigned*)((const char*)(gbase) + (size_t)_i * d##voff + (voff)), (LAS unsigned*)(lds + (bufoff) + ldsw + _i * 8192), 16, 0, 0); } while (0)
#define PG8_LDA(dst, b, h) do { _Pragma("unroll") for (int m = 0; m < 4; ++m) _Pragma("unroll") for (int k = 0; k < 2; ++k) dst[m][k] = *(const LAS bf16x8*)(lds + PG8_SA(b, h) + aoff + m * 2048 + k * 1024); } while (0)
#define PG8_LDB(dst, b, h) do { _Pragma("unroll") for (int n = 0; n < 2; ++n) _Pragma("unroll") for (int k = 0; k < 2; ++k) dst[n][k] = *(const LAS bf16x8*)(lds + PG8_SB(b, h) + boff + n * 2048 + k * 1024); } while (0)
#define PG8_MMA(ai, bj, At, Bt) do { __builtin_amdgcn_s_setprio(1); _Pragma("unroll") for (int m = 0; m < 4; ++m) _Pragma("unroll") for (int n = 0; n < 2; ++n) _Pragma("unroll") for (int k = 0; k < 2; ++k) \
        acc[ai][bj][m][n] = __builtin_amdgcn_mfma_f32_16x16x32_bf16(Bt[n][k], At[m][k], acc[ai][bj][m][n], 0, 0, 0); __builtin_amdgcn_s_setprio(0); } while (0)
#define PG8_WAIT_V(n) asm volatile("s_waitcnt vmcnt(" #n ")" ::: "memory")
#define PG8_WAIT_L(n) asm volatile("s_waitcnt lgkmcnt(" #n ")" ::: "memory")
#define PG8_BAR __builtin_amdgcn_s_barrier()
#define PG8_SCHED __builtin_amdgcn_sched_barrier(0)
    Unit cur, nxt; int ui = 0;
    if (!S.next(0, cur)) return;
    f32x4 acc[2][2][4][2];
#pragma unroll
    for (int a = 0; a < 2; ++a)
#pragma unroll
        for (int b = 0; b < 2; ++b)
#pragma unroll
            for (int m = 0; m < 4; ++m)
#pragma unroll
                for (int n = 0; n < 2; ++n) acc[a][b][m][n] = (f32x4){0.f, 0.f, 0.f, 0.f};
    bf16x8 At[4][2], B0[2][2], B1[2][2];
    const char* cA = (const char*)g.A + (size_t)cur.pm * tstepA + (size_t)cur.ka * 2; const char* cB = (const char*)g.Bt + (size_t)cur.pn * tstepB + (size_t)cur.kb * 2;
#if PG8_USE_SP2
    PG8_STAGE(PG8_SB(0, 0), cB, voffB); PG8_STAGE(PG8_SB(0, 1), cB + hstepB, voffB); PG8_STAGE(PG8_SA(0, 0), cA, voffA); PG8_STAGE(PG8_SA(0, 1), cA + hstepA, voffA);
    if (wr == 1) PG8_BAR;
    PG8_WAIT_V(2); PG8_BAR;
#else
    PG8_STAGE(PG8_SB(0, 0), cB, voffB); PG8_STAGE(PG8_SA(0, 0), cA, voffA); PG8_STAGE(PG8_SB(0, 1), cB + hstepB, voffB); PG8_STAGE(PG8_SA(0, 1), cA + hstepA, voffA);
    if (wr == 1) PG8_BAR;
    PG8_WAIT_V(4); PG8_BAR;
#endif
    PG8_STAGE(PG8_SB(1, 0), cB + kstep, voffB); PG8_STAGE(PG8_SA(1, 0), cA + kstep, voffA); PG8_STAGE(PG8_SB(1, 1), cB + hstepB + kstep, voffB);
    PG8_WAIT_V(6); PG8_BAR;
    for (;;) {
        const bool has_next = S.next(ui + 1, nxt);
        const char* nA = has_next ? (const char*)g.A + (size_t)nxt.pm * tstepA + (size_t)nxt.ka * 2 : cA; const char* nB = has_next ? (const char*)g.Bt + (size_t)nxt.pn * tstepB + (size_t)nxt.kb * 2 : cB;
        for (int t = 0; t < nt; t += 2) {
            const bool last = (t == nt - 2);
            const char* a1 = cA + (size_t)(t + 1) * kstep;
            const char* a2 = last ? nA : cA + (size_t)(t + 2) * kstep; const char* b2 = last ? nB : cB + (size_t)(t + 2) * kstep;
            const char* a3 = a2 + kstep; const char* b3 = b2 + kstep;
#if PG8_USE_SP2
            PG8_LDB(B0, 0, 0); PG8_LDB(B1, 0, 1); PG8_SCHED; PG8_LDA(At, 0, 0); PG8_STAGE(PG8_SA(1, 1), a1 + hstepA, voffA);
            PG8_WAIT_V(8); PG8_WAIT_L(0); PG8_BAR; PG8_MMA(0, 0, At, B0); PG8_MMA(0, 1, At, B1); PG8_BAR; PG8_SCHED;
            PG8_LDA(At, 0, 1); PG8_STAGE(PG8_SB(0, 0), b2, voffB); PG8_STAGE(PG8_SB(0, 1), b2 + hstepB, voffB); PG8_STAGE(PG8_SA(0, 0), a2, voffA);
            PG8_WAIT_V(8); PG8_WAIT_L(0); PG8_BAR; PG8_MMA(1, 0, At, B0); PG8_MMA(1, 1, At, B1); PG8_BAR; PG8_SCHED;
            PG8_LDB(B0, 1, 0); PG8_LDB(B1, 1, 1); PG8_SCHED; PG8_LDA(At, 1, 0); PG8_STAGE(PG8_SA(0, 1), a2 + hstepA, voffA);
            PG8_WAIT_V(8); PG8_WAIT_L(0); PG8_BAR; PG8_MMA(0, 0, At, B0); PG8_MMA(0, 1, At, B1); PG8_BAR; PG8_SCHED;
            PG8_LDA(At, 1, 1); PG8_STAGE(PG8_SB(1, 0), b3, voffB); PG8_STAGE(PG8_SB(1, 1), b3 + hstepB, voffB); PG8_STAGE(PG8_SA(1, 0), a3, voffA);
            PG8_WAIT_V(8); PG8_WAIT_L(0); PG8_BAR; PG8_MMA(1, 0, At, B0); PG8_MMA(1, 1, At, B1); PG8_BAR; PG8_SCHED;
#else
            PG8_LDB(B0, 0, 0); PG8_SCHED; PG8_LDA(At, 0, 0); PG8_STAGE(PG8_SA(1, 1), a1 + hstepA, voffA);
            PG8_WAIT_L(8); PG8_BAR; PG8_WAIT_L(0); PG8_MMA(0, 0, At, B0); PG8_BAR; PG8_SCHED;
            PG8_LDB(B1, 0, 1); PG8_STAGE(PG8_SB(0, 0), b2, voffB);
            PG8_BAR; PG8_WAIT_L(0); PG8_MMA(0, 1, At, B1); PG8_BAR;
            PG8_LDA(At, 0, 1); PG8_STAGE(PG8_SA(0, 0), a2, voffA);
            PG8_BAR; PG8_WAIT_L(0); PG8_MMA(1, 0, At, B0); PG8_BAR; PG8_SCHED;
            PG8_STAGE(PG8_SB(0, 1), b2 + hstepB, voffB);
            PG8_WAIT_V(6); PG8_BAR; PG8_MMA(1, 1, At, B1); PG8_BAR;
            PG8_LDB(B0, 1, 0); PG8_SCHED; PG8_LDA(At, 1, 0); PG8_STAGE(PG8_SA(0, 1), a2 + hstepA, voffA);
            PG8_WAIT_L(8); PG8_BAR; PG8_WAIT_L(0); PG8_MMA(0, 0, At, B0); PG8_BAR; PG8_SCHED;
            PG8_LDB(B1, 1, 1); PG8_STAGE(PG8_SB(1, 0), b3, voffB);
            PG8_BAR; PG8_WAIT_L(0); PG8_MMA(0, 1, At, B1); PG8_BAR;
            PG8_LDA(At, 1, 1); PG8_STAGE(PG8_SA(1, 0), a3, voffA);
            PG8_BAR; PG8_WAIT_L(0); PG8_MMA(1, 0, At, B0); PG8_BAR; PG8_SCHED;
            PG8_STAGE(PG8_SB(1, 1), b3 + hstepB, voffB);
            PG8_WAIT_V(6); PG8_BAR; PG8_MMA(1, 1, At, B1); PG8_BAR;
#endif
        }
        if (wr == 0) PG8_BAR;
        { int l2 = threadIdx.x; asm volatile("" : "+v"(l2)); l2 &= 63;
          E(acc, cur, wr, wc, l2 & 15, l2 >> 4, lds + XL_OFF); }
        if (!has_next) break;
        if (!(Epi::CHAIN && cur.aux == 0)) {
#pragma unroll
            for (int a = 0; a < 2; ++a)
#pragma unroll
                for (int b = 0; b < 2; ++b)
#pragma unroll
                    for (int m = 0; m < 4; ++m)
#pragma unroll
                        for (int n = 0; n < 2; ++n) acc[a][b][m][n] = (f32x4){0.f, 0.f, 0.f, 0.f};
        }
        cur = nxt; cA = nA; cB = nB; ++ui;
        if (wr == 1) PG8_BAR;
    }
    PG8_WAIT_V(0);
    PG8_BAR;
}

template <class Epi, class SchedT>
DI void gemm_phase_drain(LAS unsigned char* lds, const Gemm g, const SchedT& S, const Epi& E) {
    int tid_ = threadIdx.x; asm volatile("" : "+v"(tid_));
    const int tid = tid_, wid = __builtin_amdgcn_readfirstlane(tid >> 6), lane = tid & 63, wr = wid >> 2, wc = wid & 3, fr = lane & 15, fq = lane >> 4;
    const int nt = g.K / BK;
    unsigned voffA, voffB;
    { int R, C; stage_rc(tid * 16, R, C); const int Rb = (R & ~31) + perm32(R & 31);
      voffA = (unsigned)(R * g.lda + C) * 2u; voffB = (unsigned)(Rb * g.ldb + C) * 2u; }
    const size_t dvoffA = (size_t)64 * g.lda * 2, dvoffB = (size_t)64 * g.ldb * 2;
    const size_t kstep = (size_t)(BK * 2);
    const size_t hstepA = (size_t)HALF * g.lda * 2, hstepB = (size_t)HALF * g.ldb * 2;
    const size_t tstepA = 2 * hstepA, tstepB = 2 * hstepB;
    const unsigned ldsw = (unsigned)wid * 1024u;
    const int aoff = lds_byte(wr * 64 + fr, fq * 8), boff = lds_byte(wc * 32 + fr, fq * 8);
    bool primed = false; Unit cur, nxt;
    bool have = S.next(0, cur);
    for (int ui = 0; have; ++ui) {
        f32x4 acc[2][2][4][2];
#pragma unroll
        for (int a = 0; a < 2; ++a)
#pragma unroll
            for (int b = 0; b < 2; ++b)
#pragma unroll
                for (int m = 0; m < 4; ++m)
#pragma unroll
                    for (int n = 0; n < 2; ++n) acc[a][b][m][n] = (f32x4){0.f, 0.f, 0.f, 0.f};
        bf16x8 At[4][2], B0[2][2], B1[2][2];
        const char* cA = (const char*)g.A + (size_t)cur.pm * tstepA + (size_t)cur.ka * 2; const char* cB = (const char*)g.Bt + (size_t)cur.pn * tstepB + (size_t)cur.kb * 2;
        if (!primed) {
#if PG8_USE_SP2
        PG8_STAGE(PG8_SB(0, 0), cB, voffB); PG8_STAGE(PG8_SB(0, 1), cB + hstepB, voffB); PG8_STAGE(PG8_SA(0, 0), cA, voffA); PG8_STAGE(PG8_SA(0, 1), cA + hstepA, voffA);
        if (wr == 1) PG8_BAR;
        PG8_WAIT_V(2); PG8_BAR;
#else
        PG8_STAGE(PG8_SB(0, 0), cB, voffB); PG8_STAGE(PG8_SA(0, 0), cA, voffA); PG8_STAGE(PG8_SB(0, 1), cB + hstepB, voffB); PG8_STAGE(PG8_SA(0, 1), cA + hstepA, voffA);
        if (wr == 1) PG8_BAR;
        PG8_WAIT_V(4); PG8_BAR;
#endif
        PG8_STAGE(PG8_SB(1, 0), cB + kstep, voffB); PG8_STAGE(PG8_SA(1, 0), cA + kstep, voffA); PG8_STAGE(PG8_SB(1, 1), cB + hstepB + kstep, voffB);
        PG8_WAIT_V(6); PG8_BAR;
        }
        const bool has_next = S.next(ui + 1, nxt); const bool pf = has_next && !E.uses_lds(cur);
        const char* nA = pf ? (const char*)g.A + (size_t)nxt.pm * tstepA + (size_t)nxt.ka * 2 : cA; const char* nB = pf ? (const char*)g.Bt + (size_t)nxt.pn * tstepB + (size_t)nxt.kb * 2 : cB;
        for (int t = 0; t < nt; t += 2) {
            const bool last = (t == nt - 2);
            const char* a1 = cA + (size_t)(t + 1) * kstep;
            const char* a2 = last ? nA : cA + (size_t)(t + 2) * kstep; const char* b2 = last ? nB : cB + (size_t)(t + 2) * kstep;
            const char* a3 = a2 + kstep; const char* b3 = b2 + kstep;
#if PG8_USE_SP2
            PG8_LDB(B0, 0, 0); PG8_LDB(B1, 0, 1); PG8_SCHED; PG8_LDA(At, 0, 0); PG8_STAGE(PG8_SA(1, 1), a1 + hstepA, voffA);
            PG8_WAIT_V(8); PG8_WAIT_L(0); PG8_BAR; PG8_MMA(0, 0, At, B0); PG8_MMA(0, 1, At, B1); PG8_BAR; PG8_SCHED;
            PG8_LDA(At, 0, 1); PG8_STAGE(PG8_SB(0, 0), b2, voffB); PG8_STAGE(PG8_SB(0, 1), b2 + hstepB, voffB); PG8_STAGE(PG8_SA(0, 0), a2, voffA);
            PG8_WAIT_V(8); PG8_WAIT_L(0); PG8_BAR; PG8_MMA(1, 0, At, B0); PG8_MMA(1, 1, At, B1); PG8_BAR; PG8_SCHED;
            PG8_LDB(B0, 1, 0); PG8_LDB(B1, 1, 1); PG8_SCHED; PG8_LDA(At, 1, 0); PG8_STAGE(PG8_SA(0, 1), a2 + hstepA, voffA);
            PG8_WAIT_V(8); PG8_WAIT_L(0); PG8_BAR; PG8_MMA(0, 0, At, B0); PG8_MMA(0, 1, At, B1); PG8_BAR; PG8_SCHED;
            PG8_LDA(At, 1, 1); PG8_STAGE(PG8_SB(1, 0), b3, voffB); PG8_STAGE(PG8_SB(1, 1), b3 + hstepB, voffB); PG8_STAGE(PG8_SA(1, 0), a3, voffA);
            PG8_WAIT_V(8); PG8_WAIT_L(0); PG8_BAR; PG8_MMA(1, 0, At, B0); PG8_MMA(1, 1, At, B1); PG8_BAR; PG8_SCHED;
#else
            PG8_LDB(B0, 0, 0); PG8_SCHED; PG8_LDA(At, 0, 0); PG8_STAGE(PG8_SA(1, 1), a1 + hstepA, voffA);
            PG8_WAIT_L(8); PG8_BAR; PG8_WAIT_L(0); PG8_MMA(0, 0, At, B0); PG8_BAR; PG8_SCHED;
            PG8_LDB(B1, 0, 1); PG8_STAGE(PG8_SB(0, 0), b2, voffB);
            PG8_BAR; PG8_WAIT_L(0); PG8_MMA(0, 1, At, B1); PG8_BAR;
            PG8_LDA(At, 0, 1); PG8_STAGE(PG8_SA(0, 0), a2, voffA);
            PG8_BAR; PG8_WAIT_L(0); PG8_MMA(1, 0, At, B0); PG8_BAR; PG8_SCHED;
            PG8_STAGE(PG8_SB(0, 1), b2 + hstepB, voffB);
            PG8_WAIT_V(6); PG8_BAR; PG8_MMA(1, 1, At, B1); PG8_BAR;
            PG8_LDB(B0, 1, 0); PG8_SCHED; PG8_LDA(At, 1, 0); PG8_STAGE(PG8_SA(0, 1), a2 + hstepA, voffA);
            PG8_WAIT_L(8); PG8_BAR; PG8_WAIT_L(0); PG8_MMA(0, 0, At, B0); PG8_BAR; PG8_SCHED;
            PG8_LDB(B1, 1, 1); PG8_STAGE(PG8_SB(1, 0), b3, voffB);
            PG8_BAR; PG8_WAIT_L(0); PG8_MMA(0, 1, At, B1); PG8_BAR;
            PG8_LDA(At, 1, 1); PG8_STAGE(PG8_SA(1, 0), a3, voffA);
            PG8_BAR; PG8_WAIT_L(0); PG8_MMA(1, 0, At, B0); PG8_BAR; PG8_SCHED;
            PG8_STAGE(PG8_SB(1, 1), b3 + hstepB, voffB);
            PG8_WAIT_V(6); PG8_BAR; PG8_MMA(1, 1, At, B1); PG8_BAR;
#endif
        }
        if (wr == 0) PG8_BAR;
        if (pf) {
            { int t2 = threadIdx.x; asm volatile("" : "+v"(t2)); E.drain(acc, cur, wr, wc, t2 & 15, (t2 & 63) >> 4, lds, t2); }
            if (wr == 1) PG8_BAR;
            primed = true;
        } else {
            PG8_WAIT_V(0); PG8_WAIT_L(0); PG8_BAR;
            { int t2 = threadIdx.x; asm volatile("" : "+v"(t2)); E.drain(acc, cur, wr, wc, t2 & 15, (t2 & 63) >> 4, lds, t2); }
            PG8_WAIT_L(0); PG8_BAR;
            primed = false;
        }
        have = has_next; cur = nxt;
    }
#undef PG8_SA
#undef PG8_SB
#undef PG8_STAGE
#undef PG8_LDA
#undef PG8_LDB
#undef PG8_MMA
#undef PG8_WAIT_V
#undef PG8_WAIT_L
#undef PG8_BAR
#undef PG8_SCHED
}
}
using pg8::Unit;
typedef f32x4 AccT[2][2][4][2];

constexpr int PT = 260;
struct Epi1 {
    static constexpr bool CHAIN = false;
    DI bool uses_lds(const Unit& u) const { return u.pn < 8; }
    bf16_t *q, *k, *v, *ub, *gates; float* kmean; const float *qg, *kg, *bgate;
    DI void drain(AccT& acc, const Unit& u, int wr, int wc, int fr, int fq, LAS unsigned char* lds, int tid) const {
        const int pn = u.pn; const int rowb = u.pm * 256 + wr * 64 + fr;
        bf16_t *pq = q, *pk = k, *pv = v, *pu = ub, *pg = gates; const float *pqg = qg, *pkg = kg;
        asm volatile("" : "+s"(pq), "+s"(pk), "+s"(pv), "+s"(pu), "+s"(pg), "+s"(pqg), "+s"(pkg));
        if (pn >= 16) {
            const int c0 = (pn - 16) * 128 + wc * 32 + fq * 8;
            f32x4 ba[2], bb[2];
#pragma unroll
            for (int n = 0; n < 2; ++n) { ba[n] = *(const f32x4*)(bgate + c0 + 4 * n); bb[n] = *(const f32x4*)(bgate + 2048 + c0 + 4 * n); }
#pragma unroll
            for (int ai = 0; ai < 2; ++ai)
#pragma unroll
                for (int m = 0; m < 4; ++m) { bf16_t* rowp = pg + (size_t)(rowb + ai * 128 + m * 16) * 4096 + c0;
                    f32x4 rr[2], gg[2];
#pragma unroll
                    for (int n = 0; n < 2; ++n)
#pragma unroll
                        for (int i = 0; i < 4; ++i) { const float ea = __builtin_amdgcn_exp2f((acc[ai][0][m][n][i] + ba[n][i]) * -1.4426950408889634f), eb = __builtin_amdgcn_exp2f((acc[ai][1][m][n][i] + bb[n][i]) * -1.4426950408889634f);
                            gg[n][i] = __builtin_amdgcn_rcpf(1.0f + eb); rr[n][i] = (1.0f + eb) * __builtin_amdgcn_rcpf(1.0f + ea); }
                    *(u32x4*)rowp = pack8(rr[0], rr[1]); *(u32x4*)(rowp + 2048) = pack8(gg[0], gg[1]); }
            return;
        }
        if (pn >= 8) {
            bf16_t* base; int ldc, col0; const bool sig = false;
            if (pn < 12) { base = pv; ldc = 1024; col0 = (pn - 8) * 256; } else { base = pu; ldc = 1024; col0 = (pn - 12) * 256; }
            col0 += wc * 32 + fq * 8;
            f32x4 bv[2][2];
#pragma unroll
            for (int bj = 0; bj < 2; ++bj)
#pragma unroll
                for (int n = 0; n < 2; ++n) bv[bj][n] = sig ? *(const f32x4*)(bgate + col0 + bj * 128 + 4 * n) : (f32x4){0.f, 0.f, 0.f, 0.f};
#pragma unroll
            for (int ai = 0; ai < 2; ++ai)
#pragma unroll
                for (int m = 0; m < 4; ++m) { bf16_t* rowp = base + (size_t)(rowb + ai * 128 + m * 16) * ldc + col0;
#pragma unroll
                    for (int bj = 0; bj < 2; ++bj) { f32x4 v0 = acc[ai][bj][m][0] + bv[bj][0], v1 = acc[ai][bj][m][1] + bv[bj][1];
                        if (sig) {
#pragma unroll
                            for (int i = 0; i < 4; ++i) { v0[i] = sigmoidf_(v0[i]); v1[i] = sigmoidf_(v1[i]); } }
                        *(u32x4*)(rowp + bj * 128) = pack8(v0, v1); } }
            return;
        }
        const bool isq = pn < 4; const int hp = (pn & 3) * 2;
        const float* g = isq ? pqg : pkg; bf16_t* dst = isq ? pq : pk;
        const float qs = isq ? 0.08838834764831845f * 1.4426950408889634f : 1.0f;
        LAS float* T = (LAS float*)lds;
        const int r = tid >> 2, part = tid & 3, bj2 = part >> 1, sub = part & 1;
        float ksum = 0.f;
#pragma unroll
        for (int ai = 0; ai < 2; ++ai) {
#pragma unroll
            for (int m = 0; m < 4; ++m)
#pragma unroll
                for (int bj = 0; bj < 2; ++bj)
#pragma unroll
                    for (int n = 0; n < 2; ++n) *(LAS f32x4*)(T + (64 * wr + 16 * m + fr) * PT + 128 * bj + 32 * wc + 8 * fq + 4 * n) = acc[ai][bj][m][n];
            RAW_BAR();
            LAS float* rowp = T + r * PT + 128 * bj2 + 32 * sub;
            float ss = 0.f;
#pragma unroll
            for (int j = 0; j < 8; ++j) { const f32x4 a = *(const LAS f32x4*)(rowp + 4 * j), b = *(const LAS f32x4*)(rowp + 64 + 4 * j);
                ss += (a[0] * a[0] + a[1] * a[1]) + (a[2] * a[2] + a[3] * a[3]) + (b[0] * b[0] + b[1] * b[1]) + (b[2] * b[2] + b[3] * b[3]); }
            ss += __shfl_xor(ss, 1);
            const float rr = __builtin_amdgcn_rsqf(ss * (1.0f / 128.0f) + EPS) * qs;
            const int row = u.pm * 256 + ai * 128 + r;
            bf16_t* op = dst + (size_t)row * 1024 + (hp + bj2) * 128 + 32 * sub;
#pragma unroll 1
            for (int j = 0; j < 8; j += 2) {
                f32x4 o1[2], o2[2];
#pragma unroll
                for (int jj = 0; jj < 2; ++jj) {
                    const int d = 32 * sub + 4 * (j + jj);
                    const f32x4 x1 = *(const LAS f32x4*)(rowp + 4 * (j + jj)), x2 = *(const LAS f32x4*)(rowp + 64 + 4 * (j + jj));
                    const f32x4 g0 = *(const f32x4*)(g + d), g1 = *(const f32x4*)(g + 64 + d);
                    f32x4 cs, sn;
#pragma unroll
                    for (int i = 0; i < 4; ++i) { double t = (double)row * ROPE_C[d + i]; t -= __builtin_floor(t); const float tf = (float)t; cs[i] = __builtin_amdgcn_cosf(tf); sn[i] = __builtin_amdgcn_sinf(tf); }
                    const f32x4 a = x1 * rr * g0, b = x2 * rr * g1;
                    o1[jj] = a * cs - b * sn; o2[jj] = b * cs + a * sn;
                    if (!isq) { *(LAS f32x4*)(rowp + 4 * (j + jj)) = o1[jj]; *(LAS f32x4*)(rowp + 64 + 4 * (j + jj)) = o2[jj]; }
                }
                *(u32x4*)(op + 4 * j) = pack8(o1[0], o1[1]); *(u32x4*)(op + 64 + 4 * j) = pack8(o2[0], o2[1]);
            }
            if (!isq) { RAW_BAR(); if (tid < 256) {
#pragma unroll 8
                for (int rr2 = 0; rr2 < 128; ++rr2) ksum += T[rr2 * PT + tid]; } }
            RAW_BAR();
        }
        if (!isq && tid < 256) kmean[((size_t)(hp + (tid >> 7)) * 64 + u.pm) * 128 + (tid & 127)] = ksum * (1.0f / 256.0f);
    }
};

struct Epi3 {
    static constexpr bool CHAIN = false;
    bf16_t* am; const float* ls;
    DI void drain(AccT& acc, const Unit& u, int wr, int wc, int fr, int fq, LAS unsigned char* l, int) const { (*this)(acc, u, wr, wc, fr, fq, l); }
    DI void operator()(AccT& acc, const Unit& u, int wr, int wc, int fr, int fq, LAS unsigned char*) const {
        const int col0 = u.pn * 256 + wc * 32 + fq * 8; const int rowb = u.pm * 256 + wr * 64 + fr;
        f32x4 sv[2][2];
#pragma unroll
        for (int bj = 0; bj < 2; ++bj)
#pragma unroll
            for (int n = 0; n < 2; ++n) sv[bj][n] = *(const f32x4*)(ls + col0 + bj * 128 + 4 * n);
#pragma unroll
        for (int ai = 0; ai < 2; ++ai)
#pragma unroll
            for (int m = 0; m < 4; ++m) { bf16_t* rowp = am + (size_t)(rowb + ai * 128 + m * 16) * 2048 + 1024 + col0;
#pragma unroll
                for (int bj = 0; bj < 2; ++bj) *(u32x4*)(rowp + bj * 128) = pack8(acc[ai][bj][m][0] * sv[bj][0], acc[ai][bj][m][1] * sv[bj][1]); }
    }
};

struct Epi5 {
    static constexpr bool CHAIN = true;
    const bf16_t* gates; bf16_t* merged;
    DI void operator()(AccT& acc, const Unit& u, int wr, int wc, int fr, int fq, LAS unsigned char*) const {
        const int col0 = u.pn * 256 + wc * 32 + fq * 8; const int rowb = u.pm * 256 + wr * 64 + fr;
#pragma unroll
        for (int ai = 0; ai < 2; ++ai)
#pragma unroll
            for (int m = 0; m < 4; ++m) { const size_t row = (size_t)(rowb + ai * 128 + m * 16);
#pragma unroll
                for (int bj = 0; bj < 2; ++bj) {
                    if (u.aux == 0) {
                        float gr[8]; unpack8(*(const u32x4*)(gates + row * 4096 + col0 + bj * 128), gr);
#pragma unroll
                        for (int i = 0; i < 4; ++i) { acc[ai][bj][m][0][i] *= gr[i]; acc[ai][bj][m][1][i] *= gr[4 + i]; }
                    } else {
                        float gp[8]; unpack8(*(const u32x4*)(gates + row * 4096 + 2048 + col0 + bj * 128), gp);
                        f32x4 v0, v1;
#pragma unroll
                        for (int i = 0; i < 4; ++i) { v0[i] = acc[ai][bj][m][0][i] * gp[i]; v1[i] = acc[ai][bj][m][1][i] * gp[4 + i]; }
                        *(u32x4*)(merged + row * 2048 + col0 + bj * 128) = pack8(v0, v1);
                    }
                } }
    }
};

struct Epi6 {
    static constexpr bool CHAIN = false;
    const float* x; float* out; bf16_t* xg; const float* modf; const float* nfg; float* rowss;
    DI void operator()(AccT& acc, const Unit& u, int wr, int wc, int fr, int fq, LAS unsigned char*) const {
        const int col0 = u.pn * 256 + wc * 32 + fq * 8; const int rowb = u.pm * 256 + wr * 64 + fr;
        f32x4 g1v[2][2], gmv[2][2];
#pragma unroll
        for (int bj = 0; bj < 2; ++bj)
#pragma unroll
            for (int n = 0; n < 2; ++n) { const int c = col0 + bj * 128 + 4 * n; g1v[bj][n] = *(const f32x4*)(modf + 2 * 2048 + c);
                gmv[bj][n] = *(const f32x4*)(nfg + c) * (*(const f32x4*)(modf + 4 * 2048 + c) + 1.0f); }
#pragma unroll
        for (int ai = 0; ai < 2; ++ai)
#pragma unroll
            for (int m = 0; m < 4; ++m) { const size_t row = (size_t)(rowb + ai * 128 + m * 16); float ss = 0.f;
#pragma unroll
                for (int bj = 0; bj < 2; ++bj) { const size_t off = row * 2048 + col0 + bj * 128;
                    const f32x4 x0 = *(const f32x4*)(x + off), x1 = *(const f32x4*)(x + off + 4);
                    const f32x4 y0 = x0 + g1v[bj][0] * acc[ai][bj][m][0], y1 = x1 + g1v[bj][1] * acc[ai][bj][m][1];
                    *(f32x4*)(out + off) = y0; *(f32x4*)(out + off + 4) = y1;
                    *(u32x4*)(xg + off) = pack8(y0 * gmv[bj][0], y1 * gmv[bj][1]);
                    ss += (y0[0] * y0[0] + y0[1] * y0[1]) + (y0[2] * y0[2] + y0[3] * y0[3]) + (y1[0] * y1[0] + y1[1] * y1[1]) + (y1[2] * y1[2] + y1[3] * y1[3]); }
                ss += __shfl_xor(ss, 16); ss += __shfl_xor(ss, 32);
                if (fq == 0) rowss[row * 32 + u.pn * 4 + wc] = ss; }
    }
};

struct Epi7 {
    static constexpr bool CHAIN = false;
    DI bool uses_lds(const Unit&) const { return true; }
    const LAS float* rst; int fm; const float* rowss; const float* biasup; const float* cw; const float* cb; bf16_t* act; float* edge;
    DI void drain(AccT& acc, const Unit& u, int wr, int wc, int fr, int fq, LAS unsigned char* lds, int tid) const {
        LAS float* T = (LAS float*)lds;
        const int cgi = tid & 15, rg = tid >> 4;
        const int lcb = u.pn * 128;
#pragma unroll
        for (int ai = 0; ai < 2; ++ai) {
            {
                float rs[4];
#pragma unroll
                for (int m = 0; m < 4; ++m) { const int rloc = ai * 128 + 64 * wr + 16 * m + fr;
                    if ((unsigned)(u.pm - fm) < 8u) rs[m] = rst[(u.pm - fm) * 256 + rloc];
                    else { const float* pr = rowss + (size_t)(u.pm * 256 + rloc) * 32; float sm = 0.f; for (int j = 0; j < 32; ++j) sm += pr[j]; rs[m] = __builtin_amdgcn_rsqf(sm * (1.0f / 2048.0f) + EPS); } }
#pragma unroll
                for (int bj = 0; bj < 2; ++bj)
#pragma unroll
                    for (int n = 0; n < 2; ++n) { const f32x4 bi = *(const f32x4*)(biasup + u.pn * 256 + 128 * bj + 32 * wc + 8 * fq + 4 * n);
#pragma unroll
                        for (int m = 0; m < 4; ++m) *(LAS f32x4*)(T + (2 + 64 * wr + 16 * m + fr) * PT + 128 * bj + 32 * wc + 8 * fq + 4 * n) = acc[ai][bj][m][n] * rs[m] + bi; }
            }
            RAW_BAR();
            {
                const int cg8 = (tid >> 1) & 15, h4 = tid & 1, rgi = tid >> 5;
                const int cc = 8 * cg8 + 4 * h4, lca = lcb + cc, lcbb = DFF + lcb + cc;
                const f32x4 wa0 = *(const f32x4*)(cw + lca), wa1 = *(const f32x4*)(cw + NUP + lca), wa2 = *(const f32x4*)(cw + 2 * NUP + lca), ca0 = *(const f32x4*)(cb + lca);
                const f32x4 wb0 = *(const f32x4*)(cw + lcbb), wb1 = *(const f32x4*)(cw + NUP + lcbb), wb2 = *(const f32x4*)(cw + 2 * NUP + lcbb), cb0 = *(const f32x4*)(cb + lcbb);
#pragma unroll 1
                for (int ch = 0; ch < 2; ++ch) {
                    const int r0 = 8 * rgi + 4 * ch;
                    f32x4 xa[6], xb[6];
#pragma unroll
                    for (int kx = 0; kx < 6; ++kx) { xa[kx] = *(const LAS f32x4*)(T + (r0 + kx) * PT + cc); xb[kx] = *(const LAS f32x4*)(T + (r0 + kx) * PT + 128 + cc); }
                    u32x2 pw[4];
#pragma unroll
                    for (int kx = 0; kx < 4; ++kx) { const f32x4 av = ca0 + wa0 * xa[kx] + wa1 * xa[kx + 1] + wa2 * xa[kx + 2], bv = cb0 + wb0 * xb[kx] + wb1 * xb[kx + 1] + wb2 * xb[kx + 2];
                        float rv[4];
#pragma unroll
                        for (int i = 0; i < 4; ++i) rv[i] = av[i] * sigmoidf_(av[i]) * bv[i];
                        pw[kx].x = pk2(rv[0], rv[1]); pw[kx].y = pk2(rv[2], rv[3]); }
                    const u32x2 s0 = h4 ? pw[0] : pw[2], s1 = h4 ? pw[1] : pw[3];
                    u32x2 g0, g1; g0.x = __shfl_xor(s0.x, 1); g0.y = __shfl_xor(s0.y, 1); g1.x = __shfl_xor(s1.x, 1); g1.y = __shfl_xor(s1.y, 1);
                    const u32x2 m0 = h4 ? pw[2] : pw[0], m1 = h4 ? pw[3] : pw[1];
                    const u32x4 o0 = h4 ? (u32x4){g0.x, g0.y, m0.x, m0.y} : (u32x4){m0.x, m0.y, g0.x, g0.y};
                    const u32x4 o1 = h4 ? (u32x4){g1.x, g1.y, m1.x, m1.y} : (u32x4){m1.x, m1.y, g1.x, g1.y};
                    if (!(ai == 0 && rgi == 0 && ch == 0 && h4 == 0)) {
                        const size_t row = (size_t)(u.pm * 256 + ai * 128 + r0 + 2 * h4);
                        *(u32x4*)(act + row * DFF + lcb + 8 * cg8) = o0; *(u32x4*)(act + (row + 1) * DFF + lcb + 8 * cg8) = o1; }
                }
            }
            if (tid < 128) { const int sel = tid >> 6, col4 = (tid & 63) * 4; const int lc = (col4 < 128) ? (lcb + col4) : (DFF + lcb + col4 - 128);
                const f32x4 ev = *(const LAS f32x4*)(T + ((ai == 0 ? 2 : 128) + sel) * PT + col4);
                *(f32x4*)(edge + ((size_t)(u.pm * 4 + 2 * ai + sel)) * NUP + lc) = ev; }
            RAW_BAR();
            if (ai == 0) { if (tid < 128) { const int sel = tid >> 6, col4 = (tid & 63) * 4; *(LAS f32x4*)(T + sel * PT + col4) = *(const LAS f32x4*)(T + (128 + sel) * PT + col4); }
                RAW_BAR(); }
        }
    }
};

struct Epi9 {
    static constexpr bool CHAIN = false;
    float* out; const float* modf;
    DI void operator()(AccT& acc, const Unit& u, int wr, int wc, int fr, int fq, LAS unsigned char*) const {
        const int col0 = u.pn * 256 + wc * 32 + fq * 8; const int rowb = u.pm * 256 + wr * 64 + fr;
        f32x4 g2v[2][2];
#pragma unroll
        for (int bj = 0; bj < 2; ++bj)
#pragma unroll
            for (int n = 0; n < 2; ++n) g2v[bj][n] = *(const f32x4*)(modf + 5 * 2048 + col0 + bj * 128 + 4 * n);
#pragma unroll
        for (int ai = 0; ai < 2; ++ai)
#pragma unroll
            for (int m = 0; m < 4; ++m) { const size_t row = (size_t)(rowb + ai * 128 + m * 16);
#pragma unroll
                for (int bj = 0; bj < 2; ++bj) { const size_t off = row * 2048 + col0 + bj * 128;
                    const f32x4 x0 = *(const f32x4*)(out + off), x1 = *(const f32x4*)(out + off + 4);
                    *(f32x4*)(out + off) = x0 + g2v[bj][0] * acc[ai][bj][m][0]; *(f32x4*)(out + off + 4) = x1 + g2v[bj][1] * acc[ai][bj][m][1]; } }
    }
};

DI int dest_row(int mode, int n) {
    if (mode == 1) { if (n >= 2048) return n; const int d = n & 127; return (n & ~127) + 32 * ((d >> 4) & 3) + 8 * ((d >> 2) & 3) + 4 * (d >> 6) + (d & 3); }
    if (mode == 2) { const int bj = n >= DFF ? 1 : 0, cc = n - bj * DFF; return 256 * (cc >> 7) + 128 * bj + (cc & 127); }
    if (mode == 3) { const int bj = n >= 2048 ? 1 : 0, cc = n - bj * 2048; return 256 * (cc >> 7) + 128 * bj + (cc & 127); }
    return n;
}
DI void transpose_item(const float* W, int N, bf16_t* WT, int ldd, int koff, int row_off, int mode, LAS float* scr, int item, int lane) {
    const int nblk = N / 64, kb = item / nblk, nb = item % nblk, k0 = 64 * kb, n0 = 64 * nb;
    const int kr = lane >> 4, n4 = (lane & 15) * 4;
    f32x4 v[16];
#pragma unroll
    for (int i = 0; i < 16; ++i) v[i] = __builtin_nontemporal_load((const f32x4*)(W + (size_t)(k0 + 4 * i + kr) * N + n0 + n4));
#pragma unroll
    for (int i = 0; i < 16; ++i) { LAS float* d = scr + (4 * i + kr) * 65 + n4; d[0] = v[i][0]; d[1] = v[i][1]; d[2] = v[i][2]; d[3] = v[i][3]; }
    LDS_WAIT(); asm volatile("" ::: "memory");
    const int c = lane & 7;
#pragma unroll
    for (int j = 0; j < 8; ++j) { const int n = (lane >> 3) + 8 * j; const LAS float* sp = scr + (8 * c) * 65 + n;
        u32x4 o; o.x = pk2(sp[0 * 65], sp[1 * 65]); o.y = pk2(sp[2 * 65], sp[3 * 65]); o.z = pk2(sp[4 * 65], sp[5 * 65]); o.w = pk2(sp[6 * 65], sp[7 * 65]);
        *(u32x4*)(WT + (size_t)(row_off + dest_row(mode, n0 + n)) * ldd + koff + k0 + 8 * c) = o; }
    LDS_WAIT(); asm volatile("" ::: "memory");
}

DI s16x4 vtr(const LAS unsigned char* p) { typedef short v4i16_t __attribute__((ext_vector_type(4))); return __builtin_bit_cast(s16x4, __builtin_amdgcn_ds_read_tr16_b64_v4i16((LAS v4i16_t*)p)); }
constexpr int KV_PITCH = 272;
constexpr int LDS_KS = 0, LDS_VS = 256 * KV_PITCH, LDS_TAB = 2 * 256 * KV_PITCH;


#define XB_TMO      128
#define XB_XCNT(j)  (256  + 64 * (j))
#define XB_XSUB(j)  (1280 + 64 * (j))
#define XB_XGEN(j)  (2304 + 64 * (j))
#define XB_TOP      3328
#define XB_TOPGEN   3392
#define XCD_BAR_WORDS 3456
#define XB_SPIN_CAP (1u << 18)
DI unsigned xb_ld(unsigned* p)              { return __hip_atomic_load(p, __ATOMIC_RELAXED, __HIP_MEMORY_SCOPE_AGENT); }
DI unsigned xb_add(unsigned* p, unsigned v) { return __hip_atomic_fetch_add(p, v, __ATOMIC_RELAXED, __HIP_MEMORY_SCOPE_AGENT); }
DI unsigned xb_xcc_id() { return (unsigned)__builtin_amdgcn_s_getreg((3 << 11) | 20) & 0xFu; }
#define XB_SPIN(cond, bar) do { unsigned _sp = 0; while (cond) { __builtin_amdgcn_s_sleep(1); \
    if ((++_sp & 255u) == 0u) { if (xb_ld(&(bar)[XB_TMO])) break; if (_sp > XB_SPIN_CAP) { atomicAdd(&(bar)[XB_TMO], 1u); break; } } } } while (0)
struct XcdBarrier { unsigned* bar; unsigned x; volatile LAS unsigned* st; };
DI XcdBarrier xcd_barrier_post(unsigned* bar, volatile LAS unsigned* st) {
    XcdBarrier b; b.bar = bar; b.x = xb_xcc_id(); b.st = st;
    if (threadIdx.x == 0) (void)xb_add(&bar[XB_XCNT(b.x)], 1u);
    return b;
}
DI void xcd_barrier_complete(unsigned* bar, unsigned x, unsigned& nloc, unsigned& nx) {
    const unsigned G = gridDim.x * gridDim.y * gridDim.z;
    unsigned sum, cnt, mine, sp = 0u;
    for (;;) {
        sum = 0u; cnt = 0u; mine = 0u;
#pragma unroll
        for (unsigned j = 0; j < 16; ++j) { const unsigned c = xb_ld(&bar[XB_XCNT(j)]); sum += c; cnt += (c > 0u) ? 1u : 0u; mine = (j == x) ? c : mine; }
        if (sum == G) break;
        __builtin_amdgcn_s_sleep(1);
        if ((++sp & 255u) == 0u) { if (xb_ld(&bar[XB_TMO])) break; if (sp > XB_SPIN_CAP) { atomicAdd(&bar[XB_TMO], 1u); break; } }
    }
    nloc = mine > 0u ? mine : 1u; nx = cnt > 0u ? cnt : 1u;
}
DI void xcd_barrier(const XcdBarrier& b) {
    asm volatile("s_waitcnt vmcnt(0)" ::: "memory");
    __syncthreads();
    if (threadIdx.x == 0) {
        unsigned* bar = b.bar;
        __builtin_amdgcn_s_waitcnt(0);
        unsigned nloc = b.st[0], nx = b.st[1];
        if (nloc == 0u) { xcd_barrier_complete(bar, b.x, nloc, nx); b.st[0] = nloc; b.st[1] = nx; }
        const unsigned old = xb_add(&bar[XB_XSUB(b.x)], 1u);
        const unsigned gen = old / nloc;
        if (old + 1u == (gen + 1u) * nloc) {
            __builtin_amdgcn_fence(__ATOMIC_RELEASE, "agent");
            asm volatile("s_waitcnt vmcnt(0)" ::: "memory");
            const unsigned og = xb_add(&bar[XB_TOP], 1u);
            const unsigned tg = og / nx;
            if (og + 1u == (tg + 1u) * nx) xb_add(&bar[XB_TOPGEN], 1u);
            else XB_SPIN(xb_ld(&bar[XB_TOPGEN]) == tg, bar);
            __builtin_amdgcn_fence(__ATOMIC_ACQUIRE, "agent");
            xb_add(&bar[XB_XGEN(b.x)], 1u);
            asm volatile("s_waitcnt vmcnt(0)" ::: "memory");
        } else {
            XB_SPIN(xb_ld(&bar[XB_XGEN(b.x)]) == gen, bar);
            __builtin_amdgcn_fence(__ATOMIC_ACQUIRE, "agent");
            asm volatile("s_waitcnt vmcnt(0)" ::: "memory");
        }
    }
    __syncthreads();
}

#ifndef PHMASK
#define PHMASK 0xFFFF
#endif
struct Params {
    const float* in[20]; float* out; unsigned char* ws;
};

__global__ void __launch_bounds__(NTHR, 2) fwd_megakernel(Params p) {
    extern __shared__ __attribute__((aligned(16))) unsigned char lds_raw[];
    LAS unsigned char* lds = (LAS unsigned char*)lds_raw;
    cg::grid_group grid = cg::this_grid();
    int tid = threadIdx.x, lane = tid & 63; const int wave = __builtin_amdgcn_readfirstlane(tid >> 6);
#define RELOAD_IDS() do { tid = threadIdx.x; asm volatile("" : "+v"(tid)); lane = tid & 63; } while (0)
    const int G = gridDim.x, bx = blockIdx.x;
    const int vcu = (G % 8 == 0) ? (bx % 8) * (G / 8) + bx / 8 : bx;
    const int gw = vcu * NWAVES + wave, NGW = G * NWAVES;
    unsigned char* ws = p.ws;
    volatile LAS unsigned* xst = (volatile LAS unsigned*)(lds + LDS_BYTES - 16);
    if (threadIdx.x < 4) xst[threadIdx.x] = 0u;
    __syncthreads();
    XcdBarrier xbar; xbar.bar = (unsigned*)(ws + WS_BAR); xbar.x = 0; xbar.st = xst;
    if (blockIdx.x == 0) {
        for (int i = threadIdx.x; i < 512; i += NTHR) ((unsigned*)(ws + WS_CNT))[i] = 0u;
        for (int i = threadIdx.x; i < XCD_BAR_WORDS; i += NTHR) ((unsigned*)(ws + WS_BAR))[i] = 0u;
    }
#define xin (p.in[0])
#define cvec (p.in[1])
#define w_ada (p.in[2])
#define b_ada (p.in[3])
#define nmg (p.in[4])
#define w_in (p.in[5])
#define qng (p.in[6])
#define kng (p.in[7])
#define w_pgrp (p.in[8])
#define pscale (p.in[9])
#define w_abr (p.in[10])
#define w_pbr (p.in[11])
#define w_gate (p.in[12])
#define b_gate (p.in[13])
#define w_o (p.in[14])
#define nfg (p.in[15])
#define w_up (p.in[16])
#define conv_w (p.in[17])
#define conv_b (p.in[18])
#define w_down (p.in[19])
#define outp (p.out)
#define cnt ((unsigned*)(ws + WS_CNT))
#define kmean ((float*)(ws + WS_KMEAN))
#define modp ((float*)(ws + WS_MODP))
#define modf ((float*)(ws + WS_MODF))
#define biasup ((float*)(ws + WS_BIASUP))
#define rowss ((float*)(ws + WS_ROWSS))
#define lsum ((float*)(ws + WS_LSUM))
#define qlist ((unsigned*)(ws + WS_LIST))
#define W1t ((bf16_t*)(ws + WS_W1))
#define Wyt ((bf16_t*)(ws + WS_WY))
#define Wot ((bf16_t*)(ws + WS_WO))
#define Wgt ((bf16_t*)(ws + WS_WG))
#define Wdt ((bf16_t*)(ws + WS_WD))
#define Wut ((bf16_t*)(ws + WS_WU))
#define hbuf ((bf16_t*)(ws + WS_HB))
#define qb ((bf16_t*)(ws + WS_Q))
#define kb ((bf16_t*)(ws + WS_K))
#define vb ((bf16_t*)(ws + WS_V))
#define ub ((bf16_t*)(ws + WS_U))
#define gates ((bf16_t*)(ws + WS_GATES))
#define dbuf ((bf16_t*)(ws + WS_DB))
#define am ((bf16_t*)(ws + WS_AM))
#define merged ((bf16_t*)(ws + WS_MERGED))
#define xg ((bf16_t*)(ws + WS_XG))
#define act ((bf16_t*)(ws + WS_ACT))
#define edge ((float*)(ws + WS_EDGE))
#define slots ((bf16_t*)p.out)
#define rsb ((float*)(ws + WS_LSUM))
#if PHMASK & 1
    {
        LAS float* scr = (LAS float*)(lds + wave * 16640);
        constexpr int I_IN = 32 * 64, I_GT = 32 * 64, I_AB = 16 * 32, I_PB = 16 * 32, I_O = 32 * 32, I_UP = 32 * 176, I_DN = 88 * 32, I_G = 4 * 4;
        constexpr int NIT = I_IN + I_GT + I_AB + I_PB + I_O + I_UP + I_DN + 4 * I_G;
        for (int it = gw; it < NIT; it += NGW) {
            int r = it;
            if (r < I_UP) { transpose_item(w_up, NUP, Wut, 2048, 0, 0, 2, scr, r, lane); continue; } r -= I_UP;
            if (r < I_DN) { transpose_item(w_down, 2048, Wdt, DFF, 0, 0, 0, scr, r, lane); continue; } r -= I_DN;
            if (r < I_IN) { transpose_item(w_in, 4096, W1t, 2048, 0, 0, 0, scr, r, lane); continue; } r -= I_IN;
            if (r < I_GT) { transpose_item(w_gate, 4096, W1t, 2048, 0, 4096, 3, scr, r, lane); continue; } r -= I_GT;
            if (r < I_AB) { transpose_item(w_abr, 2048, Wyt, 2048, 0, 0, 0, scr, r, lane); continue; } r -= I_AB;
            if (r < I_PB) { transpose_item(w_pbr, 2048, Wyt, 2048, 1024, 0, 0, scr, r, lane); continue; } r -= I_PB;
            if (r < I_O) { transpose_item(w_o, 2048, Wot, 2048, 0, 0, 0, scr, r, lane); continue; } r -= I_O;
            { const int gI = r / I_G; transpose_item(w_pgrp + (size_t)gI * 65536, 256, Wgt, 1024, 0, gI * 256, 0, scr, r % I_G, lane); }
        }
        for (int it = gw; it < 768; it += NGW) {
            const int kc = it / 48, cgi = it % 48; const int col = cgi * 256 + lane * 4;
            f32x4 a = (f32x4){0.f, 0.f, 0.f, 0.f};
#pragma unroll 8
            for (int kk = 0; kk < 128; ++kk) { const int kx = kc * 128 + kk; const float cv = cvec[kx]; const float sv = cv * sigmoidf_(cv);
                a += __builtin_nontemporal_load((const f32x4*)(w_ada + (size_t)kx * 12288 + col)) * sv; }
            *(f32x4*)(modp + (size_t)kc * 12288 + col) = a;
        }
    }
    grid.sync();
    xbar = xcd_barrier_post((unsigned*)(ws + WS_BAR), xst);
    RELOAD_IDS();

#endif
#if PHMASK & 2
    {
        LAS float* sh1 = (LAS float*)lds; LAS float* gm1 = sh1 + 2048;
        for (int e = tid; e < 4096; e += NTHR) { float s = b_ada[e];
#pragma unroll
            for (int kc = 0; kc < 16; ++kc) s += modp[(size_t)kc * 12288 + e];
            if (e < 2048) sh1[e] = s; else gm1[e - 2048] = nmg[e - 2048] * (1.0f + s); }
        if (tid < 48) { const int e = bx * 48 + tid; if (e < 12288 && bx < 256) { float s = b_ada[e];
#pragma unroll
            for (int kc = 0; kc < 16; ++kc) s += modp[(size_t)kc * 12288 + e];
            modf[e] = s; } }
        if (G < 256 && bx == 0) { for (int e = G * 48 + tid; e < 12288; e += NTHR) { float s = b_ada[e]; for (int kc = 0; kc < 16; ++kc) s += modp[(size_t)kc * 12288 + e]; modf[e] = s; } }
        __syncthreads();
        for (int m = gw; m < S; m += NGW) {
            const f32x4* xr = (const f32x4*)(xin + (size_t)m * DM) + lane;
            f32x4 v[8]; float ss = 0.f;
#pragma unroll
            for (int j = 0; j < 8; ++j) { v[j] = xr[64 * j]; ss += (v[j][0] * v[j][0] + v[j][1] * v[j][1]) + (v[j][2] * v[j][2] + v[j][3] * v[j][3]); }
            const float r = __builtin_amdgcn_rsqf(wave_sum(ss) * (1.0f / DM) + EPS);
            u32x2* o8 = (u32x2*)(hbuf + (size_t)m * DM) + lane;
#pragma unroll
            for (int j = 0; j < 8; ++j) { const int c = 4 * lane + 256 * j; const f32x4 gmv = *(const LAS f32x4*)(gm1 + c), shv = *(const LAS f32x4*)(sh1 + c);
                const f32x4 hval = v[j] * r * gmv + shv; u32x2 w; w.x = pk2(hval[0], hval[1]); w.y = pk2(hval[2], hval[3]); o8[64 * j] = w; }
        }
    }
    xcd_barrier(xbar);
    RELOAD_IDS();

#endif
#if PHMASK & 4
    {
        pg8::Gemm g{hbuf, W1t, 2048, 2048, 2048}; pg8::Sched<0> Sc; Sc.init(S, N1, G, bx);
        Epi1 E{qb, kb, vb, ub, gates, kmean, qng, kng, b_gate};
        pg8::gemm_phase_drain<Epi1>(lds, g, Sc, E);
    }
    xcd_barrier(xbar);
    RELOAD_IDS();

#endif
#if PHMASK & 8
    {
        LAS unsigned char* kmb = lds;
        LAS unsigned* hist = (LAS unsigned*)(lds + 32768); LAS unsigned* basep = hist + 64;
        for (int base = bx * 8; base < 2048; base += G * 8) {
            const int h = base >> 8;
            __syncthreads();
            { const int jr = tid >> 3, c0 = (tid & 7) * 16; const f32x4* src = (const f32x4*)(kmean + (size_t)h * 8192 + jr * 128 + c0);
              const f32x4 k0 = src[0], k1 = src[1], k2 = src[2], k3 = src[3];
              *(LAS u32x4*)(kmb + jr * KV_PITCH + c0 * 2) = pack8(k0, k1); *(LAS u32x4*)(kmb + jr * KV_PITCH + c0 * 2 + 16) = pack8(k2, k3); }
            if (tid < 64) hist[tid] = 0u;
            __syncthreads();
            const int item = base + wave, qgi = item & 255, own = qgi >> 2, ns = own < 3 ? own : 3;
            const int r32 = lane & 31, hh = lane >> 5;
            int selj[2][3]; unsigned selp[2][3];
#pragma unroll
            for (int sub = 0; sub < 2; ++sub) {
                const int qi = qgi * 64 + sub * 32 + r32;
                const bf16_t* qp = qb + (size_t)qi * 1024 + h * 128 + 8 * hh;
                f32x16 ac[2];
#pragma unroll
                for (int jt = 0; jt < 2; ++jt)
#pragma unroll
                    for (int i = 0; i < 16; ++i) ac[jt][i] = 0.f;
#pragma unroll
                for (int ks = 0; ks < 8; ++ks) { const bf16x8 qf = *(const bf16x8*)(qp + 16 * ks);
#pragma unroll
                    for (int jt = 0; jt < 2; ++jt) { const bf16x8 kf = *(const LAS bf16x8*)(kmb + (32 * jt + r32) * KV_PITCH + 32 * ks + 16 * hh);
                        ac[jt] = __builtin_amdgcn_mfma_f32_32x32x16_bf16(kf, qf, ac[jt], 0, 0, 0); } }
                float b0 = -3.0e38f, b1 = -3.0e38f, b2 = -3.0e38f; int i0 = 255, i1 = 255, i2 = 255;
#pragma unroll
                for (int jt = 0; jt < 2; ++jt)
#pragma unroll
                    for (int i = 0; i < 16; ++i) { const int j = 32 * jt + (i & 3) + 8 * (i >> 2) + 4 * hh; const float vj = (j < own) ? ac[jt][i] : -3.0e38f;
                        if (vj > b0) { b2 = b1; i2 = i1; b1 = b0; i1 = i0; b0 = vj; i0 = j; }
                        else if (vj > b1) { b2 = b1; i2 = i1; b1 = vj; i1 = j; }
                        else if (vj > b2) { b2 = vj; i2 = j; } }
                const float p0 = __shfl_xor(b0, 32), p1 = __shfl_xor(b1, 32), p2 = __shfl_xor(b2, 32);
                const int q0 = __shfl_xor(i0, 32), q1 = __shfl_xor(i1, 32), q2 = __shfl_xor(i2, 32);
#pragma unroll
                for (int t = 0; t < 3; ++t) { const float vj = t == 0 ? p0 : (t == 1 ? p1 : p2); const int j = t == 0 ? q0 : (t == 1 ? q1 : q2);
                    if (vj > b0 || (vj == b0 && j < i0)) { b2 = b1; i2 = i1; b1 = b0; i1 = i0; b0 = vj; i0 = j; }
                    else if (vj > b1 || (vj == b1 && j < i1)) { b2 = b1; i2 = i1; b1 = vj; i1 = j; }
                    else if (vj > b2 || (vj == b2 && j < i2)) { b2 = vj; i2 = j; } }
                selj[sub][0] = i0; selj[sub][1] = i1; selj[sub][2] = i2;
#pragma unroll
                for (int t = 0; t < 3; ++t) selp[sub][t] = (hh == 0 && t < ns) ? __hip_atomic_fetch_add((unsigned*)(hist + selj[sub][t]), 1u, __ATOMIC_RELAXED, __HIP_MEMORY_SCOPE_WORKGROUP) : 0u;
            }
            __syncthreads();
            if (tid < 64) { const unsigned c = hist[tid]; basep[tid] = c ? atomicAdd(cnt + h * 64 + tid, c) : 0u; }
            __syncthreads();
            if (hh == 0) {
#pragma unroll
                for (int sub = 0; sub < 2; ++sub)
#pragma unroll
                    for (int t = 0; t < 3; ++t) if (t < ns) { const int j = selj[sub][t]; const unsigned qi = (unsigned)(qgi * 64 + sub * 32 + r32);
                        qlist[(size_t)(h * 64 + j) * 16384 + basep[j] + selp[sub][t]] = qi * 4u + (unsigned)t; }
            }
        }
        for (int idx = vcu * NTHR + tid; idx < 2048 * 128; idx += G * NTHR) {
            const int cgi = idx & 127, rc = idx >> 7, w = 2 << (cgi >> 5), t0 = rc * 8;
            const bf16_t* up = ub + cgi * 8;
            float sum[8];
#pragma unroll
            for (int i = 0; i < 8; ++i) sum[i] = 0.f;
            for (int i = 1; i <= w; ++i) { const int t = t0 - i; if (t >= 0) { float f[8]; unpack8(*(const u32x4*)(up + (size_t)t * 1024), f);
#pragma unroll
                for (int e = 0; e < 8; ++e) sum[e] += f[e]; } }
#pragma unroll
            for (int t = t0; t < t0 + 8; ++t) {
                float f[8]; unpack8(*(const u32x4*)(up + (size_t)t * 1024), f);
#pragma unroll
                for (int e = 0; e < 8; ++e) sum[e] += f[e];
                if (t - w >= 0) { float o[8]; unpack8(*(const u32x4*)(up + (size_t)(t - w) * 1024), o);
#pragma unroll
                    for (int e = 0; e < 8; ++e) sum[e] -= o[e]; }
                const float inv = 1.0f / (float)((t + 1) < w ? (t + 1) : w);
                u32x4 o4; o4.x = pk2(sum[0] * inv - f[0], sum[1] * inv - f[1]); o4.y = pk2(sum[2] * inv - f[2], sum[3] * inv - f[3]);
                o4.z = pk2(sum[4] * inv - f[4], sum[5] * inv - f[5]); o4.w = pk2(sum[6] * inv - f[6], sum[7] * inv - f[7]);
                *(u32x4*)(dbuf + (size_t)t * 1024 + cgi * 8) = o4;
            }
        }
        for (int rho = gw; rho < NUP; rho += NGW) {
            float s = 0.f;
#pragma unroll
            for (int j = 0; j < 4; ++j) { const int k0 = j * 512 + lane * 8; float f[8]; unpack8(*(const u32x4*)(Wut + (size_t)rho * 2048 + k0), f);
                const f32x4 s0 = *(const f32x4*)(modf + 3 * 2048 + k0), s1 = *(const f32x4*)(modf + 3 * 2048 + k0 + 4);
                s += (f[0] * s0[0] + f[1] * s0[1]) + (f[2] * s0[2] + f[3] * s0[3]) + (f[4] * s1[0] + f[5] * s1[1]) + (f[6] * s1[2] + f[7] * s1[3]); }
            s = wave_sum(s);
            if (lane == 0) biasup[rho] = s;
        }
    }
    xcd_barrier(xbar);
    RELOAD_IDS();

#endif
#if PHMASK & 16
    {
        RELOAD_IDS();
        __syncthreads();
        LAS int* pre = (LAS int*)(lds + LDS_TAB); LAS int* tmp = pre + 520;
        { const int n = 1 + (int)((cnt[tid] + 255u) >> 8); tmp[tid] = n; __syncthreads();
          for (int o = 1; o < 512; o <<= 1) { const int v = tmp[tid] + (tid >= o ? tmp[tid - o] : 0); __syncthreads(); tmp[tid] = v; __syncthreads(); }
          pre[tid + 1] = tmp[tid]; if (tid == 0) pre[0] = 0; __syncthreads(); }
        const int total = pre[512];
        int lane_ = lane; asm volatile("" : "+v"(lane_));
        const int r32 = lane_ & 31, hh = lane_ >> 5, i16 = lane_ & 15, qq = i16 >> 2, pp = i16 & 3, blk = (lane_ >> 4) & 1;
#define ATT_DECODE(UN, HJ, LI) do { int lo_ = 0, hi_ = 511; while (lo_ < hi_) { const int mid_ = (lo_ + hi_ + 1) >> 1; if (pre[mid_] <= (UN)) lo_ = mid_; else hi_ = mid_ - 1; } HJ = lo_; LI = (UN) - pre[lo_]; } while (0)
#define ATT_KVLOAD(HJ) do { const int h_ = (HJ) >> 6, j_ = (HJ) & 63; const bf16_t* kg = kb + (size_t)(j_ * 256) * 1024 + h_ * 128; const bf16_t* vg = vb + (size_t)(j_ * 256) * 1024 + h_ * 128; \
        _Pragma("unroll") for (int i = 0; i < 8; ++i) { const int idx = tid + NTHR * i, row = idx >> 4, c16 = idx & 15; \
            kreg[i] = *(const u32x4*)(kg + (size_t)row * 1024 + c16 * 8); vreg[i] = *(const u32x4*)(vg + (size_t)row * 1024 + c16 * 8); } } while (0)
#define ATT_ENT(HJ, LI, ENT, NL) do { NL = ((LI) == 0) ? 256 : (int)cnt[HJ] - ((LI) - 1) * 256; const int e_ = wave * 32 + r32; \
        if ((LI) == 0) ENT = (unsigned)(((HJ) & 63) * 256 + e_) * 4u + 3u; else ENT = qlist[(size_t)(HJ) * 16384 + (size_t)((LI) - 1) * 256 + (e_ < NL ? e_ : 0)]; } while (0)
        u32x4 kreg[8], vreg[8];
        int hj = 0, li = 0, nlist = 0; unsigned ent = 0u;
        if (bx < total) { ATT_DECODE(bx, hj, li); ATT_KVLOAD(hj); ATT_ENT(hj, li, ent, nlist); }
        for (int un = bx; un < total; un += G) {
            const int h = hj >> 6, j = hj & 63;
            const bool ownu = (li == 0);
            const int e = wave * 32 + r32;
            const bool valid = e < nlist;
            const int qi = (int)(ent >> 2), slot = (int)(ent & 3u);
            const bf16_t* qp = qb + (size_t)qi * 1024 + h * 128 + 8 * hh;
            bf16x8 qf[8];
#pragma unroll
            for (int ks = 0; ks < 8; ++ks) qf[ks] = *(const bf16x8*)(qp + 16 * ks);
            __syncthreads();
#pragma unroll
            for (int i = 0; i < 8; ++i) { const int idx = tid + NTHR * i, row = idx >> 4, c16 = idx & 15;
                *(LAS u32x4*)(lds + LDS_KS + row * KV_PITCH + c16 * 16) = kreg[i]; *(LAS u32x4*)(lds + LDS_VS + row * KV_PITCH + c16 * 16) = vreg[i]; }
            __syncthreads();
            int hj2, li2, nlist2; unsigned ent2;
            { const int unn = (un + G < total) ? un + G : un; ATT_DECODE(unn, hj2, li2); ATT_KVLOAD(hj2); ATT_ENT(hj2, li2, ent2, nlist2); }
            if (wave * 32 < nlist) {
                const int nq = ownu ? ((wave * 32 + 31) >> 6) + 1 : 4;
                f32x16 o[4];
#pragma unroll
                for (int dt = 0; dt < 4; ++dt)
#pragma unroll
                    for (int i = 0; i < 16; ++i) o[dt][i] = 0.f;
                float lacc = 0.f;
                const int qloc = e;
#pragma unroll 1
                for (int hf = 0; hf < nq; ++hf) {
                    f32x16 sa[2];
#pragma unroll
                    for (int i = 0; i < 16; ++i) { sa[0][i] = 0.f; sa[1][i] = 0.f; }
                    {
                        const LAS unsigned char* kp0 = lds + LDS_KS + (64 * hf + r32) * KV_PITCH + 16 * hh;
                        const LAS unsigned char* kp1 = kp0 + 32 * KV_PITCH;
                        bf16x8 a0 = *(const LAS bf16x8*)kp0, a1 = *(const LAS bf16x8*)kp1;
#pragma unroll
                        for (int ks = 0; ks < 8; ++ks) {
                            bf16x8 n0 = a0, n1 = a1;
                            if (ks < 7) { n0 = *(const LAS bf16x8*)(kp0 + 32 * (ks + 1)); n1 = *(const LAS bf16x8*)(kp1 + 32 * (ks + 1)); }
                            sa[0] = __builtin_amdgcn_mfma_f32_32x32x16_bf16(a0, qf[ks], sa[0], 0, 0, 0);
                            sa[1] = __builtin_amdgcn_mfma_f32_32x32x16_bf16(a1, qf[ks], sa[1], 0, 0, 0);
                            a0 = n0; a1 = n1;
                        }
                    }
                    if (ownu) {
#pragma unroll
                        for (int kt = 0; kt < 2; ++kt)
#pragma unroll
                            for (int i = 0; i < 16; ++i) { const int key = 64 * hf + 32 * kt + (i & 3) + 8 * (i >> 2) + 4 * hh;
                                float pv = __builtin_amdgcn_exp2f(sa[kt][i]); if (key > qloc) pv = 0.f; sa[kt][i] = pv; lacc += pv; }
                    } else {
#pragma unroll
                        for (int kt = 0; kt < 2; ++kt)
#pragma unroll
                            for (int i = 0; i < 16; ++i) { const float pv = __builtin_amdgcn_exp2f(sa[kt][i]); sa[kt][i] = pv; lacc += pv; }
                    }
                    bf16x8 pb[4];
#pragma unroll
                    for (int st = 0; st < 4; ++st) { const int kt = st >> 1, s2 = st & 1;
                        u32x4 pw; pw.x = pk2(sa[kt][8 * s2 + 0], sa[kt][8 * s2 + 1]); pw.y = pk2(sa[kt][8 * s2 + 2], sa[kt][8 * s2 + 3]);
                        pw.z = pk2(sa[kt][8 * s2 + 4], sa[kt][8 * s2 + 5]); pw.w = pk2(sa[kt][8 * s2 + 6], sa[kt][8 * s2 + 7]);
                        pb[st] = __builtin_bit_cast(bf16x8, pw); }
                    const LAS unsigned char* vp = lds + LDS_VS + (64 * hf + 4 * hh + qq) * KV_PITCH + 32 * blk + 8 * pp;
                    s16x4 cl[4], ch[4];
#pragma unroll
                    for (int dt = 0; dt < 4; ++dt) { cl[dt] = vtr(vp + 64 * dt); ch[dt] = vtr(vp + 8 * KV_PITCH + 64 * dt); }
#pragma unroll
                    for (int st = 0; st < 4; ++st) {
                        s16x4 nl[4], nh[4];
#pragma unroll
                        for (int dt = 0; dt < 4; ++dt) { nl[dt] = cl[dt]; nh[dt] = ch[dt]; }
                        if (st < 3) { const LAS unsigned char* vn = vp + 16 * (st + 1) * KV_PITCH;
#pragma unroll
                            for (int dt = 0; dt < 4; ++dt) { nl[dt] = vtr(vn + 64 * dt); nh[dt] = vtr(vn + 8 * KV_PITCH + 64 * dt); } }
#pragma unroll
                        for (int dt = 0; dt < 4; ++dt) { const bf16x8 vf = __builtin_shufflevector(cl[dt], ch[dt], 0, 1, 2, 3, 4, 5, 6, 7);
                            o[dt] = __builtin_amdgcn_mfma_f32_32x32x16_bf16(vf, pb[st], o[dt], 0, 0, 0); }
#pragma unroll
                        for (int dt = 0; dt < 4; ++dt) { cl[dt] = nl[dt]; ch[dt] = nh[dt]; }
                    }
                }
                lacc += __shfl_xor(lacc, 32);
                u32x4 ow[8];
#pragma unroll
                for (int dt = 0; dt < 4; ++dt)
#pragma unroll
                    for (int gp2 = 0; gp2 < 2; ++gp2) { const int g0 = 2 * gp2, g1 = g0 + 1;
                        unsigned ax = pk2(o[dt][4 * g0], o[dt][4 * g0 + 1]), ay = pk2(o[dt][4 * g0 + 2], o[dt][4 * g0 + 3]);
                        unsigned bxw = pk2(o[dt][4 * g1], o[dt][4 * g1 + 1]), by = pk2(o[dt][4 * g1 + 2], o[dt][4 * g1 + 3]);
                        { const auto rsw = __builtin_amdgcn_permlane32_swap(ax, bxw, false, false); ax = rsw[0]; bxw = rsw[1]; }
                        { const auto rsw = __builtin_amdgcn_permlane32_swap(ay, by, false, false); ay = rsw[0]; by = rsw[1]; }
                        ow[dt * 2 + gp2] = (u32x4){ax, ay, bxw, by}; }
                if (valid) {
                    bf16_t* op = slots + ((size_t)qi * 4 + slot) * 1024 + h * 128 + 8 * hh;
#pragma unroll
                    for (int dt = 0; dt < 4; ++dt)
#pragma unroll
                        for (int gp2 = 0; gp2 < 2; ++gp2) *(u32x4*)(op + 32 * dt + 16 * gp2) = ow[dt * 2 + gp2];
                    if (hh == 0) lsum[((size_t)qi * 4 + slot) * 8 + h] = lacc;
                }
            }
            hj = hj2; li = li2; ent = ent2; nlist = nlist2;
        }
        RELOAD_IDS();
        for (int base = vcu * 8; base < 2048; base += G * 8) {
            const int gI = base >> 9;
            __syncthreads();
#pragma unroll
            for (int i = 0; i < 16; ++i) { const int idx = tid + NTHR * i, row = idx >> 5, c16 = idx & 31;
                *(LAS u32x4*)(lds + row * 528 + c16 * 16) = *(const u32x4*)(Wgt + (size_t)(gI * 256 + row) * 1024 + c16 * 8); }
            __syncthreads();
            const int item = base + wave, s0 = (item & 511) * 32, r = lane & 31, hh = lane >> 5;
            bf16x8 af[16];
            const bf16_t* ap = dbuf + (size_t)(s0 + r) * 1024 + gI * 256 + 8 * hh;
#pragma unroll
            for (int ks = 0; ks < 16; ++ks) af[ks] = *(const bf16x8*)(ap + 16 * ks);
#pragma unroll 1
            for (int nt = 0; nt < 8; nt += 2) {
                f32x16 ac[2];
#pragma unroll
                for (int i = 0; i < 16; ++i) { ac[0][i] = 0.f; ac[1][i] = 0.f; }
                const LAS unsigned char* bp = lds + (nt * 32 + r) * 528 + 16 * hh;
#pragma unroll
                for (int ks = 0; ks < 16; ++ks) { const bf16x8 b0 = *(const LAS bf16x8*)(bp + 32 * ks), b1 = *(const LAS bf16x8*)(bp + 32 * 528 + 32 * ks);
                    ac[0] = __builtin_amdgcn_mfma_f32_32x32x16_bf16(b0, af[ks], ac[0], 0, 0, 0); ac[1] = __builtin_amdgcn_mfma_f32_32x32x16_bf16(b1, af[ks], ac[1], 0, 0, 0); }
#pragma unroll
                for (int t2 = 0; t2 < 2; ++t2) {
                    bf16_t* op = am + (size_t)(s0 + r) * 2048 + 1024 + gI * 256 + (nt + t2) * 32 + 4 * hh;
#pragma unroll
                    for (int q4 = 0; q4 < 4; ++q4) { const f32x4 lsv = *(const f32x4*)(pscale + gI * 256 + (nt + t2) * 32 + 8 * q4 + 4 * hh);
                        u32x2 w; w.x = pk2(ac[t2][4 * q4] * lsv[0], ac[t2][4 * q4 + 1] * lsv[1]); w.y = pk2(ac[t2][4 * q4 + 2] * lsv[2], ac[t2][4 * q4 + 3] * lsv[3]); *(u32x2*)(op + 8 * q4) = w; }
                }
            }
        }
    }
    xcd_barrier(xbar);
    RELOAD_IDS();

#endif
#if PHMASK & 32
    {
    }
    RELOAD_IDS();
#pragma unroll 2
    for (int idx = vcu * NTHR + tid; idx < S * 128; idx += G * NTHR) {
        const int qi = idx >> 7, c8 = idx & 127, h = c8 >> 4, own = qi >> 8, ns = own < 3 ? own : 3;
        float a[8]; float l = 0.f;
#pragma unroll
        for (int i = 0; i < 8; ++i) a[i] = 0.f;
#pragma unroll
        for (int s = 0; s < 4; ++s) if (s == 3 || s < ns) { float f[8]; unpack8(*(const u32x4*)(slots + ((size_t)qi * 4 + s) * 1024 + c8 * 8), f);
#pragma unroll
            for (int i = 0; i < 8; ++i) a[i] += f[i];
            l += lsum[((size_t)qi * 4 + s) * 8 + h]; }
        const float inv = 1.0f / l;
        u32x4 w; w.x = pk2(a[0] * inv, a[1] * inv); w.y = pk2(a[2] * inv, a[3] * inv); w.z = pk2(a[4] * inv, a[5] * inv); w.w = pk2(a[6] * inv, a[7] * inv);
        *(u32x4*)(am + (size_t)qi * 2048 + c8 * 8) = w;
    }
    xcd_barrier(xbar);
    RELOAD_IDS();

#endif
#if PHMASK & 64
    { pg8::Gemm g{am, Wyt, 2048, 2048, 1024}; pg8::Sched<1> Sc; Sc.init(S, 2048, G, bx); Epi5 E{gates, merged}; pg8::gemm_phase<Epi5>(lds, g, Sc, E); }
    xcd_barrier(xbar);
    RELOAD_IDS();

#endif
#if PHMASK & 128
    { pg8::Gemm g{merged, Wot, 2048, 2048, 2048}; pg8::Sched<0> Sc; Sc.init(S, 2048, G, bx); Epi6 E{xin, outp, xg, modf, nfg, rowss}; pg8::gemm_phase<Epi6>(lds, g, Sc, E); }
    xcd_barrier(xbar);
    RELOAD_IDS();

#endif
#if PHMASK & 256
    { pg8::Gemm g{xg, Wut, 2048, 2048, 2048}; pg8::Sched<0> Sc; Sc.init(S, NUP, G, bx);
      LAS float* rst = (LAS float*)(lds + 135424); int fm = 0; { Unit u0; if (Sc.next(0, u0)) fm = u0.pm & ~7; }
      for (int rl = tid; rl < 2048; rl += NTHR) { const f32x4* pr = (const f32x4*)(rowss + (size_t)(fm * 256 + rl) * 32); f32x4 sm = pr[0];
#pragma unroll
          for (int j = 1; j < 8; ++j) sm += pr[j];
          rst[rl] = __builtin_amdgcn_rsqf(((sm[0] + sm[1]) + (sm[2] + sm[3])) * (1.0f / 2048.0f) + EPS); }
      __syncthreads();
      Epi7 E{rst, fm, rowss, biasup, conv_w, conv_b, act, edge}; pg8::gemm_phase_drain<Epi7>(lds, g, Sc, E); }
    xcd_barrier(xbar);
    RELOAD_IDS();

#endif
#if PHMASK & 512
    {
        pg8::Sched<0> Sf; Sf.init(S, 2048, G, bx);
        for (int ui = 0;; ++ui) {
            Unit uf; if (!Sf.next(ui, uf)) break;
            const int tl = uf.pm;
            for (int idx = tid; idx < DFF / 4; idx += NTHR) {
                const int c = idx * 4;
                f32x4 r0[2], r1[2];
#pragma unroll
                for (int bj = 0; bj < 2; ++bj) {
                    const int lc = bj * DFF + c;
                    const f32x4 z = (f32x4){0.f, 0.f, 0.f, 0.f};
                    const f32x4 pm2 = tl > 0 ? *(const f32x4*)(edge + ((size_t)((tl - 1) * 4 + 2)) * NUP + lc) : z;
                    const f32x4 pm1 = tl > 0 ? *(const f32x4*)(edge + ((size_t)((tl - 1) * 4 + 3)) * NUP + lc) : z;
                    const f32x4 e0 = *(const f32x4*)(edge + ((size_t)(tl * 4 + 0)) * NUP + lc), e1 = *(const f32x4*)(edge + ((size_t)(tl * 4 + 1)) * NUP + lc);
                    const f32x4 w0 = *(const f32x4*)(conv_w + lc), w1 = *(const f32x4*)(conv_w + NUP + lc), w2 = *(const f32x4*)(conv_w + 2 * NUP + lc), cbv = *(const f32x4*)(conv_b + lc);
                    r0[bj] = cbv + w0 * pm2 + w1 * pm1 + w2 * e0;
                    r1[bj] = cbv + w0 * pm1 + w1 * e0 + w2 * e1;
                }
                u32x2 o0, o1; float t0[4], t1[4];
#pragma unroll
                for (int i = 0; i < 4; ++i) { t0[i] = r0[0][i] * sigmoidf_(r0[0][i]) * r0[1][i]; t1[i] = r1[0][i] * sigmoidf_(r1[0][i]) * r1[1][i]; }
                o0.x = pk2(t0[0], t0[1]); o0.y = pk2(t0[2], t0[3]); o1.x = pk2(t1[0], t1[1]); o1.y = pk2(t1[2], t1[3]);
                *(u32x2*)(act + (size_t)(tl * 256) * DFF + c) = o0; *(u32x2*)(act + (size_t)(tl * 256 + 1) * DFF + c) = o1;
            }
        }
        asm volatile("s_waitcnt vmcnt(0)" ::: "memory");
        __syncthreads();
        RELOAD_IDS();
    }
    { pg8::Gemm g{act, Wdt, DFF, DFF, DFF}; pg8::Sched<0> Sc; Sc.init(S, 2048, G, bx); Epi9 E{outp, modf}; pg8::gemm_phase<Epi9>(lds, g, Sc, E); }
#endif
}

extern "C" void kernel_launch(void* const* d_in, const int* in_sizes, int n_in, void* d_out, int out_size, void* d_ws, size_t ws_size, hipStream_t stream) {
    static int grid_blocks = 0;
    if (grid_blocks == 0) {
        if (n_in != 20 || out_size != S * DM || ws_size < WS_END) { fprintf(stderr, "kernel_launch: unexpected shapes (n_in %d out %d ws %zu)\n", n_in, out_size, ws_size); grid_blocks = -1; return; }
        int dev = 0, cus = 0, per_cu = 0;
        hipGetDevice(&dev);
        hipDeviceGetAttribute(&cus, hipDeviceAttributeMultiprocessorCount, dev);
        hipFuncSetAttribute((const void*)fwd_megakernel, hipFuncAttributeMaxDynamicSharedMemorySize, LDS_BYTES);
        hipOccupancyMaxActiveBlocksPerMultiprocessor(&per_cu, (const void*)fwd_megakernel, NTHR, LDS_BYTES);
        if (per_cu < 1) { fprintf(stderr, "kernel_launch: occupancy query reports %d blocks per CU\n", per_cu); grid_blocks = -1; return; }
        if (per_cu > 1) per_cu = 1;
        grid_blocks = cus * per_cu;
        if (grid_blocks > 256) grid_blocks = 256;
    }
    if (grid_blocks < 0) return;
    Params p{};
    for (int i = 0; i < 20; ++i) p.in[i] = (const float*)d_in[i];
    p.out = (float*)d_out; p.ws = (unsigned char*)d_ws;
    void* args[] = {&p};
    hipError_t e = hipLaunchCooperativeKernel((const void*)fwd_megakernel, dim3(grid_blocks), dim3(NTHR), args, LDS_BYTES, stream);
    if (e != hipSuccess) fprintf(stderr, "cooperative launch failed: %s (grid %d)\n", hipGetErrorString(e), grid_blocks);
}
```

```cpp
#include <hip/hip_runtime.h>
#include <hip/hip_cooperative_groups.h>
#include <cstdio>
#include <cstdint>
namespace cg = cooperative_groups;

#define LAS __attribute__((address_space(3)))
#define DI __device__ __forceinline__
typedef unsigned short bf16_t;
typedef short bf16x8 __attribute__((ext_vector_type(8)));
typedef short s16x4 __attribute__((ext_vector_type(4)));
typedef float f32x2 __attribute__((ext_vector_type(2)));
typedef float f32x4 __attribute__((ext_vector_type(4)));
typedef float f32x16 __attribute__((ext_vector_type(16)));
typedef unsigned u32x2 __attribute__((ext_vector_type(2)));
typedef unsigned u32x4 __attribute__((ext_vector_type(4)));
typedef __bf16 bf16x2_t __attribute__((ext_vector_type(2)));

constexpr int S = 16384, DM = 2048, NH = 8, HD = 128, AW = 1024, PW = 1024, DFF = 5632, NUP = 2 * DFF, N1 = 8192;
constexpr float EPS = 1e-6f;
constexpr int NWAVES = 8, NTHR = 512;
constexpr int LDS_BYTES = 147456;
constexpr int XL_OFF = 131072;

constexpr size_t MiB = 1u << 20;
constexpr size_t WS_ZERO = 0, ZERO_BYTES = 1 * MiB;
constexpr size_t WS_CNT = 0, WS_KMEAN = 65536, WS_BAR = 524288;
constexpr size_t WS_MODP = 1 * MiB;
constexpr size_t WS_MODF = 2 * MiB;
constexpr size_t WS_BIASUP = 2 * MiB + 65536;
constexpr size_t WS_ROWSS = 3 * MiB;
constexpr size_t WS_LSUM = 5 * MiB;
constexpr size_t WS_LIST = 8 * MiB;
constexpr size_t WS_W1 = 40 * MiB;
constexpr size_t WS_WY = 72 * MiB;
constexpr size_t WS_WO = 80 * MiB;
constexpr size_t WS_WG = 88 * MiB;
constexpr size_t WS_WD = 90 * MiB;
constexpr size_t WS_WU = 112 * MiB;
constexpr size_t WS_HB = 156 * MiB;
constexpr size_t WS_Q = 220 * MiB, WS_K = 252 * MiB, WS_V = 284 * MiB, WS_U = 316 * MiB;
constexpr size_t WS_GATES = 348 * MiB;
constexpr size_t WS_DB = 476 * MiB;
constexpr size_t WS_AM = WS_HB;
constexpr size_t WS_MERGED = 284 * MiB;
constexpr size_t WS_XG = WS_HB;
constexpr size_t WS_ACT = 220 * MiB;
constexpr size_t WS_EDGE = 400 * MiB;
constexpr size_t WS_END = 508 * MiB;

__constant__ double ROPE_C[64] = {
1.59154943091895346e-01, 1.37822502603982849e-01, 1.19349370211248862e-01, 1.03352296618434064e-01,
8.94994016088910133e-02, 7.75032887553740585e-02, 6.71150830052272551e-02, 5.81192674418762462e-02,
5.03292121044870353e-02, 4.35833021053073297e-02, 3.77415847174197711e-02, 3.26828658723569976e-02,
2.83022014470915797e-02, 2.45087088680224316e-02, 2.12236869570126724e-02, 1.83789788427912383e-02,
1.59154943091895346e-02, 1.37822502603982859e-02, 1.19349370211248869e-02, 1.03352296618434061e-02,
8.94994016088910168e-03, 7.75032887553740620e-03, 6.71150830052272551e-03, 5.81192674418762497e-03,
5.03292121044870353e-03, 4.35833021053073314e-03, 3.77415847174197694e-03, 3.26828658723569993e-03,
2.83022014470915797e-03, 2.45087088680224316e-03, 2.12236869570126715e-03, 1.83789788427912387e-03,
1.59154943091895346e-03, 1.37822502603982855e-03, 1.19349370211248860e-03, 1.03352296618434065e-03,
8.94994016088910125e-04, 7.75032887553740577e-04, 6.71150830052272594e-04, 5.81192674418762454e-04,
5.03292121044870353e-04, 4.35833021053073336e-04, 3.77415847174197716e-04, 3.26828658723569971e-04,
2.83022014470915775e-04, 2.45087088680224327e-04, 2.12236869570126726e-04, 1.83789788427912376e-04,
1.59154943091895335e-04, 1.37822502603982850e-04, 1.19349370211248865e-04, 1.03352296618434062e-04,
8.94994016088910179e-05, 7.75032887553740523e-05, 6.71150830052272540e-05, 5.81192674418762481e-05,
5.03292121044870380e-05, 4.35833021053073309e-05, 3.77415847174197689e-05, 3.26828658723569984e-05,
2.83022014470915789e-05, 2.45087088680224307e-05, 2.12236869570126719e-05, 1.83789788427912390e-05 };

DI unsigned pk2(float lo, float hi) { f32x2 v = {lo, hi}; bf16x2_t b = __builtin_convertvector(v, bf16x2_t); return __builtin_bit_cast(unsigned, b); }
DI float bflo(unsigned w) { return __uint_as_float(w << 16); }
DI float bfhi(unsigned w) { return __uint_as_float(w & 0xffff0000u); }
DI void unpack8(const u32x4 w, float* f) { f[0] = bflo(w.x); f[1] = bfhi(w.x); f[2] = bflo(w.y); f[3] = bfhi(w.y); f[4] = bflo(w.z); f[5] = bfhi(w.z); f[6] = bflo(w.w); f[7] = bfhi(w.w); }
DI u32x4 pack8(const f32x4 a, const f32x4 b) { u32x4 w; w.x = pk2(a[0], a[1]); w.y = pk2(a[2], a[3]); w.z = pk2(b[0], b[1]); w.w = pk2(b[2], b[3]); return w; }
DI float wave_sum(float v) {
#pragma unroll
    for (int o = 1; o < 64; o <<= 1) v += __shfl_xor(v, o);
    return v;
}
DI float sigmoidf_(float x) { return __builtin_amdgcn_rcpf(1.0f + __builtin_amdgcn_exp2f(x * -1.4426950408889634f)); }
#define LDS_WAIT() asm volatile("s_waitcnt lgkmcnt(0)" ::: "memory")
#define FENCE() do { asm volatile("" ::: "memory"); __builtin_amdgcn_sched_barrier(0); } while (0)
#define TIE(var, dep) asm volatile("" : "+v"(var) : "v"(dep))
#define RAW_BAR() do { asm volatile("s_waitcnt lgkmcnt(0)" ::: "memory"); __builtin_amdgcn_s_barrier(); asm volatile("" ::: "memory"); } while (0)

#ifndef PG8_USE_SP2
#define PG8_USE_SP2 1
#endif
namespace pg8 {
constexpr int BM = 256, BK = 64, HALF = 128, HTB = HALF * BK * 2, STAGE_BYTES = 8 * HTB, NXCD = 8, WGM = 8;
__host__ __device__ __forceinline__ int lds_byte(int r, int c) { const int st = (r >> 4) * 2 + (c >> 5), rr = r & 15, cc = c & 31, ob = rr * 64 + cc * 2; return st * 1024 + (ob ^ (((ob >> 9) & 1) << 5)); }
__host__ __device__ __forceinline__ void stage_rc(int b, int& R, int& C) { const int st = b / 1024, sb = b % 1024, swz = sb ^ (((sb >> 9) & 1) << 5); R = (st >> 1) * 16 + swz / 64; C = (st & 1) * 32 + (swz % 64) / 2; }
__host__ __device__ __forceinline__ int perm32(int rho) { const int n = rho >> 4, i = rho & 15; return 8 * (i >> 2) + 4 * n + (i & 3); }

struct Unit { int pm, pn, ka, kb, aux; };
struct Gemm { const bf16_t* A; const bf16_t* Bt; int lda, ldb, K; };

template <int mode> struct Sched {
    int nM, nN, nwg, G, c;
    __device__ void init(int M, int N, int G_, int c_) { nM = M / BM; nN = N / BM; nwg = nM * nN; G = G_; c = c_; }
    __device__ bool next(int i, Unit& u) const {
        const int ii = (mode == 1) ? (i >> 1) : i;
        const long L = (long)ii * G + c; if (L >= nwg) return false;
        int wgid = (int)L; { const int q = nwg / NXCD, r = nwg % NXCD, xcd = wgid % NXCD, off = wgid / NXCD; wgid = (xcd < r ? xcd * (q + 1) : r * (q + 1) + (xcd - r) * q) + off; }
        const int nig = WGM * nN, gid = wgid / nig, fm = gid * WGM, gsz = (nM - fm) < WGM ? (nM - fm) : WGM;
        u.pm = fm + ((wgid % nig) % gsz); u.pn = (wgid % nig) / gsz;
        u.aux = (mode == 1) ? (i & 1) : 0; u.ka = (mode == 1) ? 1024 * (i & 1) : ((mode == 2) ? 256 * u.pn : 0); u.kb = (mode == 1) ? 1024 * (i & 1) : 0;
        return true;
    }
};

template <class Epi, class SchedT>
DI void gemm_phase(LAS unsigned char* lds, const Gemm g, const SchedT& S, const Epi& E) {
    int tid_ = threadIdx.x; asm volatile("" : "+v"(tid_));
    const int tid = tid_, wid = __builtin_amdgcn_readfirstlane(tid >> 6), lane = tid & 63, wr = wid >> 2, wc = wid & 3, fr = lane & 15, fq = lane >> 4;
    const int nt = g.K / BK;
    unsigned voffA, voffB;
    { int R, C; stage_rc(tid * 16, R, C); const int Rb = (R & ~31) + perm32(R & 31);
      voffA = (unsigned)(R * g.lda + C) * 2u; voffB = (unsigned)(Rb * g.ldb + C) * 2u; }
    const size_t dvoffA = (size_t)64 * g.lda * 2, dvoffB = (size_t)64 * g.ldb * 2;
    const size_t kstep = (size_t)(BK * 2);
    const size_t hstepA = (size_t)HALF * g.lda * 2, hstepB = (size_t)HALF * g.ldb * 2;
    const size_t tstepA = 2 * hstepA, tstepB = 2 * hstepB;
    const unsigned ldsw = (unsigned)wid * 1024u;
    const int aoff = lds_byte(wr * 64 + fr, fq * 8), boff = lds_byte(wc * 32 + fr, fq * 8);
#define PG8_SA(b, h) (((b) * 2 + (h)) * HTB)
#define PG8_SB(b, h) ((4 + (b) * 2 + (h)) * HTB)
#define PG8_STAGE(bufoff, gbase, voff) do { _Pragma("unroll") for (int _i = 0; _i < 2; ++_i) \
        __builtin_amdgcn_global_load_lds((const unsigned*)((const char*)(gbase) + (size_t)_i * d##voff + (voff)), (LAS unsigned*)(lds + (bufoff) + ldsw + _i * 8192), 16, 0, 0); } while (0)
#define PG8_LDA(dst, b, h) do { _Pragma("unroll") for (int m = 0; m < 4; ++m) _Pragma("unroll") for (int k = 0; k < 2; ++k) dst[m][k] = *(const LAS bf16x8*)(lds + PG8_SA(b, h) + aoff + m * 2048 + k * 1024); } while (0)
#define PG8_LDB(dst, b, h) do { _Pragma("unroll") for (int n = 0; n < 2; ++n) _Pragma("unroll") for (int k = 0; k < 2; ++k) dst[n][k] = *(const LAS bf16x8*)(lds + PG8_SB(b, h) + boff + n * 2048 + k * 1024); } while (0)
#define PG8_MMA(ai, bj, At, Bt) do { __builtin_amdgcn_s_setprio(1); _Pragma("unroll") for (int m = 0; m < 4; ++m) _Pragma("unroll") for (int n = 0; n < 2; ++n) _Pragma("unroll") for (int k = 0; k < 2; ++k) \
        acc[ai][bj][m][n] = __builtin_amdgcn_mfma_f32_16x16x32_bf16(Bt[n][k], At[m][k], acc[ai][bj][m][n], 0, 0, 0); __builtin_amdgcn_s_setprio(0); } while (0)
#define PG8_WAIT_V(n) asm volatile("s_waitcnt vmcnt(" #n ")" ::: "memory")
#define PG8_WAIT_L(n) asm volatile("s_waitcnt lgkmcnt(" #n ")" ::: "memory")
#define PG8_BAR __builtin_amdgcn_s_barrier()
#define PG8_SCHED __builtin_amdgcn_sched_barrier(0)
    Unit cur, nxt; int ui = 0;
    if (!S.next(0, cur)) return;
    f32x4 acc[2][2][4][2];
#pragma unroll
    for (int a = 0; a < 2; ++a)
#pragma unroll
        for (int b = 0; b < 2; ++b)
#pragma unroll
            for (int m = 0; m < 4; ++m)
#pragma unroll
                for (int n = 0; n < 2; ++n) acc[a][b][m][n] = (f32x4){0.f, 0.f, 0.f, 0.f};
    bf16x8 At[4][2], B0[2][2], B1[2][2];
    const char* cA = (const char*)g.A + (size_t)cur.pm * tstepA + (size_t)cur.ka * 2; const char* cB = (const char*)g.Bt + (size_t)cur.pn * tstepB + (size_t)cur.kb * 2;
#if PG8_USE_SP2
    PG8_STAGE(PG8_SB(0, 0), cB, voffB); PG8_STAGE(PG8_SB(0, 1), cB + hstepB, voffB); PG8_STAGE(PG8_SA(0, 0), cA, voffA); PG8_STAGE(PG8_SA(0, 1), cA + hstepA, voffA);
    if (wr == 1) PG8_BAR;
    PG8_WAIT_V(2); PG8_BAR;
#else
    PG8_STAGE(PG8_SB(0, 0), cB, voffB); PG8_STAGE(PG8_SA(0, 0), cA, voffA); PG8_STAGE(PG8_SB(0, 1), cB + hstepB, voffB); PG8_STAGE(PG8_SA(0, 1), cA + hstepA, voffA);
    if (wr == 1) PG8_BAR;
    PG8_WAIT_V(4); PG8_BAR;
#endif
    PG8_STAGE(PG8_SB(1, 0), cB + kstep, voffB); PG8_STAGE(PG8_SA(1, 0), cA + kstep, voffA); PG8_STAGE(PG8_SB(1, 1), cB + hstepB + kstep, voffB);
    PG8_WAIT_V(6); PG8_BAR;
    for (;;) {
        const bool has_next = S.next(ui + 1, nxt);
        const char* nA = has_next ? (const char*)g.A + (size_t)nxt.pm * tstepA + (size_t)nxt.ka * 2 : cA; const char* nB = has_next ? (const char*)g.Bt + (size_t)nxt.pn * tstepB + (size_t)nxt.kb * 2 : cB;
        for (int t = 0; t < nt; t += 2) {
            const bool last = (t == nt - 2);
            const char* a1 = cA + (size_t)(t + 1) * kstep;
            const char* a2 = last ? nA : cA + (size_t)(t + 2) * kstep; const char* b2 = last ? nB : cB + (size_t)(t + 2) * kstep;
            const char* a3 = a2 + kstep; const char* b3 = b2 + kstep;
#if PG8_USE_SP2
            PG8_LDB(B0, 0, 0); PG8_LDB(B1, 0, 1); PG8_SCHED; PG8_LDA(At, 0, 0); PG8_STAGE(PG8_SA(1, 1), a1 + hstepA, voffA);
            PG8_WAIT_V(8); PG8_WAIT_L(0); PG8_BAR; PG8_MMA(0, 0, At, B0); PG8_MMA(0, 1, At, B1); PG8_BAR; PG8_SCHED;
            PG8_LDA(At, 0, 1); PG8_STAGE(PG8_SB(0, 0), b2, voffB); PG8_STAGE(PG8_SB(0, 1), b2 + hstepB, voffB); PG8_STAGE(PG8_SA(0, 0), a2, voffA);
            PG8_WAIT_V(8); PG8_WAIT_L(0); PG8_BAR; PG8_MMA(1, 0, At, B0); PG8_MMA(1, 1, At, B1); PG8_BAR; PG8_SCHED;
            PG8_LDB(B0, 1, 0); PG8_LDB(B1, 1, 1); PG8_SCHED; PG8_LDA(At, 1, 0); PG8_STAGE(PG8_SA(0, 1), a2 + hstepA, voffA);
            PG8_WAIT_V(8); PG8_WAIT_L(0); PG8_BAR; PG8_MMA(0, 0, At, B0); PG8_MMA(0, 1, At, B1); PG8_BAR; PG8_SCHED;
            PG8_LDA(At, 1, 1); PG8_STAGE(PG8_SB(1, 0), b3, voffB); PG8_STAGE(PG8_SB(1, 1), b3 + hstepB, voffB); PG8_STAGE(PG8_SA(1, 0), a3, voffA);
            PG8_WAIT_V(8); PG8_WAIT_L(0); PG8_BAR; PG8_MMA(1, 0, At, B0); PG8_MMA(1, 1, At, B1); PG8_BAR; PG8_SCHED;
#else
            PG8_LDB(B0, 0, 0); PG8_SCHED; PG8_LDA(At, 0, 0); PG8_STAGE(PG8_SA(1, 1), a1 + hstepA, voffA);
            PG8_WAIT_L(8); PG8_BAR; PG8_WAIT_L(0); PG8_MMA(0, 0, At, B0); PG8_BAR; PG8_SCHED;
            PG8_LDB(B1, 0, 1); PG8_STAGE(PG8_SB(0, 0), b2, voffB);
            PG8_BAR; PG8_WAIT_L(0); PG8_MMA(0, 1, At, B1); PG8_BAR;
            PG8_LDA(At, 0, 1); PG8_STAGE(PG8_SA(0, 0), a2, voffA);
            PG8_BAR; PG8_WAIT_L(0); PG8_MMA(1, 0, At, B0); PG8_BAR; PG8_SCHED;
            PG8_STAGE(PG8_SB(0, 1), b2 + hstepB, voffB);
            PG8_WAIT_V(6); PG8_BAR; PG8_MMA(1, 1, At, B1); PG8_BAR;
            PG8_LDB(B0, 1, 0); PG8_SCHED; PG8_LDA(At, 1, 0); PG8_STAGE(PG8_SA(0, 1), a2 + hstepA, voffA);
            PG8_WAIT_L(8); PG8_BAR; PG8_WAIT_L(0); PG8_MMA(0, 0, At, B0); PG8_BAR; PG8_SCHED;
            PG8_LDB(B1, 1, 1); PG8_STAGE(PG8_SB(1, 0), b3, voffB);
            PG8_BAR; PG8_WAIT_L(0); PG8_MMA(0, 1, At, B1); PG8_BAR;
            PG8_LDA(At, 1, 1); PG8_STAGE(PG8_SA(1, 0), a3, voffA);
            PG8_BAR; PG8_WAIT_L(0); PG8_MMA(1, 0, At, B0); PG8_BAR; PG8_SCHED;
            PG8_STAGE(PG8_SB(1, 1), b3 + hstepB, voffB);
            PG8_WAIT_V(6); PG8_BAR; PG8_MMA(1, 1, At, B1); PG8_BAR;
#endif
        }
        if (wr == 0) PG8_BAR;
        { int l2 = threadIdx.x; asm volatile("" : "+v"(l2)); l2 &= 63;
          E(acc, cur, wr, wc, l2 & 15, l2 >> 4, lds + XL_OFF); }
        if (!has_next) break;
        if (!(Epi::CHAIN && cur.aux == 0)) {
#pragma unroll
            for (int a = 0; a < 2; ++a)
#pragma unroll
                for (int b = 0; b < 2; ++b)
#pragma unroll
                    for (int m = 0; m < 4; ++m)
#pragma unroll
                        for (int n = 0; n < 2; ++n) acc[a][b][m][n] = (f32x4){0.f, 0.f, 0.f, 0.f};
        }
        cur = nxt; cA = nA; cB = nB; ++ui;
        if (wr == 1) PG8_BAR;
    }
    PG8_WAIT_V(0);
    PG8_BAR;
}

template <class Epi, class SchedT>
DI void gemm_phase_drain(LAS unsigned char* lds, const Gemm g, const SchedT& S, const Epi& E) {
    int tid_ = threadIdx.x; asm volatile("" : "+v"(tid_));
    const int tid = tid_, wid = __builtin_amdgcn_readfirstlane(tid >> 6), lane = tid & 63, wr = wid >> 2, wc = wid & 3, fr = lane & 15, fq = lane >> 4;
    const int nt = g.K / BK;
    unsigned voffA, voffB;
    { int R, C; stage_rc(tid * 16, R, C); const int Rb = (R & ~31) + perm32(R & 31);
      voffA = (unsigned)(R * g.lda + C) * 2u; voffB = (unsigned)(Rb * g.ldb + C) * 2u; }
    const size_t dvoffA = (size_t)64 * g.lda * 2, dvoffB = (size_t)64 * g.ldb * 2;
    const size_t kstep = (size_t)(BK * 2);
    const size_t hstepA = (size_t)HALF * g.lda * 2, hstepB = (size_t)HALF * g.ldb * 2;
    const size_t tstepA = 2 * hstepA, tstepB = 2 * hstepB;
    const unsigned ldsw = (unsigned)wid * 1024u;
    const int aoff = lds_byte(wr * 64 + fr, fq * 8), boff = lds_byte(wc * 32 + fr, fq * 8);
    bool primed = false; Unit cur, nxt;
    bool have = S.next(0, cur);
    for (int ui = 0; have; ++ui) {
        f32x4 acc[2][2][4][2];
#pragma unroll
        for (int a = 0; a < 2; ++a)
#pragma unroll
            for (int b = 0; b < 2; ++b)
#pragma unroll
                for (int m = 0; m < 4; ++m)
#pragma unroll
                    for (int n = 0; n < 2; ++n) acc[a][b][m][n] = (f32x4){0.f, 0.f, 0.f, 0.f};
        bf16x8 At[4][2], B0[2][2], B1[2][2];
        const char* cA = (const char*)g.A + (size_t)cur.pm * tstepA + (size_t)cur.ka * 2; const char* cB = (const char*)g.Bt + (size_t)cur.pn * tstepB + (size_t)cur.kb * 2;
        if (!primed) {
#if PG8_USE_SP2
        PG8_STAGE(PG8_SB(0, 0), cB, voffB); PG8_STAGE(PG8_SB(0, 1), cB + hstepB, voffB); PG8_STAGE(PG8_SA(0, 0), cA, voffA); PG8_STAGE(PG8_SA(0, 1), cA + hstepA, voffA);
        if (wr == 1) PG8_BAR;
        PG8_WAIT_V(2); PG8_BAR;
#else
        PG8_STAGE(PG8_SB(0, 0), cB, voffB); PG8_STAGE(PG8_SA(0, 0), cA, voffA); PG8_STAGE(PG8_SB(0, 1), cB + hstepB, voffB); PG8_STAGE(PG8_SA(0, 1), cA + hstepA, voffA);
        if (wr == 1) PG8_BAR;
        PG8_WAIT_V(4); PG8_BAR;
#endif
        PG8_STAGE(PG8_SB(1, 0), cB + kstep, voffB); PG8_STAGE(PG8_SA(1, 0), cA + kstep, voffA); PG8_STAGE(PG8_SB(1, 1), cB + hstepB + kstep, voffB);
        PG8_WAIT_V(6); PG8_BAR;
        }
        const bool has_next = S.next(ui + 1, nxt); const bool pf = has_next && !E.uses_lds(cur);
        const char* nA = pf ? (const char*)g.A + (size_t)nxt.pm * tstepA + (size_t)nxt.ka * 2 : cA; const char* nB = pf ? (const char*)g.Bt + (size_t)nxt.pn * tstepB + (size_t)nxt.kb * 2 : cB;
        for (int t = 0; t < nt; t += 2) {
            const bool last = (t == nt - 2);
            const char* a1 = cA + (size_t)(t + 1) * kstep;
            const char* a2 = last ? nA : cA + (size_t)(t + 2) * kstep; const char* b2 = last ? nB : cB + (size_t)(t + 2) * kstep;
            const char* a3 = a2 + kstep; const char* b3 = b2 + kstep;
#if PG8_USE_SP2
            PG8_LDB(B0, 0, 0); PG8_LDB(B1, 0, 1); PG8_SCHED; PG8_LDA(At, 0, 0); PG8_STAGE(PG8_SA(1, 1), a1 + hstepA, voffA);
            PG8_WAIT_V(8); PG8_WAIT_L(0); PG8_BAR; PG8_MMA(0, 0, At, B0); PG8_MMA(0, 1, At, B1); PG8_BAR; PG8_SCHED;
            PG8_LDA(At, 0, 1); PG8_STAGE(PG8_SB(0, 0), b2, voffB); PG8_STAGE(PG8_SB(0, 1), b2 + hstepB, voffB); PG8_STAGE(PG8_SA(0, 0), a2, voffA);
            PG8_WAIT_V(8); PG8_WAIT_L(0); PG8_BAR; PG8_MMA(1, 0, At, B0); PG8_MMA(1, 1, At, B1); PG8_BAR; PG8_SCHED;
            PG8_LDB(B0, 1, 0); PG8_LDB(B1, 1, 1); PG8_SCHED; PG8_LDA(At, 1, 0); PG8_STAGE(PG8_SA(0, 1), a2 + hstepA, voffA);
            PG8_WAIT_V(8); PG8_WAIT_L(0); PG8_BAR; PG8_MMA(0, 0, At, B0); PG8_MMA(0, 1, At, B1); PG8_BAR; PG8_SCHED;
            PG8_LDA(At, 1, 1); PG8_STAGE(PG8_SB(1, 0), b3, voffB); PG8_STAGE(PG8_SB(1, 1), b3 + hstepB, voffB); PG8_STAGE(PG8_SA(1, 0), a3, voffA);
            PG8_WAIT_V(8); PG8_WAIT_L(0); PG8_BAR; PG8_MMA(1, 0, At, B0); PG8_MMA(1, 1, At, B1); PG8_BAR; PG8_SCHED;
#else
            PG8_LDB(B0, 0, 0); PG8_SCHED; PG8_LDA(At, 0, 0); PG8_STAGE(PG8_SA(1, 1), a1 + hstepA, voffA);
            PG8_WAIT_L(8); PG8_BAR; PG8_WAIT_L(0); PG8_MMA(0, 0, At, B0); PG8_BAR; PG8_SCHED;
            PG8_LDB(B1, 0, 1); PG8_STAGE(PG8_SB(0, 0), b2, voffB);
            PG8_BAR; PG8_WAIT_L(0); PG8_MMA(0, 1, At, B1); PG8_BAR;
            PG8_LDA(At, 0, 1); PG8_STAGE(PG8_SA(0, 0), a2, voffA);
            PG8_BAR; PG8_WAIT_L(0); PG8_MMA(1, 0, At, B0); PG8_BAR; PG8_SCHED;
            PG8_STAGE(PG8_SB(0, 1), b2 + hstepB, voffB);
            PG8_WAIT_V(6); PG8_BAR; PG8_MMA(1, 1, At, B1); PG8_BAR;
            PG8_LDB(B0, 1, 0); PG8_SCHED; PG8_LDA(At, 1, 0); PG8_STAGE(PG8_SA(0, 1), a2 + hstepA, voffA);
            PG8_WAIT_L(8); PG8_BAR; PG8_WAIT_L(0); PG8_MMA(0, 0, At, B0); PG8_BAR; PG8_SCHED;
            PG8_LDB(B1, 1, 1); PG8_STAGE(PG8_SB(1, 0), b3, voffB);
            PG8_BAR; PG8_WAIT_L(0); PG8_MMA(0, 1, At, B1); PG8_BAR;
            PG8_LDA(At, 1, 1); PG8_STAGE(PG8_SA(1, 0), a3, voffA);
            PG8_BAR; PG8_WAIT_L(0); PG8_MMA(1, 0, At, B0); PG8_BAR; PG8_SCHED;
            PG8_STAGE(PG8_SB(1, 1), b3 + hstepB, voffB);
            PG8_WAIT_V(6); PG8_BAR; PG8_MMA(1, 1, At, B1); PG8_BAR;
#endif
        }
        if (wr == 0) PG8_BAR;
        if (pf) {
            { int t2 = threadIdx.x; asm volatile("" : "+v"(t2)); E.drain(acc, cur, wr, wc, t2 & 15, (t2 & 63) >> 4, lds, t2); }
            if (wr == 1) PG8_BAR;
            primed = true;
        } else {
            PG8_WAIT_V(0); PG8_WAIT_L(0); PG8_BAR;
            { int t2 = threadIdx.x; asm volatile("" : "+v"(t2)); E.drain(acc, cur, wr, wc, t2 & 15, (t2 & 63) >> 4, lds, t2); }
            PG8_WAIT_L(0); PG8_BAR;
            primed = false;
        }
        have = has_next; cur = nxt;
    }
#undef PG8_SA
#undef PG8_SB
#undef PG8_STAGE
#undef PG8_LDA
#undef PG8_LDB
#undef PG8_MMA
#undef PG8_WAIT_V
#undef PG8_WAIT_L
#undef PG8_BAR
#undef PG8_SCHED
}
}
using pg8::Unit;
typedef f32x4 AccT[2][2][4][2];

constexpr int PT = 260;
struct Epi1 {
    static constexpr bool CHAIN = false;
    DI bool uses_lds(const Unit& u) const { return u.pn < 8; }
    bf16_t *q, *k, *v, *ub, *gates; float* kmean; const float *qg, *kg, *bgate;
    DI void drain(AccT& acc, const Unit& u, int wr, int wc, int fr, int fq, LAS unsigned char* lds, int tid) const {
        const int pn = u.pn; const int rowb = u.pm * 256 + wr * 64 + fr;
        bf16_t *pq = q, *pk = k, *pv = v, *pu = ub, *pg = gates; const float *pqg = qg, *pkg = kg;
        asm volatile("" : "+s"(pq), "+s"(pk), "+s"(pv), "+s"(pu), "+s"(pg), "+s"(pqg), "+s"(pkg));
        if (pn >= 16) {
            const int c0 = (pn - 16) * 128 + wc * 32 + fq * 8;
            f32x4 ba[2], bb[2];
#pragma unroll
            for (int n = 0; n < 2; ++n) { ba[n] = *(const f32x4*)(bgate + c0 + 4 * n); bb[n] = *(const f32x4*)(bgate + 2048 + c0 + 4 * n); }
#pragma unroll
            for (int ai = 0; ai < 2; ++ai)
#pragma unroll
                for (int m = 0; m < 4; ++m) { bf16_t* rowp = pg + (size_t)(rowb + ai * 128 + m * 16) * 4096 + c0;
                    f32x4 rr[2], gg[2];
#pragma unroll
                    for (int n = 0; n < 2; ++n)
#pragma unroll
                        for (int i = 0; i < 4; ++i) { const float ea = __builtin_amdgcn_exp2f((acc[ai][0][m][n][i] + ba[n][i]) * -1.4426950408889634f), eb = __builtin_amdgcn_exp2f((acc[ai][1][m][n][i] + bb[n][i]) * -1.4426950408889634f);
                            gg[n][i] = __builtin_amdgcn_rcpf(1.0f + eb); rr[n][i] = (1.0f + eb) * __builtin_amdgcn_rcpf(1.0f + ea); }
                    *(u32x4*)rowp = pack8(rr[0], rr[1]); *(u32x4*)(rowp + 2048) = pack8(gg[0], gg[1]); }
            return;
        }
        if (pn >= 8) {
            bf16_t* base; int ldc, col0; const bool sig = false;
            if (pn < 12) { base = pv; ldc = 1024; col0 = (pn - 8) * 256; } else { base = pu; ldc = 1024; col0 = (pn - 12) * 256; }
            col0 += wc * 32 + fq * 8;
            f32x4 bv[2][2];
#pragma unroll
            for (int bj = 0; bj < 2; ++bj)
#pragma unroll
                for (int n = 0; n < 2; ++n) bv[bj][n] = sig ? *(const f32x4*)(bgate + col0 + bj * 128 + 4 * n) : (f32x4){0.f, 0.f, 0.f, 0.f};
#pragma unroll
            for (int ai = 0; ai < 2; ++ai)
#pragma unroll
                for (int m = 0; m < 4; ++m) { bf16_t* rowp = base + (size_t)(rowb + ai * 128 + m * 16) * ldc + col0;
#pragma unroll
                    for (int bj = 0; bj < 2; ++bj) { f32x4 v0 = acc[ai][bj][m][0] + bv[bj][0], v1 = acc[ai][bj][m][1] + bv[bj][1];
                        if (sig) {
#pragma unroll
                            for (int i = 0; i < 4; ++i) { v0[i] = sigmoidf_(v0[i]); v1[i] = sigmoidf_(v1[i]); } }
                        *(u32x4*)(rowp + bj * 128) = pack8(v0, v1); } }
            return;
        }
        const bool isq = pn < 4; const int hp = (pn & 3) * 2;
        const float* g = isq ? pqg : pkg; bf16_t* dst = isq ? pq : pk;
        const float qs = isq ? 0.08838834764831845f * 1.4426950408889634f : 1.0f;
        LAS float* T = (LAS float*)lds;
        const int r = tid >> 2, part = tid & 3, bj2 = part >> 1, sub = part & 1;
        float ksum = 0.f;
#pragma unroll
        for (int ai = 0; ai < 2; ++ai) {
#pragma unroll
            for (int m = 0; m < 4; ++m)
#pragma unroll
                for (int bj = 0; bj < 2; ++bj)
#pragma unroll
                    for (int n = 0; n < 2; ++n) *(LAS f32x4*)(T + (64 * wr + 16 * m + fr) * PT + 128 * bj + 32 * wc + 8 * fq + 4 * n) = acc[ai][bj][m][n];
            RAW_BAR();
            LAS float* rowp = T + r * PT + 128 * bj2 + 32 * sub;
            float ss = 0.f;
#pragma unroll
            for (int j = 0; j < 8; ++j) { const f32x4 a = *(const LAS f32x4*)(rowp + 4 * j), b = *(const LAS f32x4*)(rowp + 64 + 4 * j);
                ss += (a[0] * a[0] + a[1] * a[1]) + (a[2] * a[2] + a[3] * a[3]) + (b[0] * b[0] + b[1] * b[1]) + (b[2] * b[2] + b[3] * b[3]); }
            ss += __shfl_xor(ss, 1);
            const float rr = __builtin_amdgcn_rsqf(ss * (1.0f / 128.0f) + EPS) * qs;
            const int row = u.pm * 256 + ai * 128 + r;
            bf16_t* op = dst + (size_t)row * 1024 + (hp + bj2) * 128 + 32 * sub;
#pragma unroll 1
            for (int j = 0; j < 8; j += 2) {
                f32x4 o1[2], o2[2];
#pragma unroll
                for (int jj = 0; jj < 2; ++jj) {
                    const int d = 32 * sub + 4 * (j + jj);
                    const f32x4 x1 = *(const LAS f32x4*)(rowp + 4 * (j + jj)), x2 = *(const LAS f32x4*)(rowp + 64 + 4 * (j + jj));
                    const f32x4 g0 = *(const f32x4*)(g + d), g1 = *(const f32x4*)(g + 64 + d);
                    f32x4 cs, sn;
#pragma unroll
                    for (int i = 0; i < 4; ++i) { double t = (double)row * ROPE_C[d + i]; t -= __builtin_floor(t); const float tf = (float)t; cs[i] = __builtin_amdgcn_cosf(tf); sn[i] = __builtin_amdgcn_sinf(tf); }
                    const f32x4 a = x1 * rr * g0, b = x2 * rr * g1;
                    o1[jj] = a * cs - b * sn; o2[jj] = b * cs + a * sn;
                    if (!isq) { *(LAS f32x4*)(rowp + 4 * (j + jj)) = o1[jj]; *(LAS f32x4*)(rowp + 64 + 4 * (j + jj)) = o2[jj]; }
                }
                *(u32x4*)(op + 4 * j) = pack8(o1[0], o1[1]); *(u32x4*)(op + 64 + 4 * j) = pack8(o2[0], o2[1]);
            }
            if (!isq) { RAW_BAR(); if (tid < 256) {
#pragma unroll 8
                for (int rr2 = 0; rr2 < 128; ++rr2) ksum += T[rr2 * PT + tid]; } }
            RAW_BAR();
        }
        if (!isq && tid < 256) kmean[((size_t)(hp + (tid >> 7)) * 64 + u.pm) * 128 + (tid & 127)] = ksum * (1.0f / 256.0f);
    }
};

struct Epi3 {
    static constexpr bool CHAIN = false;
    bf16_t* am; const float* ls;
    DI void drain(AccT& acc, const Unit& u, int wr, int wc, int fr, int fq, LAS unsigned char* l, int) const { (*this)(acc, u, wr, wc, fr, fq, l); }
    DI void operator()(AccT& acc, const Unit& u, int wr, int wc, int fr, int fq, LAS unsigned char*) const {
        const int col0 = u.pn * 256 + wc * 32 + fq * 8; const int rowb = u.pm * 256 + wr * 64 + fr;
        f32x4 sv[2][2];
#pragma unroll
        for (int bj = 0; bj < 2; ++bj)
#pragma unroll
            for (int n = 0; n < 2; ++n) sv[bj][n] = *(const f32x4*)(ls + col0 + bj * 128 + 4 * n);
#pragma unroll
        for (int ai = 0; ai < 2; ++ai)
#pragma unroll
            for (int m = 0; m < 4; ++m) { bf16_t* rowp = am + (size_t)(rowb + ai * 128 + m * 16) * 2048 + 1024 + col0;
#pragma unroll
                for (int bj = 0; bj < 2; ++bj) *(u32x4*)(rowp + bj * 128) = pack8(acc[ai][bj][m][0] * sv[bj][0], acc[ai][bj][m][1] * sv[bj][1]); }
    }
};

struct Epi5 {
    static constexpr bool CHAIN = true;
    const bf16_t* gates; bf16_t* merged;
    DI void operator()(AccT& acc, const Unit& u, int wr, int wc, int fr, int fq, LAS unsigned char*) const {
        const int col0 = u.pn * 256 + wc * 32 + fq * 8; const int rowb = u.pm * 256 + wr * 64 + fr;
#pragma unroll
        for (int ai = 0; ai < 2; ++ai)
#pragma unroll
            for (int m = 0; m < 4; ++m) { const size_t row = (size_t)(rowb + ai * 128 + m * 16);
#pragma unroll
                for (int bj = 0; bj < 2; ++bj) {
                    if (u.aux == 0) {
                        float gr[8]; unpack8(*(const u32x4*)(gates + row * 4096 + col0 + bj * 128), gr);
#pragma unroll
                        for (int i = 0; i < 4; ++i) { acc[ai][bj][m][0][i] *= gr[i]; acc[ai][bj][m][1][i] *= gr[4 + i]; }
                    } else {
                        float gp[8]; unpack8(*(const u32x4*)(gates + row * 4096 + 2048 + col0 + bj * 128), gp);
                        f32x4 v0, v1;
#pragma unroll
                        for (int i = 0; i < 4; ++i) { v0[i] = acc[ai][bj][m][0][i] * gp[i]; v1[i] = acc[ai][bj][m][1][i] * gp[4 + i]; }
                        *(u32x4*)(merged + row * 2048 + col0 + bj * 128) = pack8(v0, v1);
                    }
                } }
    }
};

struct Epi6 {
    static constexpr bool CHAIN = false;
    const float* x; float* out; bf16_t* xg; const float* modf; const float* nfg; float* rowss;
    DI void operator()(AccT& acc, const Unit& u, int wr, int wc, int fr, int fq, LAS unsigned char*) const {
        const int col0 = u.pn * 256 + wc * 32 + fq * 8; const int rowb = u.pm * 256 + wr * 64 + fr;
        f32x4 g1v[2][2], gmv[2][2];
#pragma unroll
        for (int bj = 0; bj < 2; ++bj)
#pragma unroll
            for (int n = 0; n < 2; ++n) { const int c = col0 + bj * 128 + 4 * n; g1v[bj][n] = *(const f32x4*)(modf + 2 * 2048 + c);
                gmv[bj][n] = *(const f32x4*)(nfg + c) * (*(const f32x4*)(modf + 4 * 2048 + c) + 1.0f); }
#pragma unroll
        for (int ai = 0; ai < 2; ++ai)
#pragma unroll
            for (int m = 0; m < 4; ++m) { const size_t row = (size_t)(rowb + ai * 128 + m * 16); float ss = 0.f;
#pragma unroll
                for (int bj = 0; bj < 2; ++bj) { const size_t off = row * 2048 + col0 + bj * 128;
                    const f32x4 x0 = *(const f32x4*)(x + off), x1 = *(const f32x4*)(x + off + 4);
                    const f32x4 y0 = x0 + g1v[bj][0] * acc[ai][bj][m][0], y1 = x1 + g1v[bj][1] * acc[ai][bj][m][1];
                    *(f32x4*)(out + off) = y0; *(f32x4*)(out + off + 4) = y1;
                    *(u32x4*)(xg + off) = pack8(y0 * gmv[bj][0], y1 * gmv[bj][1]);
                    ss += (y0[0] * y0[0] + y0[1] * y0[1]) + (y0[2] * y0[2] + y0[3] * y0[3]) + (y1[0] * y1[0] + y1[1] * y1[1]) + (y1[2] * y1[2] + y1[3] * y1[3]); }
                ss += __shfl_xor(ss, 16); ss += __shfl_xor(ss, 32);
                if (fq == 0) rowss[row * 32 + u.pn * 4 + wc] = ss; }
    }
};

struct Epi7 {
    static constexpr bool CHAIN = false;
    DI bool uses_lds(const Unit&) const { return true; }
    const float* rsb; const float* biasup; const float* cw; const float* cb; bf16_t* act; float* edge;
    DI void drain(AccT& acc, const Unit& u, int wr, int wc, int fr, int fq, LAS unsigned char* lds, int tid) const {
        LAS float* T = (LAS float*)lds;
        const int cgi = tid & 15, rg = tid >> 4;
        const int lcb = u.pn * 128;
#pragma unroll
        for (int ai = 0; ai < 2; ++ai) {
            {
                float rs[4];
#pragma unroll
                for (int m = 0; m < 4; ++m) rs[m] = rsb[u.pm * 256 + ai * 128 + 64 * wr + 16 * m + fr];
#pragma unroll
                for (int bj = 0; bj < 2; ++bj)
#pragma unroll
                    for (int n = 0; n < 2; ++n) { const f32x4 bi = *(const f32x4*)(biasup + u.pn * 256 + 128 * bj + 32 * wc + 8 * fq + 4 * n);
#pragma unroll
                        for (int m = 0; m < 4; ++m) *(LAS f32x4*)(T + (2 + 64 * wr + 16 * m + fr) * PT + 128 * bj + 32 * wc + 8 * fq + 4 * n) = acc[ai][bj][m][n] * rs[m] + bi; }
            }
            RAW_BAR();
            {
                const int cg8 = (tid >> 1) & 15, h4 = tid & 1, rgi = tid >> 5;
                const int cc = 8 * cg8 + 4 * h4, lca = lcb + cc, lcbb = DFF + lcb + cc;
                const f32x4 wa0 = *(const f32x4*)(cw + lca), wa1 = *(const f32x4*)(cw + NUP + lca), wa2 = *(const f32x4*)(cw + 2 * NUP + lca), ca0 = *(const f32x4*)(cb + lca);
                const f32x4 wb0 = *(const f32x4*)(cw + lcbb), wb1 = *(const f32x4*)(cw + NUP + lcbb), wb2 = *(const f32x4*)(cw + 2 * NUP + lcbb), cb0 = *(const f32x4*)(cb + lcbb);
#pragma unroll 1
                for (int ch = 0; ch < 2; ++ch) {
                    const int r0 = 8 * rgi + 4 * ch;
                    f32x4 xa[6], xb[6];
#pragma unroll
                    for (int kx = 0; kx < 6; ++kx) { xa[kx] = *(const LAS f32x4*)(T + (r0 + kx) * PT + cc); xb[kx] = *(const LAS f32x4*)(T + (r0 + kx) * PT + 128 + cc); }
                    u32x2 pw[4];
#pragma unroll
                    for (int kx = 0; kx < 4; ++kx) { const f32x4 av = ca0 + wa0 * xa[kx] + wa1 * xa[kx + 1] + wa2 * xa[kx + 2], bv = cb0 + wb0 * xb[kx] + wb1 * xb[kx + 1] + wb2 * xb[kx + 2];
                        float rv[4];
#pragma unroll
                        for (int i = 0; i < 4; ++i) rv[i] = av[i] * sigmoidf_(av[i]) * bv[i];
                        pw[kx].x = pk2(rv[0], rv[1]); pw[kx].y = pk2(rv[2], rv[3]); }
                    const u32x2 s0 = h4 ? pw[0] : pw[2], s1 = h4 ? pw[1] : pw[3];
                    u32x2 g0, g1; g0.x = __shfl_xor(s0.x, 1); g0.y = __shfl_xor(s0.y, 1); g1.x = __shfl_xor(s1.x, 1); g1.y = __shfl_xor(s1.y, 1);
                    const u32x2 m0 = h4 ? pw[2] : pw[0], m1 = h4 ? pw[3] : pw[1];
                    const u32x4 o0 = h4 ? (u32x4){g0.x, g0.y, m0.x, m0.y} : (u32x4){m0.x, m0.y, g0.x, g0.y};
                    const u32x4 o1 = h4 ? (u32x4){g1.x, g1.y, m1.x, m1.y} : (u32x4){m1.x, m1.y, g1.x, g1.y};
                    if (!(ai == 0 && rgi == 0 && ch == 0 && h4 == 0)) {
                        const size_t row = (size_t)(u.pm * 256 + ai * 128 + r0 + 2 * h4);
                        *(u32x4*)(act + row * DFF + lcb + 8 * cg8) = o0; *(u32x4*)(act + (row + 1) * DFF + lcb + 8 * cg8) = o1; }
                }
            }
            if (tid < 128) { const int sel = tid >> 6, col4 = (tid & 63) * 4; const int lc = (col4 < 128) ? (lcb + col4) : (DFF + lcb + col4 - 128);
                const f32x4 ev = *(const LAS f32x4*)(T + ((ai == 0 ? 2 : 128) + sel) * PT + col4);
                *(f32x4*)(edge + ((size_t)(u.pm * 4 + 2 * ai + sel)) * NUP + lc) = ev; }
            RAW_BAR();
            if (ai == 0) { if (tid < 128) { const int sel = tid >> 6, col4 = (tid & 63) * 4; *(LAS f32x4*)(T + sel * PT + col4) = *(const LAS f32x4*)(T + (128 + sel) * PT + col4); }
                RAW_BAR(); }
        }
    }
};

struct Epi9 {
    static constexpr bool CHAIN = false;
    float* out; const float* modf;
    DI void operator()(AccT& acc, const Unit& u, int wr, int wc, int fr, int fq, LAS unsigned char*) const {
        const int col0 = u.pn * 256 + wc * 32 + fq * 8; const int rowb = u.pm * 256 + wr * 64 + fr;
        f32x4 g2v[2][2];
#pragma unroll
        for (int bj = 0; bj < 2; ++bj)
#pragma unroll
            for (int n = 0; n < 2; ++n) g2v[bj][n] = *(const f32x4*)(modf + 5 * 2048 + col0 + bj * 128 + 4 * n);
#pragma unroll
        for (int ai = 0; ai < 2; ++ai)
#pragma unroll
            for (int m = 0; m < 4; ++m) { const size_t row = (size_t)(rowb + ai * 128 + m * 16);
#pragma unroll
                for (int bj = 0; bj < 2; ++bj) { const size_t off = row * 2048 + col0 + bj * 128;
                    const f32x4 x0 = *(const f32x4*)(out + off), x1 = *(const f32x4*)(out + off + 4);
                    *(f32x4*)(out + off) = x0 + g2v[bj][0] * acc[ai][bj][m][0]; *(f32x4*)(out + off + 4) = x1 + g2v[bj][1] * acc[ai][bj][m][1]; } }
    }
};

DI int dest_row(int mode, int n) {
    if (mode == 1) { if (n >= 2048) return n; const int d = n & 127; return (n & ~127) + 32 * ((d >> 4) & 3) + 8 * ((d >> 2) & 3) + 4 * (d >> 6) + (d & 3); }
    if (mode == 2) { const int bj = n >= DFF ? 1 : 0, cc = n - bj * DFF; return 256 * (cc >> 7) + 128 * bj + (cc & 127); }
    if (mode == 3) { const int bj = n >= 2048 ? 1 : 0, cc = n - bj * 2048; return 256 * (cc >> 7) + 128 * bj + (cc & 127); }
    return n;
}
DI void transpose_item(const float* W, int N, bf16_t* WT, int ldd, int koff, int row_off, int mode, LAS float* scr, int item, int lane) {
    const int nblk = N / 64, kb = item / nblk, nb = item % nblk, k0 = 64 * kb, n0 = 64 * nb;
    const int kr = lane >> 4, n4 = (lane & 15) * 4;
    f32x4 v[16];
#pragma unroll
    for (int i = 0; i < 16; ++i) v[i] = __builtin_nontemporal_load((const f32x4*)(W + (size_t)(k0 + 4 * i + kr) * N + n0 + n4));
#pragma unroll
    for (int i = 0; i < 16; ++i) { LAS float* d = scr + (4 * i + kr) * 65 + n4; d[0] = v[i][0]; d[1] = v[i][1]; d[2] = v[i][2]; d[3] = v[i][3]; }
    LDS_WAIT(); asm volatile("" ::: "memory");
    const int c = lane & 7;
#pragma unroll
    for (int j = 0; j < 8; ++j) { const int n = (lane >> 3) + 8 * j; const LAS float* sp = scr + (8 * c) * 65 + n;
        u32x4 o; o.x = pk2(sp[0 * 65], sp[1 * 65]); o.y = pk2(sp[2 * 65], sp[3 * 65]); o.z = pk2(sp[4 * 65], sp[5 * 65]); o.w = pk2(sp[6 * 65], sp[7 * 65]);
        *(u32x4*)(WT + (size_t)(row_off + dest_row(mode, n0 + n)) * ldd + koff + k0 + 8 * c) = o; }
    LDS_WAIT(); asm volatile("" ::: "memory");
}

DI s16x4 vtr(const LAS unsigned char* p) { typedef short v4i16_t __attribute__((ext_vector_type(4))); return __builtin_bit_cast(s16x4, __builtin_amdgcn_ds_read_tr16_b64_v4i16((LAS v4i16_t*)p)); }
constexpr int KV_PITCH = 272;
constexpr int LDS_KS = 0, LDS_VS = 256 * KV_PITCH, LDS_TAB = 2 * 256 * KV_PITCH;


#define XB_TMO      128
#define XB_XCNT(j)  (256  + 64 * (j))
#define XB_XSUB(j)  (1280 + 64 * (j))
#define XB_XGEN(j)  (2304 + 64 * (j))
#define XB_TOP      3328
#define XB_TOPGEN   3392
#define XCD_BAR_WORDS 3456
#define XB_SPIN_CAP (1u << 18)
DI unsigned xb_ld(unsigned* p)              { return __hip_atomic_load(p, __ATOMIC_RELAXED, __HIP_MEMORY_SCOPE_AGENT); }
DI unsigned xb_add(unsigned* p, unsigned v) { return __hip_atomic_fetch_add(p, v, __ATOMIC_RELAXED, __HIP_MEMORY_SCOPE_AGENT); }
DI unsigned xb_xcc_id() { return (unsigned)__builtin_amdgcn_s_getreg((3 << 11) | 20) & 0xFu; }
#define XB_SPIN(cond, bar) do { unsigned _sp = 0; while (cond) { __builtin_amdgcn_s_sleep(1); \
    if ((++_sp & 255u) == 0u) { if (xb_ld(&(bar)[XB_TMO])) break; if (_sp > XB_SPIN_CAP) { atomicAdd(&(bar)[XB_TMO], 1u); break; } } } } while (0)
struct XcdBarrier { unsigned* bar; unsigned x; volatile LAS unsigned* st; };
DI XcdBarrier xcd_barrier_post(unsigned* bar, volatile LAS unsigned* st) {
    XcdBarrier b; b.bar = bar; b.x = xb_xcc_id(); b.st = st;
    if (threadIdx.x == 0) (void)xb_add(&bar[XB_XCNT(b.x)], 1u);
    return b;
}
DI void xcd_barrier_complete(unsigned* bar, unsigned x, unsigned& nloc, unsigned& nx) {
    const unsigned G = gridDim.x * gridDim.y * gridDim.z;
    unsigned sum, cnt, mine, sp = 0u;
    for (;;) {
        sum = 0u; cnt = 0u; mine = 0u;
#pragma unroll
        for (unsigned j = 0; j < 16; ++j) { const unsigned c = xb_ld(&bar[XB_XCNT(j)]); sum += c; cnt += (c > 0u) ? 1u : 0u; mine = (j == x) ? c : mine; }
        if (sum == G) break;
        __builtin_amdgcn_s_sleep(1);
        if ((++sp & 255u) == 0u) { if (xb_ld(&bar[XB_TMO])) break; if (sp > XB_SPIN_CAP) { atomicAdd(&bar[XB_TMO], 1u); break; } }
    }
    nloc = mine > 0u ? mine : 1u; nx = cnt > 0u ? cnt : 1u;
}
DI void xcd_barrier(const XcdBarrier& b) {
    asm volatile("s_waitcnt vmcnt(0)" ::: "memory");
    __syncthreads();
    if (threadIdx.x == 0) {
        unsigned* bar = b.bar;
        __builtin_amdgcn_s_waitcnt(0);
        unsigned nloc = b.st[0], nx = b.st[1];
        if (nloc == 0u) { xcd_barrier_complete(bar, b.x, nloc, nx); b.st[0] = nloc; b.st[1] = nx; }
        const unsigned old = xb_add(&bar[XB_XSUB(b.x)], 1u);
        const unsigned gen = old / nloc;
        if (old + 1u == (gen + 1u) * nloc) {
            __builtin_amdgcn_fence(__ATOMIC_RELEASE, "agent");
            asm volatile("s_waitcnt vmcnt(0)" ::: "memory");
            const unsigned og = xb_add(&bar[XB_TOP], 1u);
            const unsigned tg = og / nx;
            if (og + 1u == (tg + 1u) * nx) xb_add(&bar[XB_TOPGEN], 1u);
            else XB_SPIN(xb_ld(&bar[XB_TOPGEN]) == tg, bar);
            __builtin_amdgcn_fence(__ATOMIC_ACQUIRE, "agent");
            xb_add(&bar[XB_XGEN(b.x)], 1u);
            asm volatile("s_waitcnt vmcnt(0)" ::: "memory");
        } else {
            XB_SPIN(xb_ld(&bar[XB_XGEN(b.x)]) == gen, bar);
            __builtin_amdgcn_fence(__ATOMIC_ACQUIRE, "agent");
            asm volatile("s_waitcnt vmcnt(0)" ::: "memory");
        }
    }
    __syncthreads();
}

#ifndef PHMASK
#define PHMASK 0xFFFF
#endif
struct Params {
    const float* in[20]; float* out; unsigned char* ws;
};

__global__ void __launch_bounds__(NTHR, 2) fwd_megakernel(Params p) {
    extern __shared__ __attribute__((aligned(16))) unsigned char lds_raw[];
    LAS unsigned char* lds = (LAS unsigned char*)lds_raw;
    cg::grid_group grid = cg::this_grid();
    int tid = threadIdx.x, lane = tid & 63; const int wave = __builtin_amdgcn_readfirstlane(tid >> 6);
#define RELOAD_IDS() do { tid = threadIdx.x; asm volatile("" : "+v"(tid)); lane = tid & 63; } while (0)
    const int G = gridDim.x, bx = blockIdx.x;
    const int vcu = (G % 8 == 0) ? (bx % 8) * (G / 8) + bx / 8 : bx;
    const int gw = vcu * NWAVES + wave, NGW = G * NWAVES;
    unsigned char* ws = p.ws;
    volatile LAS unsigned* xst = (volatile LAS unsigned*)(lds + LDS_BYTES - 16);
    if (threadIdx.x < 4) xst[threadIdx.x] = 0u;
    __syncthreads();
    XcdBarrier xbar; xbar.bar = (unsigned*)(ws + WS_BAR); xbar.x = 0; xbar.st = xst;
    if (blockIdx.x == 0) {
        for (int i = threadIdx.x; i < 512; i += NTHR) ((unsigned*)(ws + WS_CNT))[i] = 0u;
        for (int i = threadIdx.x; i < XCD_BAR_WORDS; i += NTHR) ((unsigned*)(ws + WS_BAR))[i] = 0u;
    }
#define xin (p.in[0])
#define cvec (p.in[1])
#define w_ada (p.in[2])
#define b_ada (p.in[3])
#define nmg (p.in[4])
#define w_in (p.in[5])
#define qng (p.in[6])
#define kng (p.in[7])
#define w_pgrp (p.in[8])
#define pscale (p.in[9])
#define w_abr (p.in[10])
#define w_pbr (p.in[11])
#define w_gate (p.in[12])
#define b_gate (p.in[13])
#define w_o (p.in[14])
#define nfg (p.in[15])
#define w_up (p.in[16])
#define conv_w (p.in[17])
#define conv_b (p.in[18])
#define w_down (p.in[19])
#define outp (p.out)
#define cnt ((unsigned*)(ws + WS_CNT))
#define kmean ((float*)(ws + WS_KMEAN))
#define modp ((float*)(ws + WS_MODP))
#define modf ((float*)(ws + WS_MODF))
#define biasup ((float*)(ws + WS_BIASUP))
#define rowss ((float*)(ws + WS_ROWSS))
#define lsum ((float*)(ws + WS_LSUM))
#define qlist ((unsigned*)(ws + WS_LIST))
#define W1t ((bf16_t*)(ws + WS_W1))
#define Wyt ((bf16_t*)(ws + WS_WY))
#define Wot ((bf16_t*)(ws + WS_WO))
#define Wgt ((bf16_t*)(ws + WS_WG))
#define Wdt ((bf16_t*)(ws + WS_WD))
#define Wut ((bf16_t*)(ws + WS_WU))
#define hbuf ((bf16_t*)(ws + WS_HB))
#define qb ((bf16_t*)(ws + WS_Q))
#define kb ((bf16_t*)(ws + WS_K))
#define vb ((bf16_t*)(ws + WS_V))
#define ub ((bf16_t*)(ws + WS_U))
#define gates ((bf16_t*)(ws + WS_GATES))
#define dbuf ((bf16_t*)(ws + WS_DB))
#define am ((bf16_t*)(ws + WS_AM))
#define merged ((bf16_t*)(ws + WS_MERGED))
#define xg ((bf16_t*)(ws + WS_XG))
#define act ((bf16_t*)(ws + WS_ACT))
#define edge ((float*)(ws + WS_EDGE))
#define slots ((bf16_t*)p.out)
#define rsb ((float*)(ws + WS_LSUM))
#if PHMASK & 1
    {
        LAS float* scr = (LAS float*)(lds + wave * 16640);
        constexpr int I_IN = 32 * 64, I_GT = 32 * 64, I_AB = 16 * 32, I_PB = 16 * 32, I_O = 32 * 32, I_UP = 32 * 176, I_DN = 88 * 32, I_G = 4 * 4;
        constexpr int NIT = I_IN + I_GT + I_AB + I_PB + I_O + I_UP + I_DN + 4 * I_G;
        for (int it = gw; it < NIT; it += NGW) {
            int r = it;
            if (r < I_UP) { transpose_item(w_up, NUP, Wut, 2048, 0, 0, 2, scr, r, lane); continue; } r -= I_UP;
            if (r < I_DN) { transpose_item(w_down, 2048, Wdt, DFF, 0, 0, 0, scr, r, lane); continue; } r -= I_DN;
            if (r < I_IN) { transpose_item(w_in, 4096, W1t, 2048, 0, 0, 0, scr, r, lane); continue; } r -= I_IN;
            if (r < I_GT) { transpose_item(w_gate, 4096, W1t, 2048, 0, 4096, 3, scr, r, lane); continue; } r -= I_GT;
            if (r < I_AB) { transpose_item(w_abr, 2048, Wyt, 2048, 0, 0, 0, scr, r, lane); continue; } r -= I_AB;
            if (r < I_PB) { transpose_item(w_pbr, 2048, Wyt, 2048, 1024, 0, 0, scr, r, lane); continue; } r -= I_PB;
            if (r < I_O) { transpose_item(w_o, 2048, Wot, 2048, 0, 0, 0, scr, r, lane); continue; } r -= I_O;
            { const int gI = r / I_G; transpose_item(w_pgrp + (size_t)gI * 65536, 256, Wgt, 1024, 0, gI * 256, 0, scr, r % I_G, lane); }
        }
        for (int it = gw; it < 768; it += NGW) {
            const int kc = it / 48, cgi = it % 48; const int col = cgi * 256 + lane * 4;
            f32x4 a = (f32x4){0.f, 0.f, 0.f, 0.f};
#pragma unroll 8
            for (int kk = 0; kk < 128; ++kk) { const int kx = kc * 128 + kk; const float cv = cvec[kx]; const float sv = cv * sigmoidf_(cv);
                a += __builtin_nontemporal_load((const f32x4*)(w_ada + (size_t)kx * 12288 + col)) * sv; }
            *(f32x4*)(modp + (size_t)kc * 12288 + col) = a;
        }
    }
    grid.sync();
    xbar = xcd_barrier_post((unsigned*)(ws + WS_BAR), xst);
    RELOAD_IDS();

#endif
#if PHMASK & 2
    {
        LAS float* sh1 = (LAS float*)lds; LAS float* gm1 = sh1 + 2048;
        for (int e = tid; e < 4096; e += NTHR) { float s = b_ada[e];
#pragma unroll
            for (int kc = 0; kc < 16; ++kc) s += modp[(size_t)kc * 12288 + e];
            if (e < 2048) sh1[e] = s; else gm1[e - 2048] = nmg[e - 2048] * (1.0f + s); }
        if (tid < 48) { const int e = bx * 48 + tid; if (e < 12288 && bx < 256) { float s = b_ada[e];
#pragma unroll
            for (int kc = 0; kc < 16; ++kc) s += modp[(size_t)kc * 12288 + e];
            modf[e] = s; } }
        if (G < 256 && bx == 0) { for (int e = G * 48 + tid; e < 12288; e += NTHR) { float s = b_ada[e]; for (int kc = 0; kc < 16; ++kc) s += modp[(size_t)kc * 12288 + e]; modf[e] = s; } }
        __syncthreads();
        for (int m = gw; m < S; m += NGW) {
            const f32x4* xr = (const f32x4*)(xin + (size_t)m * DM) + lane;
            f32x4 v[8]; float ss = 0.f;
#pragma unroll
            for (int j = 0; j < 8; ++j) { v[j] = xr[64 * j]; ss += (v[j][0] * v[j][0] + v[j][1] * v[j][1]) + (v[j][2] * v[j][2] + v[j][3] * v[j][3]); }
            const float r = __builtin_amdgcn_rsqf(wave_sum(ss) * (1.0f / DM) + EPS);
            u32x2* o8 = (u32x2*)(hbuf + (size_t)m * DM) + lane;
#pragma unroll
            for (int j = 0; j < 8; ++j) { const int c = 4 * lane + 256 * j; const f32x4 gmv = *(const LAS f32x4*)(gm1 + c), shv = *(const LAS f32x4*)(sh1 + c);
                const f32x4 hval = v[j] * r * gmv + shv; u32x2 w; w.x = pk2(hval[0], hval[1]); w.y = pk2(hval[2], hval[3]); o8[64 * j] = w; }
        }
    }
    xcd_barrier(xbar);
    RELOAD_IDS();

#endif
#if PHMASK & 4
    {
        pg8::Gemm g{hbuf, W1t, 2048, 2048, 2048}; pg8::Sched<0> Sc; Sc.init(S, N1, G, bx);
        Epi1 E{qb, kb, vb, ub, gates, kmean, qng, kng, b_gate};
        pg8::gemm_phase_drain<Epi1>(lds, g, Sc, E);
    }
    xcd_barrier(xbar);
    RELOAD_IDS();

#endif
#if PHMASK & 8
    {
        LAS unsigned char* kmb = lds;
        LAS unsigned* hist = (LAS unsigned*)(lds + 32768); LAS unsigned* basep = hist + 64;
        for (int base = bx * 8; base < 2048; base += G * 8) {
            const int h = base >> 8;
            __syncthreads();
            { const int jr = tid >> 3, c0 = (tid & 7) * 16; const f32x4* src = (const f32x4*)(kmean + (size_t)h * 8192 + jr * 128 + c0);
              const f32x4 k0 = src[0], k1 = src[1], k2 = src[2], k3 = src[3];
              *(LAS u32x4*)(kmb + jr * KV_PITCH + c0 * 2) = pack8(k0, k1); *(LAS u32x4*)(kmb + jr * KV_PITCH + c0 * 2 + 16) = pack8(k2, k3); }
            if (tid < 64) hist[tid] = 0u;
            __syncthreads();
            const int item = base + wave, qgi = item & 255, own = qgi >> 2, ns = own < 3 ? own : 3;
            const int r32 = lane & 31, hh = lane >> 5;
            int selj[2][3]; unsigned selp[2][3];
#pragma unroll
            for (int sub = 0; sub < 2; ++sub) {
                const int qi = qgi * 64 + sub * 32 + r32;
                const bf16_t* qp = qb + (size_t)qi * 1024 + h * 128 + 8 * hh;
                f32x16 ac[2];
#pragma unroll
                for (int jt = 0; jt < 2; ++jt)
#pragma unroll
                    for (int i = 0; i < 16; ++i) ac[jt][i] = 0.f;
#pragma unroll
                for (int ks = 0; ks < 8; ++ks) { const bf16x8 qf = *(const bf16x8*)(qp + 16 * ks);
#pragma unroll
                    for (int jt = 0; jt < 2; ++jt) { const bf16x8 kf = *(const LAS bf16x8*)(kmb + (32 * jt + r32) * KV_PITCH + 32 * ks + 16 * hh);
                        ac[jt] = __builtin_amdgcn_mfma_f32_32x32x16_bf16(kf, qf, ac[jt], 0, 0, 0); } }
                float b0 = -3.0e38f, b1 = -3.0e38f, b2 = -3.0e38f; int i0 = 255, i1 = 255, i2 = 255;
#pragma unroll
                for (int jt = 0; jt < 2; ++jt)
#pragma unroll
                    for (int i = 0; i < 16; ++i) { const int j = 32 * jt + (i & 3) + 8 * (i >> 2) + 4 * hh; const float vj = (j < own) ? ac[jt][i] : -3.0e38f;
                        if (vj > b0) { b2 = b1; i2 = i1; b1 = b0; i1 = i0; b0 = vj; i0 = j; }
                        else if (vj > b1) { b2 = b1; i2 = i1; b1 = vj; i1 = j; }
                        else if (vj > b2) { b2 = vj; i2 = j; } }
                const float p0 = __shfl_xor(b0, 32), p1 = __shfl_xor(b1, 32), p2 = __shfl_xor(b2, 32);
                const int q0 = __shfl_xor(i0, 32), q1 = __shfl_xor(i1, 32), q2 = __shfl_xor(i2, 32);
#pragma unroll
                for (int t = 0; t < 3; ++t) { const float vj = t == 0 ? p0 : (t == 1 ? p1 : p2); const int j = t == 0 ? q0 : (t == 1 ? q1 : q2);
                    if (vj > b0 || (vj == b0 && j < i0)) { b2 = b1; i2 = i1; b1 = b0; i1 = i0; b0 = vj; i0 = j; }
                    else if (vj > b1 || (vj == b1 && j < i1)) { b2 = b1; i2 = i1; b1 = vj; i1 = j; }
                    else if (vj > b2 || (vj == b2 && j < i2)) { b2 = vj; i2 = j; } }
                selj[sub][0] = i0; selj[sub][1] = i1; selj[sub][2] = i2;
#pragma unroll
                for (int t = 0; t < 3; ++t) selp[sub][t] = (hh == 0 && t < ns) ? __hip_atomic_fetch_add((unsigned*)(hist + selj[sub][t]), 1u, __ATOMIC_RELAXED, __HIP_MEMORY_SCOPE_WORKGROUP) : 0u;
            }
            __syncthreads();
            if (tid < 64) { const unsigned c = hist[tid]; basep[tid] = c ? atomicAdd(cnt + h * 64 + tid, c) : 0u; }
            __syncthreads();
            if (hh == 0) {
#pragma unroll
                for (int sub = 0; sub < 2; ++sub)
#pragma unroll
                    for (int t = 0; t < 3; ++t) if (t < ns) { const int j = selj[sub][t]; const unsigned qi = (unsigned)(qgi * 64 + sub * 32 + r32);
                        qlist[(size_t)(h * 64 + j) * 16384 + basep[j] + selp[sub][t]] = qi * 4u + (unsigned)t; }
            }
        }
        for (int idx = vcu * NTHR + tid; idx < 2048 * 128; idx += G * NTHR) {
            const int cgi = idx & 127, rc = idx >> 7, w = 2 << (cgi >> 5), t0 = rc * 8;
            const bf16_t* up = ub + cgi * 8;
            float sum[8];
#pragma unroll
            for (int i = 0; i < 8; ++i) sum[i] = 0.f;
            for (int i = 1; i <= w; ++i) { const int t = t0 - i; if (t >= 0) { float f[8]; unpack8(*(const u32x4*)(up + (size_t)t * 1024), f);
#pragma unroll
                for (int e = 0; e < 8; ++e) sum[e] += f[e]; } }
#pragma unroll
            for (int t = t0; t < t0 + 8; ++t) {
                float f[8]; unpack8(*(const u32x4*)(up + (size_t)t * 1024), f);
#pragma unroll
                for (int e = 0; e < 8; ++e) sum[e] += f[e];
                if (t - w >= 0) { float o[8]; unpack8(*(const u32x4*)(up + (size_t)(t - w) * 1024), o);
#pragma unroll
                    for (int e = 0; e < 8; ++e) sum[e] -= o[e]; }
                const float inv = 1.0f / (float)((t + 1) < w ? (t + 1) : w);
                u32x4 o4; o4.x = pk2(sum[0] * inv - f[0], sum[1] * inv - f[1]); o4.y = pk2(sum[2] * inv - f[2], sum[3] * inv - f[3]);
                o4.z = pk2(sum[4] * inv - f[4], sum[5] * inv - f[5]); o4.w = pk2(sum[6] * inv - f[6], sum[7] * inv - f[7]);
                *(u32x4*)(dbuf + (size_t)t * 1024 + cgi * 8) = o4;
            }
        }
        for (int rho = gw; rho < NUP; rho += NGW) {
            float s = 0.f;
#pragma unroll
            for (int j = 0; j < 4; ++j) { const int k0 = j * 512 + lane * 8; float f[8]; unpack8(*(const u32x4*)(Wut + (size_t)rho * 2048 + k0), f);
                const f32x4 s0 = *(const f32x4*)(modf + 3 * 2048 + k0), s1 = *(const f32x4*)(modf + 3 * 2048 + k0 + 4);
                s += (f[0] * s0[0] + f[1] * s0[1]) + (f[2] * s0[2] + f[3] * s0[3]) + (f[4] * s1[0] + f[5] * s1[1]) + (f[6] * s1[2] + f[7] * s1[3]); }
            s = wave_sum(s);
            if (lane == 0) biasup[rho] = s;
        }
    }
    xcd_barrier(xbar);
    RELOAD_IDS();

#endif
#if PHMASK & 16
    {
        RELOAD_IDS();
        __syncthreads();
        LAS int* pre = (LAS int*)(lds + LDS_TAB); LAS int* tmp = pre + 520;
        { const int n = 1 + (int)((cnt[tid] + 255u) >> 8); tmp[tid] = n; __syncthreads();
          for (int o = 1; o < 512; o <<= 1) { const int v = tmp[tid] + (tid >= o ? tmp[tid - o] : 0); __syncthreads(); tmp[tid] = v; __syncthreads(); }
          pre[tid + 1] = tmp[tid]; if (tid == 0) pre[0] = 0; __syncthreads(); }
        const int total = pre[512];
        int lane_ = lane; asm volatile("" : "+v"(lane_));
        const int r32 = lane_ & 31, hh = lane_ >> 5, i16 = lane_ & 15, qq = i16 >> 2, pp = i16 & 3, blk = (lane_ >> 4) & 1;
#define ATT_DECODE(UN, HJ, LI) do { int lo_ = 0, hi_ = 511; while (lo_ < hi_) { const int mid_ = (lo_ + hi_ + 1) >> 1; if (pre[mid_] <= (UN)) lo_ = mid_; else hi_ = mid_ - 1; } HJ = lo_; LI = (UN) - pre[lo_]; } while (0)
#define ATT_KVLOAD(HJ) do { const int h_ = (HJ) >> 6, j_ = (HJ) & 63; const bf16_t* kg = kb + (size_t)(j_ * 256) * 1024 + h_ * 128; const bf16_t* vg = vb + (size_t)(j_ * 256) * 1024 + h_ * 128; \
        _Pragma("unroll") for (int i = 0; i < 8; ++i) { const int idx = tid + NTHR * i, row = idx >> 4, c16 = idx & 15; \
            kreg[i] = *(const u32x4*)(kg + (size_t)row * 1024 + c16 * 8); vreg[i] = *(const u32x4*)(vg + (size_t)row * 1024 + c16 * 8); } } while (0)
#define ATT_ENT(HJ, LI, ENT, NL) do { NL = ((LI) == 0) ? 256 : (int)cnt[HJ] - ((LI) - 1) * 256; const int e_ = wave * 32 + r32; \
        if ((LI) == 0) ENT = (unsigned)(((HJ) & 63) * 256 + e_) * 4u + 3u; else ENT = qlist[(size_t)(HJ) * 16384 + (size_t)((LI) - 1) * 256 + (e_ < NL ? e_ : 0)]; } while (0)
        u32x4 kreg[8], vreg[8];
        int fillb = (tid >> 4) * KV_PITCH + (tid & 15) * 16; asm volatile("" : "+v"(fillb));
        int hj = 0, li = 0, nlist = 0; unsigned ent = 0u;
        if (bx < total) { ATT_DECODE(bx, hj, li); ATT_KVLOAD(hj); ATT_ENT(hj, li, ent, nlist); }
        for (int un = bx; un < total; un += G) {
            const int h = hj >> 6, j = hj & 63;
            const bool ownu = (li == 0);
            const int e = wave * 32 + r32;
            const bool valid = e < nlist;
            const int qi = (int)(ent >> 2), slot = (int)(ent & 3u);
            const bf16_t* qp = qb + (size_t)qi * 1024 + h * 128 + 8 * hh;
            bf16x8 qf[8];
#pragma unroll
            for (int ks = 0; ks < 8; ++ks) qf[ks] = *(const bf16x8*)(qp + 16 * ks);
            __syncthreads();
#pragma unroll
            for (int i = 0; i < 8; ++i) {
                *(LAS u32x4*)(lds + LDS_KS + fillb + i * (32 * KV_PITCH)) = kreg[i]; *(LAS u32x4*)(lds + LDS_VS + fillb + i * (32 * KV_PITCH)) = vreg[i]; }
            __syncthreads();
            int hj2, li2, nlist2; unsigned ent2;
            { const int unn = (un + G < total) ? un + G : un; ATT_DECODE(unn, hj2, li2); ATT_KVLOAD(hj2); ATT_ENT(hj2, li2, ent2, nlist2); }
            if (wave * 32 < nlist) {
                const int nq = ownu ? ((wave * 32 + 31) >> 6) + 1 : 4;
                f32x16 o[4];
#pragma unroll
                for (int dt = 0; dt < 4; ++dt)
#pragma unroll
                    for (int i = 0; i < 16; ++i) o[dt][i] = 0.f;
                float lacc = 0.f;
                const int qloc = e;
#pragma unroll 1
                for (int hf = 0; hf < nq; ++hf) {
                    f32x16 sa[2];
#pragma unroll
                    for (int i = 0; i < 16; ++i) { sa[0][i] = 0.f; sa[1][i] = 0.f; }
                    {
                        const LAS unsigned char* kp0 = lds + LDS_KS + (64 * hf + r32) * KV_PITCH + 16 * hh;
                        const LAS unsigned char* kp1 = kp0 + 32 * KV_PITCH;
                        bf16x8 a0 = *(const LAS bf16x8*)kp0, a1 = *(const LAS bf16x8*)kp1;
#pragma unroll
                        for (int ks = 0; ks < 8; ++ks) {
                            bf16x8 n0 = a0, n1 = a1;
                            if (ks < 7) { n0 = *(const LAS bf16x8*)(kp0 + 32 * (ks + 1)); n1 = *(const LAS bf16x8*)(kp1 + 32 * (ks + 1)); }
                            sa[0] = __builtin_amdgcn_mfma_f32_32x32x16_bf16(a0, qf[ks], sa[0], 0, 0, 0);
                            sa[1] = __builtin_amdgcn_mfma_f32_32x32x16_bf16(a1, qf[ks], sa[1], 0, 0, 0);
                            a0 = n0; a1 = n1;
                        }
                    }
                    if (ownu) {
#pragma unroll
                        for (int kt = 0; kt < 2; ++kt)
#pragma unroll
                            for (int i = 0; i < 16; ++i) { const int key = 64 * hf + 32 * kt + (i & 3) + 8 * (i >> 2) + 4 * hh;
                                float pv = __builtin_amdgcn_exp2f(sa[kt][i]); if (key > qloc) pv = 0.f; sa[kt][i] = pv; lacc += pv; }
                    } else {
#pragma unroll
                        for (int kt = 0; kt < 2; ++kt)
#pragma unroll
                            for (int i = 0; i < 16; ++i) { const float pv = __builtin_amdgcn_exp2f(sa[kt][i]); sa[kt][i] = pv; lacc += pv; }
                    }
                    bf16x8 pb[4];
#pragma unroll
                    for (int st = 0; st < 4; ++st) { const int kt = st >> 1, s2 = st & 1;
                        u32x4 pw; pw.x = pk2(sa[kt][8 * s2 + 0], sa[kt][8 * s2 + 1]); pw.y = pk2(sa[kt][8 * s2 + 2], sa[kt][8 * s2 + 3]);
                        pw.z = pk2(sa[kt][8 * s2 + 4], sa[kt][8 * s2 + 5]); pw.w = pk2(sa[kt][8 * s2 + 6], sa[kt][8 * s2 + 7]);
                        pb[st] = __builtin_bit_cast(bf16x8, pw); }
                    const LAS unsigned char* vp = lds + LDS_VS + (64 * hf + 4 * hh + qq) * KV_PITCH + 32 * blk + 8 * pp;
                    s16x4 cl[4], ch[4];
#pragma unroll
                    for (int dt = 0; dt < 4; ++dt) { cl[dt] = vtr(vp + 64 * dt); ch[dt] = vtr(vp + 8 * KV_PITCH + 64 * dt); }
#pragma unroll
                    for (int st = 0; st < 4; ++st) {
                        s16x4 nl[4], nh[4];
#pragma unroll
                        for (int dt = 0; dt < 4; ++dt) { nl[dt] = cl[dt]; nh[dt] = ch[dt]; }
                        if (st < 3) { const LAS unsigned char* vn = vp + 16 * (st + 1) * KV_PITCH;
#pragma unroll
                            for (int dt = 0; dt < 4; ++dt) { nl[dt] = vtr(vn + 64 * dt); nh[dt] = vtr(vn + 8 * KV_PITCH + 64 * dt); } }
#pragma unroll
                        for (int dt = 0; dt < 4; ++dt) { const bf16x8 vf = __builtin_shufflevector(cl[dt], ch[dt], 0, 1, 2, 3, 4, 5, 6, 7);
                            o[dt] = __builtin_amdgcn_mfma_f32_32x32x16_bf16(vf, pb[st], o[dt], 0, 0, 0); }
#pragma unroll
                        for (int dt = 0; dt < 4; ++dt) { cl[dt] = nl[dt]; ch[dt] = nh[dt]; }
                    }
                }
                lacc += __shfl_xor(lacc, 32);
                u32x4 ow[8];
#pragma unroll
                for (int dt = 0; dt < 4; ++dt)
#pragma unroll
                    for (int gp2 = 0; gp2 < 2; ++gp2) { const int g0 = 2 * gp2, g1 = g0 + 1;
                        unsigned ax = pk2(o[dt][4 * g0], o[dt][4 * g0 + 1]), ay = pk2(o[dt][4 * g0 + 2], o[dt][4 * g0 + 3]);
                        unsigned bxw = pk2(o[dt][4 * g1], o[dt][4 * g1 + 1]), by = pk2(o[dt][4 * g1 + 2], o[dt][4 * g1 + 3]);
                        { const auto rsw = __builtin_amdgcn_permlane32_swap(ax, bxw, false, false); ax = rsw[0]; bxw = rsw[1]; }
                        { const auto rsw = __builtin_amdgcn_permlane32_swap(ay, by, false, false); ay = rsw[0]; by = rsw[1]; }
                        ow[dt * 2 + gp2] = (u32x4){ax, ay, bxw, by}; }
                if (valid) {
                    bf16_t* op = slots + ((size_t)qi * 4 + slot) * 1024 + h * 128 + 8 * hh;
#pragma unroll
                    for (int dt = 0; dt < 4; ++dt)
#pragma unroll
                        for (int gp2 = 0; gp2 < 2; ++gp2) *(u32x4*)(op + 32 * dt + 16 * gp2) = ow[dt * 2 + gp2];
                    if (hh == 0) lsum[((size_t)qi * 4 + slot) * 8 + h] = lacc;
                }
            }
            hj = hj2; li = li2; ent = ent2; nlist = nlist2;
        }
        RELOAD_IDS();
        for (int base = vcu * 8; base < 2048; base += G * 8) {
            const int gI = base >> 9;
            __syncthreads();
#pragma unroll
            for (int i = 0; i < 16; ++i) { const int idx = tid + NTHR * i, row = idx >> 5, c16 = idx & 31;
                *(LAS u32x4*)(lds + row * 528 + c16 * 16) = *(const u32x4*)(Wgt + (size_t)(gI * 256 + row) * 1024 + c16 * 8); }
            __syncthreads();
            const int item = base + wave, s0 = (item & 511) * 32, r = lane & 31, hh = lane >> 5;
            bf16x8 af[16];
            const bf16_t* ap = dbuf + (size_t)(s0 + r) * 1024 + gI * 256 + 8 * hh;
#pragma unroll
            for (int ks = 0; ks < 16; ++ks) af[ks] = *(const bf16x8*)(ap + 16 * ks);
#pragma unroll 1
            for (int nt = 0; nt < 8; nt += 2) {
                f32x16 ac[2];
#pragma unroll
                for (int i = 0; i < 16; ++i) { ac[0][i] = 0.f; ac[1][i] = 0.f; }
                const LAS unsigned char* bp = lds + (nt * 32 + r) * 528 + 16 * hh;
#pragma unroll
                for (int ks = 0; ks < 16; ++ks) { const bf16x8 b0 = *(const LAS bf16x8*)(bp + 32 * ks), b1 = *(const LAS bf16x8*)(bp + 32 * 528 + 32 * ks);
                    ac[0] = __builtin_amdgcn_mfma_f32_32x32x16_bf16(b0, af[ks], ac[0], 0, 0, 0); ac[1] = __builtin_amdgcn_mfma_f32_32x32x16_bf16(b1, af[ks], ac[1], 0, 0, 0); }
#pragma unroll
                for (int t2 = 0; t2 < 2; ++t2) {
                    bf16_t* op = am + (size_t)(s0 + r) * 2048 + 1024 + gI * 256 + (nt + t2) * 32 + 4 * hh;
#pragma unroll
                    for (int q4 = 0; q4 < 4; ++q4) { const f32x4 lsv = *(const f32x4*)(pscale + gI * 256 + (nt + t2) * 32 + 8 * q4 + 4 * hh);
                        u32x2 w; w.x = pk2(ac[t2][4 * q4] * lsv[0], ac[t2][4 * q4 + 1] * lsv[1]); w.y = pk2(ac[t2][4 * q4 + 2] * lsv[2], ac[t2][4 * q4 + 3] * lsv[3]); *(u32x2*)(op + 8 * q4) = w; }
                }
            }
        }
    }
    xcd_barrier(xbar);
    RELOAD_IDS();

#endif
#if PHMASK & 32
    {
    }
    RELOAD_IDS();
#pragma unroll 2
    for (int idx = vcu * NTHR + tid; idx < S * 128; idx += G * NTHR) {
        const int qi = idx >> 7, c8 = idx & 127, h = c8 >> 4, own = qi >> 8, ns = own < 3 ? own : 3;
        float a[8]; float l = 0.f;
#pragma unroll
        for (int i = 0; i < 8; ++i) a[i] = 0.f;
#pragma unroll
        for (int s = 0; s < 4; ++s) if (s == 3 || s < ns) { float f[8]; unpack8(*(const u32x4*)(slots + ((size_t)qi * 4 + s) * 1024 + c8 * 8), f);
#pragma unroll
            for (int i = 0; i < 8; ++i) a[i] += f[i];
            l += lsum[((size_t)qi * 4 + s) * 8 + h]; }
        const float inv = 1.0f / l;
        u32x4 w; w.x = pk2(a[0] * inv, a[1] * inv); w.y = pk2(a[2] * inv, a[3] * inv); w.z = pk2(a[4] * inv, a[5] * inv); w.w = pk2(a[6] * inv, a[7] * inv);
        *(u32x4*)(am + (size_t)qi * 2048 + c8 * 8) = w;
    }
    xcd_barrier(xbar);
    RELOAD_IDS();

#endif
#if PHMASK & 64
    { pg8::Gemm g{am, Wyt, 2048, 2048, 1024}; pg8::Sched<1> Sc; Sc.init(S, 2048, G, bx); Epi5 E{gates, merged}; pg8::gemm_phase<Epi5>(lds, g, Sc, E); }
    xcd_barrier(xbar);
    RELOAD_IDS();

#endif
#if PHMASK & 128
    { pg8::Gemm g{merged, Wot, 2048, 2048, 2048}; pg8::Sched<0> Sc; Sc.init(S, 2048, G, bx); Epi6 E{xin, outp, xg, modf, nfg, rowss}; pg8::gemm_phase<Epi6>(lds, g, Sc, E); }
    xcd_barrier(xbar);
    RELOAD_IDS();

#endif
#if PHMASK & 256
    for (int row = vcu * NTHR + tid; row < S; row += G * NTHR) { const f32x4* pr = (const f32x4*)(rowss + (size_t)row * 32); f32x4 sm = pr[0];
#pragma unroll
        for (int j = 1; j < 8; ++j) sm += pr[j];
        rsb[row] = __builtin_amdgcn_rsqf(((sm[0] + sm[1]) + (sm[2] + sm[3])) * (1.0f / 2048.0f) + EPS); }
    xcd_barrier(xbar);
    RELOAD_IDS();
    { pg8::Gemm g{xg, Wut, 2048, 2048, 2048}; pg8::Sched<0> Sc; Sc.init(S, NUP, G, bx); Epi7 E{rsb, biasup, conv_w, conv_b, act, edge}; pg8::gemm_phase_drain<Epi7>(lds, g, Sc, E); }
    xcd_barrier(xbar);
    RELOAD_IDS();

#endif
#if PHMASK & 512
    {
        pg8::Sched<0> Sf; Sf.init(S, 2048, G, bx);
        for (int ui = 0;; ++ui) {
            Unit uf; if (!Sf.next(ui, uf)) break;
            const int tl = uf.pm;
            for (int idx = tid; idx < DFF / 4; idx += NTHR) {
                const int c = idx * 4;
                f32x4 r0[2], r1[2];
#pragma unroll
                for (int bj = 0; bj < 2; ++bj) {
                    const int lc = bj * DFF + c;
                    const f32x4 z = (f32x4){0.f, 0.f, 0.f, 0.f};
                    const f32x4 pm2 = tl > 0 ? *(const f32x4*)(edge + ((size_t)((tl - 1) * 4 + 2)) * NUP + lc) : z;
                    const f32x4 pm1 = tl > 0 ? *(const f32x4*)(edge + ((size_t)((tl - 1) * 4 + 3)) * NUP + lc) : z;
                    const f32x4 e0 = *(const f32x4*)(edge + ((size_t)(tl * 4 + 0)) * NUP + lc), e1 = *(const f32x4*)(edge + ((size_t)(tl * 4 + 1)) * NUP + lc);
                    const f32x4 w0 = *(const f32x4*)(conv_w + lc), w1 = *(const f32x4*)(conv_w + NUP + lc), w2 = *(const f32x4*)(conv_w + 2 * NUP + lc), cbv = *(const f32x4*)(conv_b + lc);
                    r0[bj] = cbv + w0 * pm2 + w1 * pm1 + w2 * e0;
                    r1[bj] = cbv + w0 * pm1 + w1 * e0 + w2 * e1;
                }
                u32x2 o0, o1; float t0[4], t1[4];
#pragma unroll
                for (int i = 0; i < 4; ++i) { t0[i] = r0[0][i] * sigmoidf_(r0[0][i]) * r0[1][i]; t1[i] = r1[0][i] * sigmoidf_(r1[0][i]) * r1[1][i]; }
                o0.x = pk2(t0[0], t0[1]); o0.y = pk2(t0[2], t0[3]); o1.x = pk2(t1[0], t1[1]); o1.y = pk2(t1[2], t1[3]);
                *(u32x2*)(act + (size_t)(tl * 256) * DFF + c) = o0; *(u32x2*)(act + (size_t)(tl * 256 + 1) * DFF + c) = o1;
            }
        }
        asm volatile("s_waitcnt vmcnt(0)" ::: "memory");
        __syncthreads();
        RELOAD_IDS();
    }
    { pg8::Gemm g{act, Wdt, DFF, DFF, DFF}; pg8::Sched<0> Sc; Sc.init(S, 2048, G, bx); Epi9 E{outp, modf}; pg8::gemm_phase<Epi9>(lds, g, Sc, E); }
#endif
}

extern "C" void kernel_launch(void* const* d_in, const int* in_sizes, int n_in, void* d_out, int out_size, void* d_ws, size_t ws_size, hipStream_t stream) {
    static int grid_blocks = 0;
    if (grid_blocks == 0) {
        if (n_in != 20 || out_size != S * DM || ws_size < WS_END) { fprintf(stderr, "kernel_launch: unexpected shapes (n_in %d out %d ws %zu)\n", n_in, out_size, ws_size); grid_blocks = -1; return; }
        int dev = 0, cus = 0, per_cu = 0;
        hipGetDevice(&dev);
        hipDeviceGetAttribute(&cus, hipDeviceAttributeMultiprocessorCount, dev);
        hipFuncSetAttribute((const void*)fwd_megakernel, hipFuncAttributeMaxDynamicSharedMemorySize, LDS_BYTES);
        hipOccupancyMaxActiveBlocksPerMultiprocessor(&per_cu, (const void*)fwd_megakernel, NTHR, LDS_BYTES);
        if (per_cu < 1) { fprintf(stderr, "kernel_launch: occupancy query reports %d blocks per CU\n", per_cu); grid_blocks = -1; return; }
        if (per_cu > 1) per_cu = 1;
        grid_blocks = cus * per_cu;
        if (grid_blocks > 256) grid_blocks = 256;
    }
    if (grid_blocks < 0) return;
    Params p{};
    for (int i = 0; i < 20; ++i) p.in[i] = (const float*)d_in[i];
    p.out = (float*)d_out; p.ws = (unsigned char*)d_ws;
    void* args[] = {&p};
    hipError_t e = hipLaunchCooperativeKernel((const void*)fwd_megakernel, dim3(grid_blocks), dim3(NTHR), args, LDS_BYTES, stream);
    if (e != hipSuccess) fprintf(stderr, "cooperative launch failed: %s (grid %d)\n", hipGetErrorString(e), grid_blocks);
}
```

```cpp
#include <hip/hip_runtime.h>
#include <hip/hip_cooperative_groups.h>
#include <cstdio>
#include <cstdint>
namespace cg = cooperative_groups;

#define LAS __attribute__((address_space(3)))
#define DI __device__ __forceinline__
typedef unsigned short bf16_t;
typedef short bf16x8 __attribute__((ext_vector_type(8)));
typedef short s16x4 __attribute__((ext_vector_type(4)));
typedef float f32x2 __attribute__((ext_vector_type(2)));
typedef float f32x4 __attribute__((ext_vector_type(4)));
typedef float f32x16 __attribute__((ext_vector_type(16)));
typedef unsigned u32x2 __attribute__((ext_vector_type(2)));
typedef unsigned u32x4 __attribute__((ext_vector_type(4)));
typedef __bf16 bf16x2_t __attribute__((ext_vector_type(2)));

constexpr int S = 16384, DM = 2048, NH = 8, HD = 128, AW = 1024, PW = 1024, DFF = 5632, NUP = 2 * DFF, N1 = 8192;
constexpr float EPS = 1e-6f;
constexpr int NWAVES = 8, NTHR = 512;
constexpr int LDS_BYTES = 147456;
constexpr int XL_OFF = 131072;

constexpr size_t MiB = 1u << 20;
constexpr size_t WS_ZERO = 0, ZERO_BYTES = 1 * MiB;
constexpr size_t WS_CNT = 0, WS_KMEAN = 65536, WS_BAR = 524288;
constexpr size_t WS_MODP = 1 * MiB;
constexpr size_t WS_MODF = 2 * MiB;
constexpr size_t WS_BIASUP = 2 * MiB + 65536;
constexpr size_t WS_ROWSS = 3 * MiB;
constexpr size_t WS_LSUM = 5 * MiB;
constexpr size_t WS_LIST = 8 * MiB;
constexpr size_t WS_W1 = 40 * MiB;
constexpr size_t WS_WY = 72 * MiB;
constexpr size_t WS_WO = 80 * MiB;
constexpr size_t WS_WG = 88 * MiB;
constexpr size_t WS_WD = 90 * MiB;
constexpr size_t WS_WU = 112 * MiB;
constexpr size_t WS_HB = 156 * MiB;
constexpr size_t WS_Q = 220 * MiB, WS_K = 252 * MiB, WS_V = 284 * MiB, WS_U = 316 * MiB;
constexpr size_t WS_GATES = 348 * MiB;
constexpr size_t WS_DB = 476 * MiB;
constexpr size_t WS_AM = WS_HB;
constexpr size_t WS_MERGED = 284 * MiB;
constexpr size_t WS_XG = WS_HB;
constexpr size_t WS_ACT = 220 * MiB;
constexpr size_t WS_EDGE = 400 * MiB;
constexpr size_t WS_END = 508 * MiB;

__constant__ double ROPE_C[64] = {
1.59154943091895346e-01, 1.37822502603982849e-01, 1.19349370211248862e-01, 1.03352296618434064e-01,
8.94994016088910133e-02, 7.75032887553740585e-02, 6.71150830052272551e-02, 5.81192674418762462e-02,
5.03292121044870353e-02, 4.35833021053073297e-02, 3.77415847174197711e-02, 3.26828658723569976e-02,
2.83022014470915797e-02, 2.45087088680224316e-02, 2.12236869570126724e-02, 1.83789788427912383e-02,
1.59154943091895346e-02, 1.37822502603982859e-02, 1.19349370211248869e-02, 1.03352296618434061e-02,
8.94994016088910168e-03, 7.75032887553740620e-03, 6.71150830052272551e-03, 5.81192674418762497e-03,
5.03292121044870353e-03, 4.35833021053073314e-03, 3.77415847174197694e-03, 3.26828658723569993e-03,
2.83022014470915797e-03, 2.45087088680224316e-03, 2.12236869570126715e-03, 1.83789788427912387e-03,
1.59154943091895346e-03, 1.37822502603982855e-03, 1.19349370211248860e-03, 1.03352296618434065e-03,
8.94994016088910125e-04, 7.75032887553740577e-04, 6.71150830052272594e-04, 5.81192674418762454e-04,
5.03292121044870353e-04, 4.35833021053073336e-04, 3.77415847174197716e-04, 3.26828658723569971e-04,
2.83022014470915775e-04, 2.45087088680224327e-04, 2.12236869570126726e-04, 1.83789788427912376e-04,
1.59154943091895335e-04, 1.37822502603982850e-04, 1.19349370211248865e-04, 1.03352296618434062e-04,
8.94994016088910179e-05, 7.75032887553740523e-05, 6.71150830052272540e-05, 5.81192674418762481e-05,
5.03292121044870380e-05, 4.35833021053073309e-05, 3.77415847174197689e-05, 3.26828658723569984e-05,
2.83022014470915789e-05, 2.45087088680224307e-05, 2.12236869570126719e-05, 1.83789788427912390e-05 };

DI unsigned pk2(float lo, float hi) { f32x2 v = {lo, hi}; bf16x2_t b = __builtin_convertvector(v, bf16x2_t); return __builtin_bit_cast(unsigned, b); }
DI float bflo(unsigned w) { return __uint_as_float(w << 16); }
DI float bfhi(unsigned w) { return __uint_as_float(w & 0xffff0000u); }
DI void unpack8(const u32x4 w, float* f) { f[0] = bflo(w.x); f[1] = bfhi(w.x); f[2] = bflo(w.y); f[3] = bfhi(w.y); f[4] = bflo(w.z); f[5] = bfhi(w.z); f[6] = bflo(w.w); f[7] = bfhi(w.w); }
DI u32x4 pack8(const f32x4 a, const f32x4 b) { u32x4 w; w.x = pk2(a[0], a[1]); w.y = pk2(a[2], a[3]); w.z = pk2(b[0], b[1]); w.w = pk2(b[2], b[3]); return w; }
DI float wave_sum(float v) {
#pragma unroll
    for (int o = 1; o < 64; o <<= 1) v += __shfl_xor(v, o);
    return v;
}
DI float sigmoidf_(float x) { return __builtin_amdgcn_rcpf(1.0f + __builtin_amdgcn_exp2f(x * -1.4426950408889634f)); }
#define LDS_WAIT() asm volatile("s_waitcnt lgkmcnt(0)" ::: "memory")
#define FENCE() do { asm volatile("" ::: "memory"); __builtin_amdgcn_sched_barrier(0); } while (0)
#define TIE(var, dep) asm volatile("" : "+v"(var) : "v"(dep))
#define RAW_BAR() do { asm volatile("s_waitcnt lgkmcnt(0)" ::: "memory"); __builtin_amdgcn_s_barrier(); asm volatile("" ::: "memory"); } while (0)

#ifndef PG8_USE_SP2
#define PG8_USE_SP2 1
#endif
namespace pg8 {
constexpr int BM = 256, BK = 64, HALF = 128, HTB = HALF * BK * 2, STAGE_BYTES = 8 * HTB, NXCD = 8, WGM = 8;
__host__ __device__ __forceinline__ int lds_byte(int r, int c) { const int st = (r >> 4) * 2 + (c >> 5), rr = r & 15, cc = c & 31, ob = rr * 64 + cc * 2; return st * 1024 + (ob ^ (((ob >> 9) & 1) << 5)); }
__host__ __device__ __forceinline__ void stage_rc(int b, int& R, int& C) { const int st = b / 1024, sb = b % 1024, swz = sb ^ (((sb >> 9) & 1) << 5); R = (st >> 1) * 16 + swz / 64; C = (st & 1) * 32 + (swz % 64) / 2; }
__host__ __device__ __forceinline__ int perm32(int rho) { const int n = rho >> 4, i = rho & 15; return 8 * (i >> 2) + 4 * n + (i & 3); }

struct Unit { int pm, pn, ka, kb, aux; };
struct Gemm { const bf16_t* A; const bf16_t* Bt; int lda, ldb, K; };

template <int mode> struct Sched {
    int nM, nN, nwg, G, c;
    __device__ void init(int M, int N, int G_, int c_) { nM = M / BM; nN = N / BM; nwg = nM * nN; G = G_; c = c_; }
    __device__ bool next(int i, Unit& u) const {
        const int ii = (mode == 1) ? (i >> 1) : i;
        const long L = (long)ii * G + c; if (L >= nwg) return false;
        int wgid = (int)L; { const int q = nwg / NXCD, r = nwg % NXCD, xcd = wgid % NXCD, off = wgid / NXCD; wgid = (xcd < r ? xcd * (q + 1) : r * (q + 1) + (xcd - r) * q) + off; }
        const int nig = WGM * nN, gid = wgid / nig, fm = gid * WGM, gsz = (nM - fm) < WGM ? (nM - fm) : WGM;
        u.pm = fm + ((wgid % nig) % gsz); u.pn = (wgid % nig) / gsz;
        u.aux = (mode == 1) ? (i & 1) : 0; u.ka = (mode == 1) ? 1024 * (i & 1) : ((mode == 2) ? 256 * u.pn : 0); u.kb = (mode == 1) ? 1024 * (i & 1) : 0;
        return true;
    }
};

template <class Epi, class SchedT>
DI void gemm_phase(LAS unsigned char* lds, const Gemm g, const SchedT& S, const Epi& E) {
    int tid_ = threadIdx.x; asm volatile("" : "+v"(tid_));
    const int tid = tid_, wid = __builtin_amdgcn_readfirstlane(tid >> 6), lane = tid & 63, wr = wid >> 2, wc = wid & 3, fr = lane & 15, fq = lane >> 4;
    const int nt = g.K / BK;
    unsigned voffA, voffB;
    { int R, C; stage_rc(tid * 16, R, C); const int Rb = (R & ~31) + perm32(R & 31);
      voffA = (unsigned)(R * g.lda + C) * 2u; voffB = (unsigned)(Rb * g.ldb + C) * 2u; }
    const size_t dvoffA = (size_t)64 * g.lda * 2, dvoffB = (size_t)64 * g.ldb * 2;
    const size_t kstep = (size_t)(BK * 2);
    const size_t hstepA = (size_t)HALF * g.lda * 2, hstepB = (size_t)HALF * g.ldb * 2;
    const size_t tstepA = 2 * hstepA, tstepB = 2 * hstepB;
    const unsigned ldsw = (unsigned)wid * 1024u;
    const int aoff = lds_byte(wr * 64 + fr, fq * 8), boff = lds_byte(wc * 32 + fr, fq * 8);
#define PG8_SA(b, h) (((b) * 2 + (h)) * HTB)
#define PG8_SB(b, h) ((4 + (b) * 2 + (h)) * HTB)
#define PG8_STAGE(bufoff, gbase, voff) do { _Pragma("unroll") for (int _i = 0; _i < 2; ++_i) \
        __builtin_amdgcn_global_load_lds((const unsigned*)((const char*)(gbase) + (size_t)_i * d##voff + (voff)), (LAS unsigned*)(lds + (bufoff) + ldsw + _i * 8192), 16, 0, 0); } while (0)
#define PG8_LDA(dst, b, h) do { _Pragma("unroll") for (int m = 0; m < 4; ++m) _Pragma("unroll") for (int k = 0; k < 2; ++k) dst[m][k] = *(const LAS bf16x8*)(lds + PG8_SA(b, h) + aoff + m * 2048 + k * 1024); } while (0)
#define PG8_LDB(dst, b, h) do { _Pragma("unroll") for (int n = 0; n < 2; ++n) _Pragma("unroll") for (int k = 0; k < 2; ++k) dst[n][k] = *(const LAS bf16x8*)(lds + PG8_SB(b, h) + boff + n * 2048 + k * 1024); } while (0)
#define PG8_MMA(ai, bj, At, Bt) do { __builtin_amdgcn_s_setprio(1); _Pragma("unroll") for (int m = 0; m < 4; ++m) _Pragma("unroll") for (int n = 0; n < 2; ++n) _Pragma("unroll") for (int k = 0; k < 2; ++k) \
        acc[ai][bj][m][n] = __builtin_amdgcn_mfma_f32_16x16x32_bf16(Bt[n][k], At[m][k], acc[ai][bj][m][n], 0, 0, 0); __builtin_amdgcn_s_setprio(0); } while (0)
#define PG8_WAIT_V(n) asm volatile("s_waitcnt vmcnt(" #n ")" ::: "memory")
#define PG8_WAIT_L(n) asm volatile("s_waitcnt lgkmcnt(" #n ")" ::: "memory")
#define PG8_BAR __builtin_amdgcn_s_barrier()
#define PG8_SCHED __builtin_amdgcn_sched_barrier(0)
    Unit cur, nxt; int ui = 0;
    if (!S.next(0, cur)) return;
    f32x4 acc[2][2][4][2];
#pragma unroll
    for (int a = 0; a < 2; ++a)
#pragma unroll
        for (int b = 0; b < 2; ++b)
#pragma unroll
            for (int m = 0; m < 4; ++m)
#pragma unroll
                for (int n = 0; n < 2; ++n) acc[a][b][m][n] = (f32x4){0.f, 0.f, 0.f, 0.f};
    bf16x8 At[4][2], B0[2][2], B1[2][2];
    const char* cA = (const char*)g.A + (size_t)cur.pm * tstepA + (size_t)cur.ka * 2; const char* cB = (const char*)g.Bt + (size_t)cur.pn * tstepB + (size_t)cur.kb * 2;
#if PG8_USE_SP2
    PG8_STAGE(PG8_SB(0, 0), cB, voffB); PG8_STAGE(PG8_SB(0, 1), cB + hstepB, voffB); PG8_STAGE(PG8_SA(0, 0), cA, voffA); PG8_STAGE(PG8_SA(0, 1), cA + hstepA, voffA);
    if (wr == 1) PG8_BAR;
    PG8_WAIT_V(2); PG8_BAR;
#else
    PG8_STAGE(PG8_SB(0, 0), cB, voffB); PG8_STAGE(PG8_SA(0, 0), cA, voffA); PG8_STAGE(PG8_SB(0, 1), cB + hstepB, voffB); PG8_STAGE(PG8_SA(0, 1), cA + hstepA, voffA);
    if (wr == 1) PG8_BAR;
    PG8_WAIT_V(4); PG8_BAR;
#endif
    PG8_STAGE(PG8_SB(1, 0), cB + kstep, voffB); PG8_STAGE(PG8_SA(1, 0), cA + kstep, voffA); PG8_STAGE(PG8_SB(1, 1), cB + hstepB + kstep, voffB);
    PG8_WAIT_V(6); PG8_BAR;
    for (;;) {
        const bool has_next = S.next(ui + 1, nxt);
        const char* nA = has_next ? (const char*)g.A + (size_t)nxt.pm * tstepA + (size_t)nxt.ka * 2 : cA; const char* nB = has_next ? (const char*)g.Bt + (size_t)nxt.pn * tstepB + (size_t)nxt.kb * 2 : cB;
        for (int t = 0; t < nt; t += 2) {
            const bool last = (t == nt - 2);
            const char* a1 = cA + (size_t)(t + 1) * kstep;
            const char* a2 = last ? nA : cA + (size_t)(t + 2) * kstep; const char* b2 = last ? nB : cB + (size_t)(t + 2) * kstep;
            const char* a3 = a2 + kstep; const char* b3 = b2 + kstep;
#if PG8_USE_SP2
            PG8_LDB(B0, 0, 0); PG8_LDB(B1, 0, 1); PG8_SCHED; PG8_LDA(At, 0, 0); PG8_STAGE(PG8_SA(1, 1), a1 + hstepA, voffA);
            PG8_WAIT_V(8); PG8_WAIT_L(0); PG8_BAR; PG8_MMA(0, 0, At, B0); PG8_MMA(0, 1, At, B1); PG8_BAR; PG8_SCHED;
            PG8_LDA(At, 0, 1); PG8_STAGE(PG8_SB(0, 0), b2, voffB); PG8_STAGE(PG8_SB(0, 1), b2 + hstepB, voffB); PG8_STAGE(PG8_SA(0, 0), a2, voffA);
            PG8_WAIT_V(8); PG8_WAIT_L(0); PG8_BAR; PG8_MMA(1, 0, At, B0); PG8_MMA(1, 1, At, B1); PG8_BAR; PG8_SCHED;
            PG8_LDB(B0, 1, 0); PG8_LDB(B1, 1, 1); PG8_SCHED; PG8_LDA(At, 1, 0); PG8_STAGE(PG8_SA(0, 1), a2 + hstepA, voffA);
            PG8_WAIT_V(8); PG8_WAIT_L(0); PG8_BAR; PG8_MMA(0, 0, At, B0); PG8_MMA(0, 1, At, B1); PG8_BAR; PG8_SCHED;
            PG8_LDA(At, 1, 1); PG8_STAGE(PG8_SB(1, 0), b3, voffB); PG8_STAGE(PG8_SB(1, 1), b3 + hstepB, voffB); PG8_STAGE(PG8_SA(1, 0), a3, voffA);
            PG8_WAIT_V(8); PG8_WAIT_L(0); PG8_BAR; PG8_MMA(1, 0, At, B0); PG8_MMA(1, 1, At, B1); PG8_BAR; PG8_SCHED;
#else
            PG8_LDB(B0, 0, 0); PG8_SCHED; PG8_LDA(At, 0, 0); PG8_STAGE(PG8_SA(1, 1), a1 + hstepA, voffA);
            PG8_WAIT_L(8); PG8_BAR; PG8_WAIT_L(0); PG8_MMA(0, 0, At, B0); PG8_BAR; PG8_SCHED;
            PG8_LDB(B1, 0, 1); PG8_STAGE(PG8_SB(0, 0), b2, voffB);
            PG8_BAR; PG8_WAIT_L(0); PG8_MMA(0, 1, At, B1); PG8_BAR;
            PG8_LDA(At, 0, 1); PG8_STAGE(PG8_SA(0, 0), a2, voffA);
            PG8_BAR; PG8_WAIT_L(0); PG8_MMA(1, 0, At, B0); PG8_BAR; PG8_SCHED;
            PG8_STAGE(PG8_SB(0, 1), b2 + hstepB, voffB);
            PG8_WAIT_V(6); PG8_BAR; PG8_MMA(1, 1, At, B1); PG8_BAR;
            PG8_LDB(B0, 1, 0); PG8_SCHED; PG8_LDA(At, 1, 0); PG8_STAGE(PG8_SA(0, 1), a2 + hstepA, voffA);
            PG8_WAIT_L(8); PG8_BAR; PG8_WAIT_L(0); PG8_MMA(0, 0, At, B0); PG8_BAR; PG8_SCHED;
            PG8_LDB(B1, 1, 1); PG8_STAGE(PG8_SB(1, 0), b3, voffB);
            PG8_BAR; PG8_WAIT_L(0); PG8_MMA(0, 1, At, B1); PG8_BAR;
            PG8_LDA(At, 1, 1); PG8_STAGE(PG8_SA(1, 0), a3, voffA);
            PG8_BAR; PG8_WAIT_L(0); PG8_MMA(1, 0, At, B0); PG8_BAR; PG8_SCHED;
            PG8_STAGE(PG8_SB(1, 1), b3 + hstepB, voffB);
            PG8_WAIT_V(6); PG8_BAR; PG8_MMA(1, 1, At, B1); PG8_BAR;
#endif
        }
        if (wr == 0) PG8_BAR;
        { int l2 = threadIdx.x; asm volatile("" : "+v"(l2)); l2 &= 63;
          E(acc, cur, wr, wc, l2 & 15, l2 >> 4, lds + XL_OFF); }
        if (!has_next) break;
        if (!(Epi::CHAIN && cur.aux == 0)) {
#pragma unroll
            for (int a = 0; a < 2; ++a)
#pragma unroll
                for (int b = 0; b < 2; ++b)
#pragma unroll
                    for (int m = 0; m < 4; ++m)
#pragma unroll
                        for (int n = 0; n < 2; ++n) acc[a][b][m][n] = (f32x4){0.f, 0.f, 0.f, 0.f};
        }
        cur = nxt; cA = nA; cB = nB; ++ui;
        if (wr == 1) PG8_BAR;
    }
    PG8_WAIT_V(0);
    PG8_BAR;
}

template <class Epi, class SchedT>
DI void gemm_phase_drain(LAS unsigned char* lds, const Gemm g, const SchedT& S, const Epi& E) {
    int tid_ = threadIdx.x; asm volatile("" : "+v"(tid_));
    const int tid = tid_, wid = __builtin_amdgcn_readfirstlane(tid >> 6), lane = tid & 63, wr = wid >> 2, wc = wid & 3, fr = lane & 15, fq = lane >> 4;
    const int nt = g.K / BK;
    unsigned voffA, voffB;
    { int R, C; stage_rc(tid * 16, R, C); const int Rb = (R & ~31) + perm32(R & 31);
      voffA = (unsigned)(R * g.lda + C) * 2u; voffB = (unsigned)(Rb * g.ldb + C) * 2u; }
    const size_t dvoffA = (size_t)64 * g.lda * 2, dvoffB = (size_t)64 * g.ldb * 2;
    const size_t kstep = (size_t)(BK * 2);
    const size_t hstepA = (size_t)HALF * g.lda * 2, hstepB = (size_t)HALF * g.ldb * 2;
    const size_t tstepA = 2 * hstepA, tstepB = 2 * hstepB;
    const unsigned ldsw = (unsigned)wid * 1024u;
    const int aoff = lds_byte(wr * 64 + fr, fq * 8), boff = lds_byte(wc * 32 + fr, fq * 8);
    bool primed = false; Unit cur, nxt;
    bool have = S.next(0, cur);
    for (int ui = 0; have; ++ui) {
        f32x4 acc[2][2][4][2];
#pragma unroll
        for (int a = 0; a < 2; ++a)
#pragma unroll
            for (int b = 0; b < 2; ++b)
#pragma unroll
                for (int m = 0; m < 4; ++m)
#pragma unroll
                    for (int n = 0; n < 2; ++n) acc[a][b][m][n] = (f32x4){0.f, 0.f, 0.f, 0.f};
        bf16x8 At[4][2], B0[2][2], B1[2][2];
        const char* cA = (const char*)g.A + (size_t)cur.pm * tstepA + (size_t)cur.ka * 2; const char* cB = (const char*)g.Bt + (size_t)cur.pn * tstepB + (size_t)cur.kb * 2;
        if (!primed) {
#if PG8_USE_SP2
        PG8_STAGE(PG8_SB(0, 0), cB, voffB); PG8_STAGE(PG8_SB(0, 1), cB + hstepB, voffB); PG8_STAGE(PG8_SA(0, 0), cA, voffA); PG8_STAGE(PG8_SA(0, 1), cA + hstepA, voffA);
        if (wr == 1) PG8_BAR;
        PG8_WAIT_V(2); PG8_BAR;
#else
        PG8_STAGE(PG8_SB(0, 0), cB, voffB); PG8_STAGE(PG8_SA(0, 0), cA, voffA); PG8_STAGE(PG8_SB(0, 1), cB + hstepB, voffB); PG8_STAGE(PG8_SA(0, 1), cA + hstepA, voffA);
        if (wr == 1) PG8_BAR;
        PG8_WAIT_V(4); PG8_BAR;
#endif
        PG8_STAGE(PG8_SB(1, 0), cB + kstep, voffB); PG8_STAGE(PG8_SA(1, 0), cA + kstep, voffA); PG8_STAGE(PG8_SB(1, 1), cB + hstepB + kstep, voffB);
        PG8_WAIT_V(6); PG8_BAR;
        }
        const bool has_next = S.next(ui + 1, nxt); const bool pf = has_next && !E.uses_lds(cur);
        const char* nA = pf ? (const char*)g.A + (size_t)nxt.pm * tstepA + (size_t)nxt.ka * 2 : cA; const char* nB = pf ? (const char*)g.Bt + (size_t)nxt.pn * tstepB + (size_t)nxt.kb * 2 : cB;
        for (int t = 0; t < nt; t += 2) {
            const bool last = (t == nt - 2);
            const char* a1 = cA + (size_t)(t + 1) * kstep;
            const char* a2 = last ? nA : cA + (size_t)(t + 2) * kstep; const char* b2 = last ? nB : cB + (size_t)(t + 2) * kstep;
            const char* a3 = a2 + kstep; const char* b3 = b2 + kstep;
#if PG8_USE_SP2
            PG8_LDB(B0, 0, 0); PG8_LDB(B1, 0, 1); PG8_SCHED; PG8_LDA(At, 0, 0); PG8_STAGE(PG8_SA(1, 1), a1 + hstepA, voffA);
            PG8_WAIT_V(8); PG8_WAIT_L(0); PG8_BAR; PG8_MMA(0, 0, At, B0); PG8_MMA(0, 1, At, B1); PG8_BAR; PG8_SCHED;
            PG8_LDA(At, 0, 1); PG8_STAGE(PG8_SB(0, 0), b2, voffB); PG8_STAGE(PG8_SB(0, 1), b2 + hstepB, voffB); PG8_STAGE(PG8_SA(0, 0), a2, voffA);
            PG8_WAIT_V(8); PG8_WAIT_L(0); PG8_BAR; PG8_MMA(1, 0, At, B0); PG8_MMA(1, 1, At, B1); PG8_BAR; PG8_SCHED;
            PG8_LDB(B0, 1, 0); PG8_LDB(B1, 1, 1); PG8_SCHED; PG8_LDA(At, 1, 0); PG8_STAGE(PG8_SA(0, 1), a2 + hstepA, voffA);
            PG8_WAIT_V(8); PG8_WAIT_L(0); PG8_BAR; PG8_MMA(0, 0, At, B0); PG8_MMA(0, 1, At, B1); PG8_BAR; PG8_SCHED;
            PG8_LDA(At, 1, 1); PG8_STAGE(PG8_SB(1, 0), b3, voffB); PG8_STAGE(PG8_SB(1, 1), b3 + hstepB, voffB); PG8_STAGE(PG8_SA(1, 0), a3, voffA);
            PG8_WAIT_V(8); PG8_WAIT_L(0); PG8_BAR; PG8_MMA(1, 0, At, B0); PG8_MMA(1, 1, At, B1); PG8_BAR; PG8_SCHED;
#else
            PG8_LDB(B0, 0, 0); PG8_SCHED; PG8_LDA(At, 0, 0); PG8_STAGE(PG8_SA(1, 1), a1 + hstepA, voffA);
            PG8_WAIT_L(8); PG8_BAR; PG8_WAIT_L(0); PG8_MMA(0, 0, At, B0); PG8_BAR; PG8_SCHED;
            PG8_LDB(B1, 0, 1); PG8_STAGE(PG8_SB(0, 0), b2, voffB);
            PG8_BAR; PG8_WAIT_L(0); PG8_MMA(0, 1, At, B1); PG8_BAR;
            PG8_LDA(At, 0, 1); PG8_STAGE(PG8_SA(0, 0), a2, voffA);
            PG8_BAR; PG8_WAIT_L(0); PG8_MMA(1, 0, At, B0); PG8_BAR; PG8_SCHED;
            PG8_STAGE(PG8_SB(0, 1), b2 + hstepB, voffB);
            PG8_WAIT_V(6); PG8_BAR; PG8_MMA(1, 1, At, B1); PG8_BAR;
            PG8_LDB(B0, 1, 0); PG8_SCHED; PG8_LDA(At, 1, 0); PG8_STAGE(PG8_SA(0, 1), a2 + hstepA, voffA);
            PG8_WAIT_L(8); PG8_BAR; PG8_WAIT_L(0); PG8_MMA(0, 0, At, B0); PG8_BAR; PG8_SCHED;
            PG8_LDB(B1, 1, 1); PG8_STAGE(PG8_SB(1, 0), b3, voffB);
            PG8_BAR; PG8_WAIT_L(0); PG8_MMA(0, 1, At, B1); PG8_BAR;
            PG8_LDA(At, 1, 1); PG8_STAGE(PG8_SA(1, 0), a3, voffA);
            PG8_BAR; PG8_WAIT_L(0); PG8_MMA(1, 0, At, B0); PG8_BAR; PG8_SCHED;
            PG8_STAGE(PG8_SB(1, 1), b3 + hstepB, voffB);
            PG8_WAIT_V(6); PG8_BAR; PG8_MMA(1, 1, At, B1); PG8_BAR;
#endif
        }
        if (wr == 0) PG8_BAR;
        if (pf) {
            { int t2 = threadIdx.x; asm volatile("" : "+v"(t2)); E.drain(acc, cur, wr, wc, t2 & 15, (t2 & 63) >> 4, lds, t2); }
            if (wr == 1) PG8_BAR;
            primed = true;
        } else {
            PG8_WAIT_V(0); PG8_WAIT_L(0); PG8_BAR;
            { int t2 = threadIdx.x; asm volatile("" : "+v"(t2)); E.drain(acc, cur, wr, wc, t2 & 15, (t2 & 63) >> 4, lds, t2); }
            PG8_WAIT_L(0); PG8_BAR;
            primed = false;
        }
        have = has_next; cur = nxt;
    }
#undef PG8_SA
#undef PG8_SB
#undef PG8_STAGE
#undef PG8_LDA
#undef PG8_LDB
#undef PG8_MMA
#undef PG8_WAIT_V
#undef PG8_WAIT_L
#undef PG8_BAR
#undef PG8_SCHED
}
}
using pg8::Unit;
typedef f32x4 AccT[2][2][4][2];

constexpr int PT = 260;
struct Epi1 {
    static constexpr bool CHAIN = false;
    DI bool uses_lds(const Unit& u) const { return u.pn < 8; }
    bf16_t *q, *k, *v, *ub, *gates; float* kmean; const float *qg, *kg, *bgate;
    DI void drain(AccT& acc, const Unit& u, int wr, int wc, int fr, int fq, LAS unsigned char* lds, int tid) const {
        const int pn = u.pn; const int rowb = u.pm * 256 + wr * 64 + fr;
        bf16_t *pq = q, *pk = k, *pv = v, *pu = ub, *pg = gates; const float *pqg = qg, *pkg = kg;
        asm volatile("" : "+s"(pq), "+s"(pk), "+s"(pv), "+s"(pu), "+s"(pg), "+s"(pqg), "+s"(pkg));
        if (pn >= 16) {
            const int c0 = (pn - 16) * 128 + wc * 32 + fq * 8;
            f32x4 ba[2], bb[2];
#pragma unroll
            for (int n = 0; n < 2; ++n) { ba[n] = *(const f32x4*)(bgate + c0 + 4 * n); bb[n] = *(const f32x4*)(bgate + 2048 + c0 + 4 * n); }
#pragma unroll
            for (int ai = 0; ai < 2; ++ai)
#pragma unroll
                for (int m = 0; m < 4; ++m) { bf16_t* rowp = pg + (size_t)(rowb + ai * 128 + m * 16) * 4096 + c0;
                    f32x4 rr[2], gg[2];
#pragma unroll
                    for (int n = 0; n < 2; ++n)
#pragma unroll
                        for (int i = 0; i < 4; ++i) { const float ea = __builtin_amdgcn_exp2f((acc[ai][0][m][n][i] + ba[n][i]) * -1.4426950408889634f), eb = __builtin_amdgcn_exp2f((acc[ai][1][m][n][i] + bb[n][i]) * -1.4426950408889634f);
                            gg[n][i] = __builtin_amdgcn_rcpf(1.0f + eb); rr[n][i] = (1.0f + eb) * __builtin_amdgcn_rcpf(1.0f + ea); }
                    *(u32x4*)rowp = pack8(rr[0], rr[1]); *(u32x4*)(rowp + 2048) = pack8(gg[0], gg[1]); }
            return;
        }
        if (pn >= 8) {
            bf16_t* base; int ldc, col0; const bool sig = false;
            if (pn < 12) { base = pv; ldc = 1024; col0 = (pn - 8) * 256; } else { base = pu; ldc = 1024; col0 = (pn - 12) * 256; }
            col0 += wc * 32 + fq * 8;
            f32x4 bv[2][2];
#pragma unroll
            for (int bj = 0; bj < 2; ++bj)
#pragma unroll
                for (int n = 0; n < 2; ++n) bv[bj][n] = sig ? *(const f32x4*)(bgate + col0 + bj * 128 + 4 * n) : (f32x4){0.f, 0.f, 0.f, 0.f};
#pragma unroll
            for (int ai = 0; ai < 2; ++ai)
#pragma unroll
                for (int m = 0; m < 4; ++m) { bf16_t* rowp = base + (size_t)(rowb + ai * 128 + m * 16) * ldc + col0;
#pragma unroll
                    for (int bj = 0; bj < 2; ++bj) { f32x4 v0 = acc[ai][bj][m][0] + bv[bj][0], v1 = acc[ai][bj][m][1] + bv[bj][1];
                        if (sig) {
#pragma unroll
                            for (int i = 0; i < 4; ++i) { v0[i] = sigmoidf_(v0[i]); v1[i] = sigmoidf_(v1[i]); } }
                        *(u32x4*)(rowp + bj * 128) = pack8(v0, v1); } }
            return;
        }
        const bool isq = pn < 4; const int hp = (pn & 3) * 2;
        const float* g = isq ? pqg : pkg; bf16_t* dst = isq ? pq : pk;
        const float qs = isq ? 0.08838834764831845f * 1.4426950408889634f : 1.0f;
        LAS float* T = (LAS float*)lds;
        const int r = tid >> 2, part = tid & 3, bj2 = part >> 1, sub = part & 1;
        float ksum = 0.f;
#pragma unroll
        for (int ai = 0; ai < 2; ++ai) {
#pragma unroll
            for (int m = 0; m < 4; ++m)
#pragma unroll
                for (int bj = 0; bj < 2; ++bj)
#pragma unroll
                    for (int n = 0; n < 2; ++n) *(LAS f32x4*)(T + (64 * wr + 16 * m + fr) * PT + 128 * bj + 32 * wc + 8 * fq + 4 * n) = acc[ai][bj][m][n];
            RAW_BAR();
            LAS float* rowp = T + r * PT + 128 * bj2 + 32 * sub;
            float ss = 0.f;
#pragma unroll
            for (int j = 0; j < 8; ++j) { const f32x4 a = *(const LAS f32x4*)(rowp + 4 * j), b = *(const LAS f32x4*)(rowp + 64 + 4 * j);
                ss += (a[0] * a[0] + a[1] * a[1]) + (a[2] * a[2] + a[3] * a[3]) + (b[0] * b[0] + b[1] * b[1]) + (b[2] * b[2] + b[3] * b[3]); }
            ss += __shfl_xor(ss, 1);
            const float rr = __builtin_amdgcn_rsqf(ss * (1.0f / 128.0f) + EPS) * qs;
            const int row = u.pm * 256 + ai * 128 + r;
            bf16_t* op = dst + (size_t)row * 1024 + (hp + bj2) * 128 + 32 * sub;
#pragma unroll 1
            for (int j = 0; j < 8; j += 2) {
                f32x4 o1[2], o2[2];
#pragma unroll
                for (int jj = 0; jj < 2; ++jj) {
                    const int d = 32 * sub + 4 * (j + jj);
                    const f32x4 x1 = *(const LAS f32x4*)(rowp + 4 * (j + jj)), x2 = *(const LAS f32x4*)(rowp + 64 + 4 * (j + jj));
                    const f32x4 g0 = *(const f32x4*)(g + d), g1 = *(const f32x4*)(g + 64 + d);
                    f32x4 cs, sn;
#pragma unroll
                    for (int i = 0; i < 4; ++i) { double t = (double)row * ROPE_C[d + i]; t -= __builtin_floor(t); const float tf = (float)t; cs[i] = __builtin_amdgcn_cosf(tf); sn[i] = __builtin_amdgcn_sinf(tf); }
                    const f32x4 a = x1 * rr * g0, b = x2 * rr * g1;
                    o1[jj] = a * cs - b * sn; o2[jj] = b * cs + a * sn;
                    if (!isq) { *(LAS f32x4*)(rowp + 4 * (j + jj)) = o1[jj]; *(LAS f32x4*)(rowp + 64 + 4 * (j + jj)) = o2[jj]; }
                }
                *(u32x4*)(op + 4 * j) = pack8(o1[0], o1[1]); *(u32x4*)(op + 64 + 4 * j) = pack8(o2[0], o2[1]);
            }
            if (!isq) { RAW_BAR(); if (tid < 256) {
#pragma unroll 8
                for (int rr2 = 0; rr2 < 128; ++rr2) ksum += T[rr2 * PT + tid]; } }
            RAW_BAR();
        }
        if (!isq && tid < 256) kmean[((size_t)(hp + (tid >> 7)) * 64 + u.pm) * 128 + (tid & 127)] = ksum * (1.0f / 256.0f);
    }
};

struct Epi3 {
    static constexpr bool CHAIN = false;
    bf16_t* am; const float* ls;
    DI void drain(AccT& acc, const Unit& u, int wr, int wc, int fr, int fq, LAS unsigned char* l, int) const { (*this)(acc, u, wr, wc, fr, fq, l); }
    DI void operator()(AccT& acc, const Unit& u, int wr, int wc, int fr, int fq, LAS unsigned char*) const {
        const int col0 = u.pn * 256 + wc * 32 + fq * 8; const int rowb = u.pm * 256 + wr * 64 + fr;
        f32x4 sv[2][2];
#pragma unroll
        for (int bj = 0; bj < 2; ++bj)
#pragma unroll
            for (int n = 0; n < 2; ++n) sv[bj][n] = *(const f32x4*)(ls + col0 + bj * 128 + 4 * n);
#pragma unroll
        for (int ai = 0; ai < 2; ++ai)
#pragma unroll
            for (int m = 0; m < 4; ++m) { bf16_t* rowp = am + (size_t)(rowb + ai * 128 + m * 16) * 2048 + 1024 + col0;
#pragma unroll
                for (int bj = 0; bj < 2; ++bj) *(u32x4*)(rowp + bj * 128) = pack8(acc[ai][bj][m][0] * sv[bj][0], acc[ai][bj][m][1] * sv[bj][1]); }
    }
};

struct Epi5 {
    static constexpr bool CHAIN = true;
    const bf16_t* gates; bf16_t* merged;
    DI void operator()(AccT& acc, const Unit& u, int wr, int wc, int fr, int fq, LAS unsigned char*) const {
        const int col0 = u.pn * 256 + wc * 32 + fq * 8; const int rowb = u.pm * 256 + wr * 64 + fr;
        if (u.aux == 0) {
#pragma unroll
            for (int ai = 0; ai < 2; ++ai) {
                u32x4 gw[4][2];
#pragma unroll
                for (int m = 0; m < 4; ++m)
#pragma unroll
                    for (int bj = 0; bj < 2; ++bj) gw[m][bj] = *(const u32x4*)(gates + (size_t)(rowb + ai * 128 + m * 16) * 4096 + col0 + bj * 128);
#pragma unroll
                for (int m = 0; m < 4; ++m)
#pragma unroll
                    for (int bj = 0; bj < 2; ++bj) { float gr[8]; unpack8(gw[m][bj], gr);
#pragma unroll
                        for (int i = 0; i < 4; ++i) { acc[ai][bj][m][0][i] *= gr[i]; acc[ai][bj][m][1][i] *= gr[4 + i]; } }
                FENCE();
            }
        } else {
#pragma unroll
            for (int ai = 0; ai < 2; ++ai) {
                u32x4 gw[4][2];
#pragma unroll
                for (int m = 0; m < 4; ++m)
#pragma unroll
                    for (int bj = 0; bj < 2; ++bj) gw[m][bj] = *(const u32x4*)(gates + (size_t)(rowb + ai * 128 + m * 16) * 4096 + 2048 + col0 + bj * 128);
#pragma unroll
                for (int m = 0; m < 4; ++m)
#pragma unroll
                    for (int bj = 0; bj < 2; ++bj) { float gp[8]; unpack8(gw[m][bj], gp); f32x4 v0, v1;
#pragma unroll
                        for (int i = 0; i < 4; ++i) { v0[i] = acc[ai][bj][m][0][i] * gp[i]; v1[i] = acc[ai][bj][m][1][i] * gp[4 + i]; }
                        *(u32x4*)(merged + (size_t)(rowb + ai * 128 + m * 16) * 2048 + col0 + bj * 128) = pack8(v0, v1); }
                FENCE();
            }
        }
    }
};

struct Epi6 {
    static constexpr bool CHAIN = false;
    const float* x; float* out; bf16_t* xg; const float* modf; const float* nfg; float* rowss;
    DI void operator()(AccT& acc, const Unit& u, int wr, int wc, int fr, int fq, LAS unsigned char*) const {
        const int col0 = u.pn * 256 + wc * 32 + fq * 8; const int rowb = u.pm * 256 + wr * 64 + fr;
        f32x4 g1v[2][2], gmv[2][2];
#pragma unroll
        for (int bj = 0; bj < 2; ++bj)
#pragma unroll
            for (int n = 0; n < 2; ++n) { const int c = col0 + bj * 128 + 4 * n; g1v[bj][n] = *(const f32x4*)(modf + 2 * 2048 + c);
                gmv[bj][n] = *(const f32x4*)(nfg + c) * (*(const f32x4*)(modf + 4 * 2048 + c) + 1.0f); }
#pragma unroll
        for (int ag = 0; ag < 4; ++ag) { const int ai = ag >> 1, m0 = (ag & 1) * 2;
            f32x4 xr[4][2][2];
#pragma unroll
            for (int m = m0; m < m0 + 2; ++m)
#pragma unroll
                for (int bj = 0; bj < 2; ++bj) { const size_t off = (size_t)(rowb + ai * 128 + m * 16) * 2048 + col0 + bj * 128;
                    xr[m][bj][0] = *(const f32x4*)(x + off); xr[m][bj][1] = *(const f32x4*)(x + off + 4); }
            FENCE();
#pragma unroll
            for (int m = m0; m < m0 + 2; ++m) { const size_t row = (size_t)(rowb + ai * 128 + m * 16); float ss = 0.f;
#pragma unroll
                for (int bj = 0; bj < 2; ++bj) { const size_t off = row * 2048 + col0 + bj * 128;
                    const f32x4 y0 = xr[m][bj][0] + g1v[bj][0] * acc[ai][bj][m][0], y1 = xr[m][bj][1] + g1v[bj][1] * acc[ai][bj][m][1];
                    *(f32x4*)(out + off) = y0; *(f32x4*)(out + off + 4) = y1;
                    *(u32x4*)(xg + off) = pack8(y0 * gmv[bj][0], y1 * gmv[bj][1]);
                    ss += (y0[0] * y0[0] + y0[1] * y0[1]) + (y0[2] * y0[2] + y0[3] * y0[3]) + (y1[0] * y1[0] + y1[1] * y1[1]) + (y1[2] * y1[2] + y1[3] * y1[3]); }
                ss += __shfl_xor(ss, 16); ss += __shfl_xor(ss, 32);
                if (fq == 0) rowss[row * 32 + u.pn * 4 + wc] = ss; }
            FENCE();
        }
    }
};

struct Epi7 {
    static constexpr bool CHAIN = false;
    DI bool uses_lds(const Unit&) const { return true; }
    const float* rsb; const float* biasup; const float* cw; const float* cb; bf16_t* act; float* edge;
    DI void drain(AccT& acc, const Unit& u, int wr, int wc, int fr, int fq, LAS unsigned char* lds, int tid) const {
        LAS float* T = (LAS float*)lds;
        const int cgi = tid & 15, rg = tid >> 4;
        const int lcb = u.pn * 128;
#pragma unroll
        for (int ai = 0; ai < 2; ++ai) {
            {
                float rs[4];
#pragma unroll
                for (int m = 0; m < 4; ++m) rs[m] = rsb[u.pm * 256 + ai * 128 + 64 * wr + 16 * m + fr];
#pragma unroll
                for (int bj = 0; bj < 2; ++bj)
#pragma unroll
                    for (int n = 0; n < 2; ++n) { const f32x4 bi = *(const f32x4*)(biasup + u.pn * 256 + 128 * bj + 32 * wc + 8 * fq + 4 * n);
#pragma unroll
                        for (int m = 0; m < 4; ++m) *(LAS f32x4*)(T + (2 + 64 * wr + 16 * m + fr) * PT + 128 * bj + 32 * wc + 8 * fq + 4 * n) = acc[ai][bj][m][n] * rs[m] + bi; }
            }
            RAW_BAR();
            {
                const int cg8 = (tid >> 1) & 15, h4 = tid & 1, rgi = tid >> 5;
                const int cc = 8 * cg8 + 4 * h4, lca = lcb + cc, lcbb = DFF + lcb + cc;
                const f32x4 wa0 = *(const f32x4*)(cw + lca), wa1 = *(const f32x4*)(cw + NUP + lca), wa2 = *(const f32x4*)(cw + 2 * NUP + lca), ca0 = *(const f32x4*)(cb + lca);
                const f32x4 wb0 = *(const f32x4*)(cw + lcbb), wb1 = *(const f32x4*)(cw + NUP + lcbb), wb2 = *(const f32x4*)(cw + 2 * NUP + lcbb), cb0 = *(const f32x4*)(cb + lcbb);
#pragma unroll 1
                for (int ch = 0; ch < 2; ++ch) {
                    const int r0 = 8 * rgi + 4 * ch;
                    f32x4 xa[6], xb[6];
#pragma unroll
                    for (int kx = 0; kx < 6; ++kx) { xa[kx] = *(const LAS f32x4*)(T + (r0 + kx) * PT + cc); xb[kx] = *(const LAS f32x4*)(T + (r0 + kx) * PT + 128 + cc); }
                    u32x2 pw[4];
#pragma unroll
                    for (int kx = 0; kx < 4; ++kx) { const f32x4 av = ca0 + wa0 * xa[kx] + wa1 * xa[kx + 1] + wa2 * xa[kx + 2], bv = cb0 + wb0 * xb[kx] + wb1 * xb[kx + 1] + wb2 * xb[kx + 2];
                        float rv[4];
#pragma unroll
                        for (int i = 0; i < 4; ++i) rv[i] = av[i] * sigmoidf_(av[i]) * bv[i];
                        pw[kx].x = pk2(rv[0], rv[1]); pw[kx].y = pk2(rv[2], rv[3]); }
                    const u32x2 s0 = h4 ? pw[0] : pw[2], s1 = h4 ? pw[1] : pw[3];
                    u32x2 g0, g1; g0.x = __shfl_xor(s0.x, 1); g0.y = __shfl_xor(s0.y, 1); g1.x = __shfl_xor(s1.x, 1); g1.y = __shfl_xor(s1.y, 1);
                    const u32x2 m0 = h4 ? pw[2] : pw[0], m1 = h4 ? pw[3] : pw[1];
                    const u32x4 o0 = h4 ? (u32x4){g0.x, g0.y, m0.x, m0.y} : (u32x4){m0.x, m0.y, g0.x, g0.y};
                    const u32x4 o1 = h4 ? (u32x4){g1.x, g1.y, m1.x, m1.y} : (u32x4){m1.x, m1.y, g1.x, g1.y};
                    if (!(ai == 0 && rgi == 0 && ch == 0 && h4 == 0)) {
                        const size_t row = (size_t)(u.pm * 256 + ai * 128 + r0 + 2 * h4);
                        *(u32x4*)(act + row * DFF + lcb + 8 * cg8) = o0; *(u32x4*)(act + (row + 1) * DFF + lcb + 8 * cg8) = o1; }
                }
            }
            if (tid < 128) { const int sel = tid >> 6, col4 = (tid & 63) * 4; const int lc = (col4 < 128) ? (lcb + col4) : (DFF + lcb + col4 - 128);
                const f32x4 ev = *(const LAS f32x4*)(T + ((ai == 0 ? 2 : 128) + sel) * PT + col4);
                *(f32x4*)(edge + ((size_t)(u.pm * 4 + 2 * ai + sel)) * NUP + lc) = ev; }
            RAW_BAR();
            if (ai == 0) { if (tid < 128) { const int sel = tid >> 6, col4 = (tid & 63) * 4; *(LAS f32x4*)(T + sel * PT + col4) = *(const LAS f32x4*)(T + (128 + sel) * PT + col4); }
                RAW_BAR(); }
        }
    }
};

struct Epi9 {
    static constexpr bool CHAIN = false;
    float* out; const float* modf;
    DI void operator()(AccT& acc, const Unit& u, int wr, int wc, int fr, int fq, LAS unsigned char*) const {
        const int col0 = u.pn * 256 + wc * 32 + fq * 8; const int rowb = u.pm * 256 + wr * 64 + fr;
        f32x4 g2v[2][2];
#pragma unroll
        for (int bj = 0; bj < 2; ++bj)
#pragma unroll
            for (int n = 0; n < 2; ++n) g2v[bj][n] = *(const f32x4*)(modf + 5 * 2048 + col0 + bj * 128 + 4 * n);
#pragma unroll
        for (int ag = 0; ag < 4; ++ag) { const int ai = ag >> 1, m0 = (ag & 1) * 2;
            f32x4 xr[4][2][2];
#pragma unroll
            for (int m = m0; m < m0 + 2; ++m)
#pragma unroll
                for (int bj = 0; bj < 2; ++bj) { const size_t off = (size_t)(rowb + ai * 128 + m * 16) * 2048 + col0 + bj * 128;
                    xr[m][bj][0] = *(const f32x4*)(out + off); xr[m][bj][1] = *(const f32x4*)(out + off + 4); }
            FENCE();
#pragma unroll
            for (int m = m0; m < m0 + 2; ++m)
#pragma unroll
                for (int bj = 0; bj < 2; ++bj) { const size_t off = (size_t)(rowb + ai * 128 + m * 16) * 2048 + col0 + bj * 128;
                    *(f32x4*)(out + off) = xr[m][bj][0] + g2v[bj][0] * acc[ai][bj][m][0]; *(f32x4*)(out + off + 4) = xr[m][bj][1] + g2v[bj][1] * acc[ai][bj][m][1]; }
            FENCE();
        }
    }
};

DI int dest_row(int mode, int n) {
    if (mode == 1) { if (n >= 2048) return n; const int d = n & 127; return (n & ~127) + 32 * ((d >> 4) & 3) + 8 * ((d >> 2) & 3) + 4 * (d >> 6) + (d & 3); }
    if (mode == 2) { const int bj = n >= DFF ? 1 : 0, cc = n - bj * DFF; return 256 * (cc >> 7) + 128 * bj + (cc & 127); }
    if (mode == 3) { const int bj = n >= 2048 ? 1 : 0, cc = n - bj * 2048; return 256 * (cc >> 7) + 128 * bj + (cc & 127); }
    return n;
}
DI void transpose_item(const float* W, int N, bf16_t* WT, int ldd, int koff, int row_off, int mode, LAS float* scr, int item, int lane) {
    const int nblk = N / 64, kb = item / nblk, nb = item % nblk, k0 = 64 * kb, n0 = 64 * nb;
    const int kr = lane >> 4, n4 = (lane & 15) * 4;
    f32x4 v[16];
#pragma unroll
    for (int i = 0; i < 16; ++i) v[i] = __builtin_nontemporal_load((const f32x4*)(W + (size_t)(k0 + 4 * i + kr) * N + n0 + n4));
#pragma unroll
    for (int i = 0; i < 16; ++i) { LAS float* d = scr + (4 * i + kr) * 65 + n4; d[0] = v[i][0]; d[1] = v[i][1]; d[2] = v[i][2]; d[3] = v[i][3]; }
    LDS_WAIT(); asm volatile("" ::: "memory");
    const int c = lane & 7;
#pragma unroll
    for (int j = 0; j < 8; ++j) { const int n = (lane >> 3) + 8 * j; const LAS float* sp = scr + (8 * c) * 65 + n;
        u32x4 o; o.x = pk2(sp[0 * 65], sp[1 * 65]); o.y = pk2(sp[2 * 65], sp[3 * 65]); o.z = pk2(sp[4 * 65], sp[5 * 65]); o.w = pk2(sp[6 * 65], sp[7 * 65]);
        *(u32x4*)(WT + (size_t)(row_off + dest_row(mode, n0 + n)) * ldd + koff + k0 + 8 * c) = o; }
    LDS_WAIT(); asm volatile("" ::: "memory");
}

DI s16x4 vtr(const LAS unsigned char* p) { typedef short v4i16_t __attribute__((ext_vector_type(4))); return __builtin_bit_cast(s16x4, __builtin_amdgcn_ds_read_tr16_b64_v4i16((LAS v4i16_t*)p)); }
constexpr int KV_PITCH = 272;
constexpr int LDS_KS = 0, LDS_VS = 256 * KV_PITCH, LDS_TAB = 2 * 256 * KV_PITCH;


#define XB_TMO      128
#define XB_XCNT(j)  (256  + 64 * (j))
#define XB_XSUB(j)  (1280 + 64 * (j))
#define XB_XGEN(j)  (2304 + 64 * (j))
#define XB_TOP      3328
#define XB_TOPGEN   3392
#define XCD_BAR_WORDS 3456
#define XB_SPIN_CAP (1u << 18)
DI unsigned xb_ld(unsigned* p)              { return __hip_atomic_load(p, __ATOMIC_RELAXED, __HIP_MEMORY_SCOPE_AGENT); }
DI unsigned xb_add(unsigned* p, unsigned v) { return __hip_atomic_fetch_add(p, v, __ATOMIC_RELAXED, __HIP_MEMORY_SCOPE_AGENT); }
DI unsigned xb_xcc_id() { return (unsigned)__builtin_amdgcn_s_getreg((3 << 11) | 20) & 0xFu; }
#define XB_SPIN(cond, bar) do { unsigned _sp = 0; while (cond) { __builtin_amdgcn_s_sleep(1); \
    if ((++_sp & 255u) == 0u) { if (xb_ld(&(bar)[XB_TMO])) break; if (_sp > XB_SPIN_CAP) { atomicAdd(&(bar)[XB_TMO], 1u); break; } } } } while (0)
struct XcdBarrier { unsigned* bar; unsigned x; volatile LAS unsigned* st; };
DI XcdBarrier xcd_barrier_post(unsigned* bar, volatile LAS unsigned* st) {
    XcdBarrier b; b.bar = bar; b.x = xb_xcc_id(); b.st = st;
    if (threadIdx.x == 0) (void)xb_add(&bar[XB_XCNT(b.x)], 1u);
    return b;
}
DI void xcd_barrier_complete(unsigned* bar, unsigned x, unsigned& nloc, unsigned& nx) {
    const unsigned G = gridDim.x * gridDim.y * gridDim.z;
    unsigned sum, cnt, mine, sp = 0u;
    for (;;) {
        sum = 0u; cnt = 0u; mine = 0u;
#pragma unroll
        for (unsigned j = 0; j < 16; ++j) { const unsigned c = xb_ld(&bar[XB_XCNT(j)]); sum += c; cnt += (c > 0u) ? 1u : 0u; mine = (j == x) ? c : mine; }
        if (sum == G) break;
        __builtin_amdgcn_s_sleep(1);
        if ((++sp & 255u) == 0u) { if (xb_ld(&bar[XB_TMO])) break; if (sp > XB_SPIN_CAP) { atomicAdd(&bar[XB_TMO], 1u); break; } }
    }
    nloc = mine > 0u ? mine : 1u; nx = cnt > 0u ? cnt : 1u;
}
DI void xcd_barrier(const XcdBarrier& b) {
    asm volatile("s_waitcnt vmcnt(0)" ::: "memory");
    __syncthreads();
    if (threadIdx.x == 0) {
        unsigned* bar = b.bar;
        __builtin_amdgcn_s_waitcnt(0);
        unsigned nloc = b.st[0], nx = b.st[1];
        if (nloc == 0u) { xcd_barrier_complete(bar, b.x, nloc, nx); b.st[0] = nloc; b.st[1] = nx; }
        const unsigned old = xb_add(&bar[XB_XSUB(b.x)], 1u);
        const unsigned gen = old / nloc;
        if (old + 1u == (gen + 1u) * nloc) {
            __builtin_amdgcn_fence(__ATOMIC_RELEASE, "agent");
            asm volatile("s_waitcnt vmcnt(0)" ::: "memory");
            const unsigned og = xb_add(&bar[XB_TOP], 1u);
            const unsigned tg = og / nx;
            if (og + 1u == (tg + 1u) * nx) xb_add(&bar[XB_TOPGEN], 1u);
            else XB_SPIN(xb_ld(&bar[XB_TOPGEN]) == tg, bar);
            __builtin_amdgcn_fence(__ATOMIC_ACQUIRE, "agent");
            xb_add(&bar[XB_XGEN(b.x)], 1u);
            asm volatile("s_waitcnt vmcnt(0)" ::: "memory");
        } else {
            XB_SPIN(xb_ld(&bar[XB_XGEN(b.x)]) == gen, bar);
            __builtin_amdgcn_fence(__ATOMIC_ACQUIRE, "agent");
            asm volatile("s_waitcnt vmcnt(0)" ::: "memory");
        }
    }
    __syncthreads();
}

#ifndef PHMASK
#define PHMASK 0xFFFF
#endif
struct Params {
    const float* in[20]; float* out; unsigned char* ws;
};

__global__ void __launch_bounds__(NTHR, 2) fwd_megakernel(Params p) {
    extern __shared__ __attribute__((aligned(16))) unsigned char lds_raw[];
    LAS unsigned char* lds = (LAS unsigned char*)lds_raw;
    cg::grid_group grid = cg::this_grid();
    int tid = threadIdx.x, lane = tid & 63; const int wave = __builtin_amdgcn_readfirstlane(tid >> 6);
#define RELOAD_IDS() do { tid = threadIdx.x; asm volatile("" : "+v"(tid)); lane = tid & 63; } while (0)
    const int G = gridDim.x, bx = blockIdx.x;
    const int vcu = (G % 8 == 0) ? (bx % 8) * (G / 8) + bx / 8 : bx;
    const int gw = vcu * NWAVES + wave, NGW = G * NWAVES;
    unsigned char* ws = p.ws;
    volatile LAS unsigned* xst = (volatile LAS unsigned*)(lds + LDS_BYTES - 16);
    if (threadIdx.x < 4) xst[threadIdx.x] = 0u;
    __syncthreads();
    XcdBarrier xbar; xbar.bar = (unsigned*)(ws + WS_BAR); xbar.x = 0; xbar.st = xst;
    if (blockIdx.x == 0) {
        for (int i = threadIdx.x; i < 512; i += NTHR) ((unsigned*)(ws + WS_CNT))[i] = 0u;
        for (int i = threadIdx.x; i < XCD_BAR_WORDS; i += NTHR) ((unsigned*)(ws + WS_BAR))[i] = 0u;
    }
#define xin (p.in[0])
#define cvec (p.in[1])
#define w_ada (p.in[2])
#define b_ada (p.in[3])
#define nmg (p.in[4])
#define w_in (p.in[5])
#define qng (p.in[6])
#define kng (p.in[7])
#define w_pgrp (p.in[8])
#define pscale (p.in[9])
#define w_abr (p.in[10])
#define w_pbr (p.in[11])
#define w_gate (p.in[12])
#define b_gate (p.in[13])
#define w_o (p.in[14])
#define nfg (p.in[15])
#define w_up (p.in[16])
#define conv_w (p.in[17])
#define conv_b (p.in[18])
#define w_down (p.in[19])
#define outp (p.out)
#define cnt ((unsigned*)(ws + WS_CNT))
#define kmean ((float*)(ws + WS_KMEAN))
#define modp ((float*)(ws + WS_MODP))
#define modf ((float*)(ws + WS_MODF))
#define biasup ((float*)(ws + WS_BIASUP))
#define rowss ((float*)(ws + WS_ROWSS))
#define lsum ((float*)(ws + WS_LSUM))
#define qlist ((unsigned*)(ws + WS_LIST))
#define W1t ((bf16_t*)(ws + WS_W1))
#define Wyt ((bf16_t*)(ws + WS_WY))
#define Wot ((bf16_t*)(ws + WS_WO))
#define Wgt ((bf16_t*)(ws + WS_WG))
#define Wdt ((bf16_t*)(ws + WS_WD))
#define Wut ((bf16_t*)(ws + WS_WU))
#define hbuf ((bf16_t*)(ws + WS_HB))
#define qb ((bf16_t*)(ws + WS_Q))
#define kb ((bf16_t*)(ws + WS_K))
#define vb ((bf16_t*)(ws + WS_V))
#define ub ((bf16_t*)(ws + WS_U))
#define gates ((bf16_t*)(ws + WS_GATES))
#define dbuf ((bf16_t*)(ws + WS_DB))
#define am ((bf16_t*)(ws + WS_AM))
#define merged ((bf16_t*)(ws + WS_MERGED))
#define xg ((bf16_t*)(ws + WS_XG))
#define act ((bf16_t*)(ws + WS_ACT))
#define edge ((float*)(ws + WS_EDGE))
#define slots ((bf16_t*)p.out)
#define rsb ((float*)(ws + WS_LSUM))
#if PHMASK & 1
    {
        LAS float* scr = (LAS float*)(lds + wave * 16640);
        constexpr int I_IN = 32 * 64, I_GT = 32 * 64, I_AB = 16 * 32, I_PB = 16 * 32, I_O = 32 * 32, I_UP = 32 * 176, I_DN = 88 * 32, I_G = 4 * 4;
        constexpr int NIT = I_IN + I_GT + I_AB + I_PB + I_O + I_UP + I_DN + 4 * I_G;
        for (int it = gw; it < NIT; it += NGW) {
            int r = it;
            if (r < I_UP) { transpose_item(w_up, NUP, Wut, 2048, 0, 0, 2, scr, r, lane); continue; } r -= I_UP;
            if (r < I_DN) { transpose_item(w_down, 2048, Wdt, DFF, 0, 0, 0, scr, r, lane); continue; } r -= I_DN;
            if (r < I_IN) { transpose_item(w_in, 4096, W1t, 2048, 0, 0, 0, scr, r, lane); continue; } r -= I_IN;
            if (r < I_GT) { transpose_item(w_gate, 4096, W1t, 2048, 0, 4096, 3, scr, r, lane); continue; } r -= I_GT;
            if (r < I_AB) { transpose_item(w_abr, 2048, Wyt, 2048, 0, 0, 0, scr, r, lane); continue; } r -= I_AB;
            if (r < I_PB) { transpose_item(w_pbr, 2048, Wyt, 2048, 1024, 0, 0, scr, r, lane); continue; } r -= I_PB;
            if (r < I_O) { transpose_item(w_o, 2048, Wot, 2048, 0, 0, 0, scr, r, lane); continue; } r -= I_O;
            { const int gI = r / I_G; transpose_item(w_pgrp + (size_t)gI * 65536, 256, Wgt, 1024, 0, gI * 256, 0, scr, r % I_G, lane); }
        }
        for (int it = gw; it < 768; it += NGW) {
            const int kc = it / 48, cgi = it % 48; const int col = cgi * 256 + lane * 4;
            f32x4 a = (f32x4){0.f, 0.f, 0.f, 0.f};
#pragma unroll 8
            for (int kk = 0; kk < 128; ++kk) { const int kx = kc * 128 + kk; const float cv = cvec[kx]; const float sv = cv * sigmoidf_(cv);
                a += __builtin_nontemporal_load((const f32x4*)(w_ada + (size_t)kx * 12288 + col)) * sv; }
            *(f32x4*)(modp + (size_t)kc * 12288 + col) = a;
        }
    }
    grid.sync();
    xbar = xcd_barrier_post((unsigned*)(ws + WS_BAR), xst);
    RELOAD_IDS();

#endif
#if PHMASK & 2
    {
        LAS float* sh1 = (LAS float*)lds; LAS float* gm1 = sh1 + 2048;
        for (int e = tid; e < 4096; e += NTHR) { float s = b_ada[e];
#pragma unroll
            for (int kc = 0; kc < 16; ++kc) s += modp[(size_t)kc * 12288 + e];
            if (e < 2048) sh1[e] = s; else gm1[e - 2048] = nmg[e - 2048] * (1.0f + s); }
        if (tid < 48) { const int e = bx * 48 + tid; if (e < 12288 && bx < 256) { float s = b_ada[e];
#pragma unroll
            for (int kc = 0; kc < 16; ++kc) s += modp[(size_t)kc * 12288 + e];
            modf[e] = s; } }
        if (G < 256 && bx == 0) { for (int e = G * 48 + tid; e < 12288; e += NTHR) { float s = b_ada[e]; for (int kc = 0; kc < 16; ++kc) s += modp[(size_t)kc * 12288 + e]; modf[e] = s; } }
        __syncthreads();
        for (int m = gw; m < S; m += NGW) {
            const f32x4* xr = (const f32x4*)(xin + (size_t)m * DM) + lane;
            f32x4 v[8]; float ss = 0.f;
#pragma unroll
            for (int j = 0; j < 8; ++j) { v[j] = xr[64 * j]; ss += (v[j][0] * v[j][0] + v[j][1] * v[j][1]) + (v[j][2] * v[j][2] + v[j][3] * v[j][3]); }
            const float r = __builtin_amdgcn_rsqf(wave_sum(ss) * (1.0f / DM) + EPS);
            u32x2* o8 = (u32x2*)(hbuf + (size_t)m * DM) + lane;
#pragma unroll
            for (int j = 0; j < 8; ++j) { const int c = 4 * lane + 256 * j; const f32x4 gmv = *(const LAS f32x4*)(gm1 + c), shv = *(const LAS f32x4*)(sh1 + c);
                const f32x4 hval = v[j] * r * gmv + shv; u32x2 w; w.x = pk2(hval[0], hval[1]); w.y = pk2(hval[2], hval[3]); o8[64 * j] = w; }
        }
    }
    xcd_barrier(xbar);
    RELOAD_IDS();

#endif
#if PHMASK & 4
    {
        pg8::Gemm g{hbuf, W1t, 2048, 2048, 2048}; pg8::Sched<0> Sc; Sc.init(S, N1, G, bx);
        Epi1 E{qb, kb, vb, ub, gates, kmean, qng, kng, b_gate};
        pg8::gemm_phase_drain<Epi1>(lds, g, Sc, E);
    }
    xcd_barrier(xbar);
    RELOAD_IDS();

#endif
#if PHMASK & 8
    {
        LAS unsigned char* kmb = lds;
        LAS unsigned* hist = (LAS unsigned*)(lds + 32768); LAS unsigned* basep = hist + 64;
        for (int base = bx * 8; base < 2048; base += G * 8) {
            const int h = base >> 8;
            __syncthreads();
            { const int jr = tid >> 3, c0 = (tid & 7) * 16; const f32x4* src = (const f32x4*)(kmean + (size_t)h * 8192 + jr * 128 + c0);
              const f32x4 k0 = src[0], k1 = src[1], k2 = src[2], k3 = src[3];
              *(LAS u32x4*)(kmb + jr * KV_PITCH + c0 * 2) = pack8(k0, k1); *(LAS u32x4*)(kmb + jr * KV_PITCH + c0 * 2 + 16) = pack8(k2, k3); }
            if (tid < 64) hist[tid] = 0u;
            __syncthreads();
            const int item = base + wave, qgi = item & 255, own = qgi >> 2, ns = own < 3 ? own : 3;
            const int r32 = lane & 31, hh = lane >> 5;
            int selj[2][3]; unsigned selp[2][3];
#pragma unroll
            for (int sub = 0; sub < 2; ++sub) {
                const int qi = qgi * 64 + sub * 32 + r32;
                const bf16_t* qp = qb + (size_t)qi * 1024 + h * 128 + 8 * hh;
                f32x16 ac[2];
#pragma unroll
                for (int jt = 0; jt < 2; ++jt)
#pragma unroll
                    for (int i = 0; i < 16; ++i) ac[jt][i] = 0.f;
#pragma unroll
                for (int ks = 0; ks < 8; ++ks) { const bf16x8 qf = *(const bf16x8*)(qp + 16 * ks);
#pragma unroll
                    for (int jt = 0; jt < 2; ++jt) { const bf16x8 kf = *(const LAS bf16x8*)(kmb + (32 * jt + r32) * KV_PITCH + 32 * ks + 16 * hh);
                        ac[jt] = __builtin_amdgcn_mfma_f32_32x32x16_bf16(kf, qf, ac[jt], 0, 0, 0); } }
                float b0 = -3.0e38f, b1 = -3.0e38f, b2 = -3.0e38f; int i0 = 255, i1 = 255, i2 = 255;
#pragma unroll
                for (int jt = 0; jt < 2; ++jt)
#pragma unroll
                    for (int i = 0; i < 16; ++i) { const int j = 32 * jt + (i & 3) + 8 * (i >> 2) + 4 * hh; const float vj = (j < own) ? ac[jt][i] : -3.0e38f;
                        if (vj > b0) { b2 = b1; i2 = i1; b1 = b0; i1 = i0; b0 = vj; i0 = j; }
                        else if (vj > b1) { b2 = b1; i2 = i1; b1 = vj; i1 = j; }
                        else if (vj > b2) { b2 = vj; i2 = j; } }
                const float p0 = __shfl_xor(b0, 32), p1 = __shfl_xor(b1, 32), p2 = __shfl_xor(b2, 32);
                const int q0 = __shfl_xor(i0, 32), q1 = __shfl_xor(i1, 32), q2 = __shfl_xor(i2, 32);
#pragma unroll
                for (int t = 0; t < 3; ++t) { const float vj = t == 0 ? p0 : (t == 1 ? p1 : p2); const int j = t == 0 ? q0 : (t == 1 ? q1 : q2);
                    if (vj > b0 || (vj == b0 && j < i0)) { b2 = b1; i2 = i1; b1 = b0; i1 = i0; b0 = vj; i0 = j; }
                    else if (vj > b1 || (vj == b1 && j < i1)) { b2 = b1; i2 = i1; b1 = vj; i1 = j; }
                    else if (vj > b2 || (vj == b2 && j < i2)) { b2 = vj; i2 = j; } }
                selj[sub][0] = i0; selj[sub][1] = i1; selj[sub][2] = i2;
#pragma unroll
                for (int t = 0; t < 3; ++t) selp[sub][t] = (hh == 0 && t < ns) ? __hip_atomic_fetch_add((unsigned*)(hist + selj[sub][t]), 1u, __ATOMIC_RELAXED, __HIP_MEMORY_SCOPE_WORKGROUP) : 0u;
            }
            __syncthreads();
            if (tid < 64) { const unsigned c = hist[tid]; basep[tid] = c ? atomicAdd(cnt + h * 64 + tid, c) : 0u; }
            __syncthreads();
            if (hh == 0) {
#pragma unroll
                for (int sub = 0; sub < 2; ++sub)
#pragma unroll
                    for (int t = 0; t < 3; ++t) if (t < ns) { const int j = selj[sub][t]; const unsigned qi = (unsigned)(qgi * 64 + sub * 32 + r32);
                        qlist[(size_t)(h * 64 + j) * 16384 + basep[j] + selp[sub][t]] = qi * 4u + (unsigned)t; }
            }
        }
        for (int idx = vcu * NTHR + tid; idx < 2048 * 128; idx += G * NTHR) {
            const int cgi = idx & 127, rc = idx >> 7, w = 2 << (cgi >> 5), t0 = rc * 8;
            const bf16_t* up = ub + cgi * 8;
            float sum[8];
#pragma unroll
            for (int i = 0; i < 8; ++i) sum[i] = 0.f;
            for (int i = 1; i <= w; ++i) { const int t = t0 - i; if (t >= 0) { float f[8]; unpack8(*(const u32x4*)(up + (size_t)t * 1024), f);
#pragma unroll
                for (int e = 0; e < 8; ++e) sum[e] += f[e]; } }
#pragma unroll
            for (int t = t0; t < t0 + 8; ++t) {
                float f[8]; unpack8(*(const u32x4*)(up + (size_t)t * 1024), f);
#pragma unroll
                for (int e = 0; e < 8; ++e) sum[e] += f[e];
                if (t - w >= 0) { float o[8]; unpack8(*(const u32x4*)(up + (size_t)(t - w) * 1024), o);
#pragma unroll
                    for (int e = 0; e < 8; ++e) sum[e] -= o[e]; }
                const float inv = 1.0f / (float)((t + 1) < w ? (t + 1) : w);
                u32x4 o4; o4.x = pk2(sum[0] * inv - f[0], sum[1] * inv - f[1]); o4.y = pk2(sum[2] * inv - f[2], sum[3] * inv - f[3]);
                o4.z = pk2(sum[4] * inv - f[4], sum[5] * inv - f[5]); o4.w = pk2(sum[6] * inv - f[6], sum[7] * inv - f[7]);
                *(u32x4*)(dbuf + (size_t)t * 1024 + cgi * 8) = o4;
            }
        }
        for (int rho = gw; rho < NUP; rho += NGW) {
            float s = 0.f;
#pragma unroll
            for (int j = 0; j < 4; ++j) { const int k0 = j * 512 + lane * 8; float f[8]; unpack8(*(const u32x4*)(Wut + (size_t)rho * 2048 + k0), f);
                const f32x4 s0 = *(const f32x4*)(modf + 3 * 2048 + k0), s1 = *(const f32x4*)(modf + 3 * 2048 + k0 + 4);
                s += (f[0] * s0[0] + f[1] * s0[1]) + (f[2] * s0[2] + f[3] * s0[3]) + (f[4] * s1[0] + f[5] * s1[1]) + (f[6] * s1[2] + f[7] * s1[3]); }
            s = wave_sum(s);
            if (lane == 0) biasup[rho] = s;
        }
    }
    xcd_barrier(xbar);
    RELOAD_IDS();

#endif
#if PHMASK & 16
    {
        RELOAD_IDS();
        __syncthreads();
        LAS int* pre = (LAS int*)(lds + LDS_TAB); LAS int* tmp = pre + 520;
        { const int n = 1 + (int)((cnt[tid] + 255u) >> 8); tmp[tid] = n; __syncthreads();
          for (int o = 1; o < 512; o <<= 1) { const int v = tmp[tid] + (tid >= o ? tmp[tid - o] : 0); __syncthreads(); tmp[tid] = v; __syncthreads(); }
          pre[tid + 1] = tmp[tid]; if (tid == 0) pre[0] = 0; __syncthreads(); }
        const int total = pre[512];
        int lane_ = lane; asm volatile("" : "+v"(lane_));
        const int r32 = lane_ & 31, hh = lane_ >> 5, i16 = lane_ & 15, qq = i16 >> 2, pp = i16 & 3, blk = (lane_ >> 4) & 1;
#define ATT_DECODE(UN, HJ, LI) do { int lo_ = 0, hi_ = 511; while (lo_ < hi_) { const int mid_ = (lo_ + hi_ + 1) >> 1; if (pre[mid_] <= (UN)) lo_ = mid_; else hi_ = mid_ - 1; } HJ = lo_; LI = (UN) - pre[lo_]; } while (0)
#define ATT_KVLOAD(HJ) do { const int h_ = (HJ) >> 6, j_ = (HJ) & 63; const bf16_t* kg = kb + (size_t)(j_ * 256) * 1024 + h_ * 128; const bf16_t* vg = vb + (size_t)(j_ * 256) * 1024 + h_ * 128; \
        _Pragma("unroll") for (int i = 0; i < 8; ++i) { const int idx = tid + NTHR * i, row = idx >> 4, c16 = idx & 15; \
            kreg[i] = *(const u32x4*)(kg + (size_t)row * 1024 + c16 * 8); vreg[i] = *(const u32x4*)(vg + (size_t)row * 1024 + c16 * 8); } } while (0)
#define ATT_ENT(HJ, LI, ENT, NL) do { NL = ((LI) == 0) ? 256 : (int)cnt[HJ] - ((LI) - 1) * 256; const int e_ = wave * 32 + r32; \
        if ((LI) == 0) ENT = (unsigned)(((HJ) & 63) * 256 + e_) * 4u + 3u; else ENT = qlist[(size_t)(HJ) * 16384 + (size_t)((LI) - 1) * 256 + (e_ < NL ? e_ : 0)]; } while (0)
        u32x4 kreg[8], vreg[8];
        int hj = 0, li = 0, nlist = 0; unsigned ent = 0u;
        if (bx < total) { ATT_DECODE(bx, hj, li); ATT_KVLOAD(hj); ATT_ENT(hj, li, ent, nlist); }
        for (int un = bx; un < total; un += G) {
            const int h = hj >> 6, j = hj & 63;
            const bool ownu = (li == 0);
            const int e = wave * 32 + r32;
            const bool valid = e < nlist;
            const int qi = (int)(ent >> 2), slot = (int)(ent & 3u);
            const bf16_t* qp = qb + (size_t)qi * 1024 + h * 128 + 8 * hh;
            bf16x8 qf[8];
#pragma unroll
            for (int ks = 0; ks < 8; ++ks) qf[ks] = *(const bf16x8*)(qp + 16 * ks);
            __syncthreads();
#pragma unroll
            for (int i = 0; i < 8; ++i) { const int idx = tid + NTHR * i, row = idx >> 4, c16 = idx & 15;
                *(LAS u32x4*)(lds + LDS_KS + row * KV_PITCH + c16 * 16) = kreg[i]; *(LAS u32x4*)(lds + LDS_VS + row * KV_PITCH + c16 * 16) = vreg[i]; }
            __syncthreads();
            int hj2, li2, nlist2; unsigned ent2;
            { const int unn = (un + G < total) ? un + G : un; ATT_DECODE(unn, hj2, li2); ATT_KVLOAD(hj2); ATT_ENT(hj2, li2, ent2, nlist2); }
            if (wave * 32 < nlist) {
                const int nq = ownu ? ((wave * 32 + 31) >> 6) + 1 : 4;
                f32x16 o[4];
#pragma unroll
                for (int dt = 0; dt < 4; ++dt)
#pragma unroll
                    for (int i = 0; i < 16; ++i) o[dt][i] = 0.f;
                float lacc = 0.f;
                const int qloc = e;
#pragma unroll 1
                for (int hf = 0; hf < nq; ++hf) {
                    f32x16 sa[2];
#pragma unroll
                    for (int i = 0; i < 16; ++i) { sa[0][i] = 0.f; sa[1][i] = 0.f; }
                    {
                        const LAS unsigned char* kp0 = lds + LDS_KS + (64 * hf + r32) * KV_PITCH + 16 * hh;
                        const LAS unsigned char* kp1 = kp0 + 32 * KV_PITCH;
                        bf16x8 a0 = *(const LAS bf16x8*)kp0, a1 = *(const LAS bf16x8*)kp1;
#pragma unroll
                        for (int ks = 0; ks < 8; ++ks) {
                            bf16x8 n0 = a0, n1 = a1;
                            if (ks < 7) { n0 = *(const LAS bf16x8*)(kp0 + 32 * (ks + 1)); n1 = *(const LAS bf16x8*)(kp1 + 32 * (ks + 1)); }
                            sa[0] = __builtin_amdgcn_mfma_f32_32x32x16_bf16(a0, qf[ks], sa[0], 0, 0, 0);
                            sa[1] = __builtin_amdgcn_mfma_f32_32x32x16_bf16(a1, qf[ks], sa[1], 0, 0, 0);
                            a0 = n0; a1 = n1;
                        }
                    }
                    if (ownu) {
#pragma unroll
                        for (int kt = 0; kt < 2; ++kt)
#pragma unroll
                            for (int i = 0; i < 16; ++i) { const int key = 64 * hf + 32 * kt + (i & 3) + 8 * (i >> 2) + 4 * hh;
                                float pv = __builtin_amdgcn_exp2f(sa[kt][i]); if (key > qloc) pv = 0.f; sa[kt][i] = pv; lacc += pv; }
                    } else {
#pragma unroll
                        for (int kt = 0; kt < 2; ++kt)
#pragma unroll
                            for (int i = 0; i < 16; ++i) { const float pv = __builtin_amdgcn_exp2f(sa[kt][i]); sa[kt][i] = pv; lacc += pv; }
                    }
                    bf16x8 pb[4];
#pragma unroll
                    for (int st = 0; st < 4; ++st) { const int kt = st >> 1, s2 = st & 1;
                        u32x4 pw; pw.x = pk2(sa[kt][8 * s2 + 0], sa[kt][8 * s2 + 1]); pw.y = pk2(sa[kt][8 * s2 + 2], sa[kt][8 * s2 + 3]);
                        pw.z = pk2(sa[kt][8 * s2 + 4], sa[kt][8 * s2 + 5]); pw.w = pk2(sa[kt][8 * s2 + 6], sa[kt][8 * s2 + 7]);
                        pb[st] = __builtin_bit_cast(bf16x8, pw); }
                    const LAS unsigned char* vp = lds + LDS_VS + (64 * hf + 4 * hh + qq) * KV_PITCH + 32 * blk + 8 * pp;
                    s16x4 cl[4], ch[4];
#pragma unroll
                    for (int dt = 0; dt < 4; ++dt) { cl[dt] = vtr(vp + 64 * dt); ch[dt] = vtr(vp + 8 * KV_PITCH + 64 * dt); }
#pragma unroll
                    for (int st = 0; st < 4; ++st) {
                        s16x4 nl[4], nh[4];
#pragma unroll
                        for (int dt = 0; dt < 4; ++dt) { nl[dt] = cl[dt]; nh[dt] = ch[dt]; }
                        if (st < 3) { const LAS unsigned char* vn = vp + 16 * (st + 1) * KV_PITCH;
#pragma unroll
                            for (int dt = 0; dt < 4; ++dt) { nl[dt] = vtr(vn + 64 * dt); nh[dt] = vtr(vn + 8 * KV_PITCH + 64 * dt); } }
#pragma unroll
                        for (int dt = 0; dt < 4; ++dt) { const bf16x8 vf = __builtin_shufflevector(cl[dt], ch[dt], 0, 1, 2, 3, 4, 5, 6, 7);
                            o[dt] = __builtin_amdgcn_mfma_f32_32x32x16_bf16(vf, pb[st], o[dt], 0, 0, 0); }
#pragma unroll
                        for (int dt = 0; dt < 4; ++dt) { cl[dt] = nl[dt]; ch[dt] = nh[dt]; }
                    }
                }
                lacc += __shfl_xor(lacc, 32);
                u32x4 ow[8];
#pragma unroll
                for (int dt = 0; dt < 4; ++dt)
#pragma unroll
                    for (int gp2 = 0; gp2 < 2; ++gp2) { const int g0 = 2 * gp2, g1 = g0 + 1;
                        unsigned ax = pk2(o[dt][4 * g0], o[dt][4 * g0 + 1]), ay = pk2(o[dt][4 * g0 + 2], o[dt][4 * g0 + 3]);
                        unsigned bxw = pk2(o[dt][4 * g1], o[dt][4 * g1 + 1]), by = pk2(o[dt][4 * g1 + 2], o[dt][4 * g1 + 3]);
                        { const auto rsw = __builtin_amdgcn_permlane32_swap(ax, bxw, false, false); ax = rsw[0]; bxw = rsw[1]; }
                        { const auto rsw = __builtin_amdgcn_permlane32_swap(ay, by, false, false); ay = rsw[0]; by = rsw[1]; }
                        ow[dt * 2 + gp2] = (u32x4){ax, ay, bxw, by}; }
                if (valid) {
                    bf16_t* op = slots + ((size_t)qi * 4 + slot) * 1024 + h * 128 + 8 * hh;
#pragma unroll
                    for (int dt = 0; dt < 4; ++dt)
#pragma unroll
                        for (int gp2 = 0; gp2 < 2; ++gp2) *(u32x4*)(op + 32 * dt + 16 * gp2) = ow[dt * 2 + gp2];
                    if (hh == 0) lsum[((size_t)qi * 4 + slot) * 8 + h] = lacc;
                }
            }
            hj = hj2; li = li2; ent = ent2; nlist = nlist2;
        }
        RELOAD_IDS();
        for (int base = vcu * 8; base < 2048; base += G * 8) {
            const int gI = base >> 9;
            __syncthreads();
#pragma unroll
            for (int i = 0; i < 16; ++i) { const int idx = tid + NTHR * i, row = idx >> 5, c16 = idx & 31;
                *(LAS u32x4*)(lds + row * 528 + c16 * 16) = *(const u32x4*)(Wgt + (size_t)(gI * 256 + row) * 1024 + c16 * 8); }
            __syncthreads();
            const int item = base + wave, s0 = (item & 511) * 32, r = lane & 31, hh = lane >> 5;
            bf16x8 af[16];
            const bf16_t* ap = dbuf + (size_t)(s0 + r) * 1024 + gI * 256 + 8 * hh;
#pragma unroll
            for (int ks = 0; ks < 16; ++ks) af[ks] = *(const bf16x8*)(ap + 16 * ks);
#pragma unroll 1
            for (int nt = 0; nt < 8; nt += 2) {
                f32x16 ac[2];
#pragma unroll
                for (int i = 0; i < 16; ++i) { ac[0][i] = 0.f; ac[1][i] = 0.f; }
                const LAS unsigned char* bp = lds + (nt * 32 + r) * 528 + 16 * hh;
#pragma unroll
                for (int ks = 0; ks < 16; ++ks) { const bf16x8 b0 = *(const LAS bf16x8*)(bp + 32 * ks), b1 = *(const LAS bf16x8*)(bp + 32 * 528 + 32 * ks);
                    ac[0] = __builtin_amdgcn_mfma_f32_32x32x16_bf16(b0, af[ks], ac[0], 0, 0, 0); ac[1] = __builtin_amdgcn_mfma_f32_32x32x16_bf16(b1, af[ks], ac[1], 0, 0, 0); }
#pragma unroll
                for (int t2 = 0; t2 < 2; ++t2) {
                    bf16_t* op = am + (size_t)(s0 + r) * 2048 + 1024 + gI * 256 + (nt + t2) * 32 + 4 * hh;
#pragma unroll
                    for (int q4 = 0; q4 < 4; ++q4) { const f32x4 lsv = *(const f32x4*)(pscale + gI * 256 + (nt + t2) * 32 + 8 * q4 + 4 * hh);
                        u32x2 w; w.x = pk2(ac[t2][4 * q4] * lsv[0], ac[t2][4 * q4 + 1] * lsv[1]); w.y = pk2(ac[t2][4 * q4 + 2] * lsv[2], ac[t2][4 * q4 + 3] * lsv[3]); *(u32x2*)(op + 8 * q4) = w; }
                }
            }
        }
    }
    xcd_barrier(xbar);
    RELOAD_IDS();

#endif
#if PHMASK & 32
    {
    }
    RELOAD_IDS();
#pragma unroll 2
    for (int idx = vcu * NTHR + tid; idx < S * 128; idx += G * NTHR) {
        const int qi = idx >> 7, c8 = idx & 127, h = c8 >> 4, own = qi >> 8, ns = own < 3 ? own : 3;
        float a[8]; float l = 0.f;
#pragma unroll
        for (int i = 0; i < 8; ++i) a[i] = 0.f;
#pragma unroll
        for (int s = 0; s < 4; ++s) if (s == 3 || s < ns) { float f[8]; unpack8(*(const u32x4*)(slots + ((size_t)qi * 4 + s) * 1024 + c8 * 8), f);
#pragma unroll
            for (int i = 0; i < 8; ++i) a[i] += f[i];
            l += lsum[((size_t)qi * 4 + s) * 8 + h]; }
        const float inv = 1.0f / l;
        u32x4 w; w.x = pk2(a[0] * inv, a[1] * inv); w.y = pk2(a[2] * inv, a[3] * inv); w.z = pk2(a[4] * inv, a[5] * inv); w.w = pk2(a[6] * inv, a[7] * inv);
        *(u32x4*)(am + (size_t)qi * 2048 + c8 * 8) = w;
    }
    xcd_barrier(xbar);
    RELOAD_IDS();

#endif
#if PHMASK & 64
    { pg8::Gemm g{am, Wyt, 2048, 2048, 1024}; pg8::Sched<1> Sc; Sc.init(S, 2048, G, bx); Epi5 E{gates, merged}; pg8::gemm_phase<Epi5>(lds, g, Sc, E); }
    xcd_barrier(xbar);
    RELOAD_IDS();

#endif
#if PHMASK & 128
    { pg8::Gemm g{merged, Wot, 2048, 2048, 2048}; pg8::Sched<0> Sc; Sc.init(S, 2048, G, bx); Epi6 E{xin, outp, xg, modf, nfg, rowss}; pg8::gemm_phase<Epi6>(lds, g, Sc, E); }
    xcd_barrier(xbar);
    RELOAD_IDS();

#endif
#if PHMASK & 256
    for (int row = vcu * NTHR + tid; row < S; row += G * NTHR) { const f32x4* pr = (const f32x4*)(rowss + (size_t)row * 32); f32x4 sm = pr[0];
#pragma unroll
        for (int j = 1; j < 8; ++j) sm += pr[j];
        rsb[row] = __builtin_amdgcn_rsqf(((sm[0] + sm[1]) + (sm[2] + sm[3])) * (1.0f / 2048.0f) + EPS); }
    xcd_barrier(xbar);
    RELOAD_IDS();
    { pg8::Gemm g{xg, Wut, 2048, 2048, 2048}; pg8::Sched<0> Sc; Sc.init(S, NUP, G, bx); Epi7 E{rsb, biasup, conv_w, conv_b, act, edge}; pg8::gemm_phase_drain<Epi7>(lds, g, Sc, E); }
    xcd_barrier(xbar);
    RELOAD_IDS();

#endif
#if PHMASK & 512
    {
        pg8::Sched<0> Sf; Sf.init(S, 2048, G, bx);
        for (int ui = 0;; ++ui) {
            Unit uf; if (!Sf.next(ui, uf)) break;
            const int tl = uf.pm;
            for (int idx = tid; idx < DFF / 4; idx += NTHR) {
                const int c = idx * 4;
                f32x4 r0[2], r1[2];
#pragma unroll
                for (int bj = 0; bj < 2; ++bj) {
                    const int lc = bj * DFF + c;
                    const f32x4 z = (f32x4){0.f, 0.f, 0.f, 0.f};
                    const f32x4 pm2 = tl > 0 ? *(const f32x4*)(edge + ((size_t)((tl - 1) * 4 + 2)) * NUP + lc) : z;
                    const f32x4 pm1 = tl > 0 ? *(const f32x4*)(edge + ((size_t)((tl - 1) * 4 + 3)) * NUP + lc) : z;
                    const f32x4 e0 = *(const f32x4*)(edge + ((size_t)(tl * 4 + 0)) * NUP + lc), e1 = *(const f32x4*)(edge + ((size_t)(tl * 4 + 1)) * NUP + lc);
                    const f32x4 w0 = *(const f32x4*)(conv_w + lc), w1 = *(const f32x4*)(conv_w + NUP + lc), w2 = *(const f32x4*)(conv_w + 2 * NUP + lc), cbv = *(const f32x4*)(conv_b + lc);
                    r0[bj] = cbv + w0 * pm2 + w1 * pm1 + w2 * e0;
                    r1[bj] = cbv + w0 * pm1 + w1 * e0 + w2 * e1;
                }
                u32x2 o0, o1; float t0[4], t1[4];
#pragma unroll
                for (int i = 0; i < 4; ++i) { t0[i] = r0[0][i] * sigmoidf_(r0[0][i]) * r0[1][i]; t1[i] = r1[0][i] * sigmoidf_(r1[0][i]) * r1[1][i]; }
                o0.x = pk2(t0[0], t0[1]); o0.y = pk2(t0[2], t0[3]); o1.x = pk2(t1[0], t1[1]); o1.y = pk2(t1[2], t1[3]);
                *(u32x2*)(act + (size_t)(tl * 256) * DFF + c) = o0; *(u32x2*)(act + (size_t)(tl * 256 + 1) * DFF + c) = o1;
            }
        }
        asm volatile("s_waitcnt vmcnt(0)" ::: "memory");
        __syncthreads();
        RELOAD_IDS();
    }
    { pg8::Gemm g{act, Wdt, DFF, DFF, DFF}; pg8::Sched<0> Sc; Sc.init(S, 2048, G, bx); Epi9 E{outp, modf}; pg8::gemm_phase<Epi9>(lds, g, Sc, E); }
#endif
}

extern "C" void kernel_launch(void* const* d_in, const int* in_sizes, int n_in, void* d_out, int out_size, void* d_ws, size_t ws_size, hipStream_t stream) {
    static int grid_blocks = 0;
    if (grid_blocks == 0) {
        if (n_in != 20 || out_size != S * DM || ws_size < WS_END) { fprintf(stderr, "kernel_launch: unexpected shapes (n_in %d out %d ws %zu)\n", n_in, out_size, ws_size); grid_blocks = -1; return; }
        int dev = 0, cus = 0, per_cu = 0;
        hipGetDevice(&dev);
        hipDeviceGetAttribute(&cus, hipDeviceAttributeMultiprocessorCount, dev);
        hipFuncSetAttribute((const void*)fwd_megakernel, hipFuncAttributeMaxDynamicSharedMemorySize, LDS_BYTES);
        hipOccupancyMaxActiveBlocksPerMultiprocessor(&per_cu, (const void*)fwd_megakernel, NTHR, LDS_BYTES);
        if (per_cu < 1) { fprintf(stderr, "kernel_launch: occupancy query reports %d blocks per CU\n", per_cu); grid_blocks = -1; return; }
        if (per_cu > 1) per_cu = 1;
        grid_blocks = cus * per_cu;
        if (grid_blocks > 256) grid_blocks = 256;
    }
    if (grid_blocks < 0) return;
    Params p{};
    for (int i = 0; i < 20; ++i) p.in[i] = (const float*)d_in[i];
    p.out = (float*)d_out; p.ws = (unsigned char*)d_ws;
    void* args[] = {&p};
    hipError_t e = hipLaunchCooperativeKernel((const void*)fwd_megakernel, dim3(grid_blocks), dim3(NTHR), args, LDS_BYTES, stream);
    if (e != hipSuccess) fprintf(stderr, "cooperative launch failed: %s (grid %d)\n", hipGetErrorString(e), grid_blocks);
}
```

```cpp
#include <hip/hip_runtime.h>
#include <hip/hip_cooperative_groups.h>
#include <cstdio>
#include <cstdint>
namespace cg = cooperative_groups;

#define LAS __attribute__((address_space(3)))
#define DI __device__ __forceinline__
typedef unsigned short bf16_t;
typedef short bf16x8 __attribute__((ext_vector_type(8)));
typedef short s16x4 __attribute__((ext_vector_type(4)));
typedef float f32x2 __attribute__((ext_vector_type(2)));
typedef float f32x4 __attribute__((ext_vector_type(4)));
typedef float f32x16 __attribute__((ext_vector_type(16)));
typedef unsigned u32x2 __attribute__((ext_vector_type(2)));
typedef unsigned u32x4 __attribute__((ext_vector_type(4)));
typedef __bf16 bf16x2_t __attribute__((ext_vector_type(2)));

constexpr int S = 16384, DM = 2048, NH = 8, HD = 128, AW = 1024, PW = 1024, DFF = 5632, NUP = 2 * DFF, N1 = 8192;
constexpr float EPS = 1e-6f;
constexpr int NWAVES = 8, NTHR = 512;
constexpr int LDS_BYTES = 147456;
constexpr int XL_OFF = 131072;

constexpr size_t MiB = 1u << 20;
constexpr size_t WS_ZERO = 0, ZERO_BYTES = 1 * MiB;
constexpr size_t WS_CNT = 0, WS_KMEAN = 65536, WS_BAR = 524288;
constexpr size_t WS_MODP = 1 * MiB;
constexpr size_t WS_MODF = 2 * MiB;
constexpr size_t WS_BIASUP = 2 * MiB + 65536;
constexpr size_t WS_ROWSS = 3 * MiB;
constexpr size_t WS_LSUM = 5 * MiB;
constexpr size_t WS_LIST = 8 * MiB;
constexpr size_t WS_W1 = 40 * MiB;
constexpr size_t WS_WY = 72 * MiB;
constexpr size_t WS_WO = 80 * MiB;
constexpr size_t WS_WG = 88 * MiB;
constexpr size_t WS_WD = 90 * MiB;
constexpr size_t WS_WU = 112 * MiB;
constexpr size_t WS_HB = 156 * MiB;
constexpr size_t WS_Q = 220 * MiB, WS_K = 252 * MiB, WS_V = 284 * MiB, WS_U = 316 * MiB;
constexpr size_t WS_GATES = 348 * MiB;
constexpr size_t WS_DB = 476 * MiB;
constexpr size_t WS_AM = WS_HB;
constexpr size_t WS_MERGED = 284 * MiB;
constexpr size_t WS_XG = WS_HB;
constexpr size_t WS_ACT = 220 * MiB;
constexpr size_t WS_EDGE = 400 * MiB;
constexpr size_t WS_END = 508 * MiB;

__constant__ double ROPE_C[64] = {
1.59154943091895346e-01, 1.37822502603982849e-01, 1.19349370211248862e-01, 1.03352296618434064e-01,
8.94994016088910133e-02, 7.75032887553740585e-02, 6.71150830052272551e-02, 5.81192674418762462e-02,
5.03292121044870353e-02, 4.35833021053073297e-02, 3.77415847174197711e-02, 3.26828658723569976e-02,
2.83022014470915797e-02, 2.45087088680224316e-02, 2.12236869570126724e-02, 1.83789788427912383e-02,
1.59154943091895346e-02, 1.37822502603982859e-02, 1.19349370211248869e-02, 1.03352296618434061e-02,
8.94994016088910168e-03, 7.75032887553740620e-03, 6.71150830052272551e-03, 5.81192674418762497e-03,
5.03292121044870353e-03, 4.35833021053073314e-03, 3.77415847174197694e-03, 3.26828658723569993e-03,
2.83022014470915797e-03, 2.45087088680224316e-03, 2.12236869570126715e-03, 1.83789788427912387e-03,
1.59154943091895346e-03, 1.37822502603982855e-03, 1.19349370211248860e-03, 1.03352296618434065e-03,
8.94994016088910125e-04, 7.75032887553740577e-04, 6.71150830052272594e-04, 5.81192674418762454e-04,
5.03292121044870353e-04, 4.35833021053073336e-04, 3.77415847174197716e-04, 3.26828658723569971e-04,
2.83022014470915775e-04, 2.45087088680224327e-04, 2.12236869570126726e-04, 1.83789788427912376e-04,
1.59154943091895335e-04, 1.37822502603982850e-04, 1.19349370211248865e-04, 1.03352296618434062e-04,
8.94994016088910179e-05, 7.75032887553740523e-05, 6.71150830052272540e-05, 5.81192674418762481e-05,
5.03292121044870380e-05, 4.35833021053073309e-05, 3.77415847174197689e-05, 3.26828658723569984e-05,
2.83022014470915789e-05, 2.45087088680224307e-05, 2.12236869570126719e-05, 1.83789788427912390e-05 };

DI unsigned pk2(float lo, float hi) { f32x2 v = {lo, hi}; bf16x2_t b = __builtin_convertvector(v, bf16x2_t); return __builtin_bit_cast(unsigned, b); }
DI float bflo(unsigned w) { return __uint_as_float(w << 16); }
DI float bfhi(unsigned w) { return __uint_as_float(w & 0xffff0000u); }
DI void unpack8(const u32x4 w, float* f) { f[0] = bflo(w.x); f[1] = bfhi(w.x); f[2] = bflo(w.y); f[3] = bfhi(w.y); f[4] = bflo(w.z); f[5] = bfhi(w.z); f[6] = bflo(w.w); f[7] = bfhi(w.w); }
DI u32x4 pack8(const f32x4 a, const f32x4 b) { u32x4 w; w.x = pk2(a[0], a[1]); w.y = pk2(a[2], a[3]); w.z = pk2(b[0], b[1]); w.w = pk2(b[2], b[3]); return w; }
DI float wave_sum(float v) {
#pragma unroll
    for (int o = 1; o < 64; o <<= 1) v += __shfl_xor(v, o);
    return v;
}
DI float sigmoidf_(float x) { return __builtin_amdgcn_rcpf(1.0f + __builtin_amdgcn_exp2f(x * -1.4426950408889634f)); }
#define LDS_WAIT() asm volatile("s_waitcnt lgkmcnt(0)" ::: "memory")
#define FENCE() do { asm volatile("" ::: "memory"); __builtin_amdgcn_sched_barrier(0); } while (0)
#define TIE(var, dep) asm volatile("" : "+v"(var) : "v"(dep))
#define RAW_BAR() do { asm volatile("s_waitcnt lgkmcnt(0)" ::: "memory"); __builtin_amdgcn_s_barrier(); asm volatile("" ::: "memory"); } while (0)

#ifndef PG8_USE_SP2
#define PG8_USE_SP2 1
#endif
namespace pg8 {
constexpr int BM = 256, BK = 64, HALF = 128, HTB = HALF * BK * 2, STAGE_BYTES = 8 * HTB, NXCD = 8, WGM = 8;
__host__ __device__ __forceinline__ int lds_byte(int r, int c) { const int st = (r >> 4) * 2 + (c >> 5), rr = r & 15, cc = c & 31, ob = rr * 64 + cc * 2; return st * 1024 + (ob ^ (((ob >> 9) & 1) << 5)); }
__host__ __device__ __forceinline__ void stage_rc(int b, int& R, int& C) { const int st = b / 1024, sb = b % 1024, swz = sb ^ (((sb >> 9) & 1) << 5); R = (st >> 1) * 16 + swz / 64; C = (st & 1) * 32 + (swz % 64) / 2; }
__host__ __device__ __forceinline__ int perm32(int rho) { const int n = rho >> 4, i = rho & 15; return 8 * (i >> 2) + 4 * n + (i & 3); }

struct Unit { int pm, pn, ka, kb, aux; };
struct Gemm { const bf16_t* A; const bf16_t* Bt; int lda, ldb, K; };

template <int mode> struct Sched {
    int nM, nN, nwg, G, c;
    __device__ void init(int M, int N, int G_, int c_) { nM = M / BM; nN = N / BM; nwg = nM * nN; G = G_; c = c_; }
    __device__ bool next(int i, Unit& u) const {
        const int ii = (mode == 1) ? (i >> 1) : i;
        const long L = (long)ii * G + c; if (L >= nwg) return false;
        int wgid = (int)L; { const int q = nwg / NXCD, r = nwg % NXCD, xcd = wgid % NXCD, off = wgid / NXCD; wgid = (xcd < r ? xcd * (q + 1) : r * (q + 1) + (xcd - r) * q) + off; }
        const int nig = WGM * nN, gid = wgid / nig, fm = gid * WGM, gsz = (nM - fm) < WGM ? (nM - fm) : WGM;
        u.pm = fm + ((wgid % nig) % gsz); u.pn = (wgid % nig) / gsz;
        u.aux = (mode == 1) ? (i & 1) : 0; u.ka = (mode == 1) ? 1024 * (i & 1) : ((mode == 2) ? 256 * u.pn : 0); u.kb = (mode == 1) ? 1024 * (i & 1) : 0;
        return true;
    }
};

template <class Epi, class SchedT>
DI void gemm_phase(LAS unsigned char* lds, const Gemm g, const SchedT& S, const Epi& E) {
    int tid_ = threadIdx.x; asm volatile("" : "+v"(tid_));
    const int tid = tid_, wid = __builtin_amdgcn_readfirstlane(tid >> 6), lane = tid & 63, wr = wid >> 2, wc = wid & 3, fr = lane & 15, fq = lane >> 4;
    const int nt = g.K / BK;
    unsigned voffA, voffB;
    { int R, C; stage_rc(tid * 16, R, C); const int Rb = (R & ~31) + perm32(R & 31);
      voffA = (unsigned)(R * g.lda + C) * 2u; voffB = (unsigned)(Rb * g.ldb + C) * 2u; }
    const size_t dvoffA = (size_t)64 * g.lda * 2, dvoffB = (size_t)64 * g.ldb * 2;
    const size_t kstep = (size_t)(BK * 2);
    const size_t hstepA = (size_t)HALF * g.lda * 2, hstepB = (size_t)HALF * g.ldb * 2;
    const size_t tstepA = 2 * hstepA, tstepB = 2 * hstepB;
    const unsigned ldsw = (unsigned)wid * 1024u;
    const int aoff = lds_byte(wr * 64 + fr, fq * 8), boff = lds_byte(wc * 32 + fr, fq * 8);
#define PG8_SA(b, h) (((b) * 2 + (h)) * HTB)
#define PG8_SB(b, h) ((4 + (b) * 2 + (h)) * HTB)
#define PG8_STAGE(bufoff, gbase, voff) do { _Pragma("unroll") for (int _i = 0; _i < 2; ++_i) \
        __builtin_amdgcn_global_load_lds((const unsigned*)((const char*)(gbase) + (size_t)_i * d##voff + (voff)), (LAS unsigned*)(lds + (bufoff) + ldsw + _i * 8192), 16, 0, 0); } while (0)
#define PG8_LDA(dst, b, h) do { _Pragma("unroll") for (int m = 0; m < 4; ++m) _Pragma("unroll") for (int k = 0; k < 2; ++k) dst[m][k] = *(const LAS bf16x8*)(lds + PG8_SA(b, h) + aoff + m * 2048 + k * 1024); } while (0)
#define PG8_LDB(dst, b, h) do { _Pragma("unroll") for (int n = 0; n < 2; ++n) _Pragma("unroll") for (int k = 0; k < 2; ++k) dst[n][k] = *(const LAS bf16x8*)(lds + PG8_SB(b, h) + boff + n * 2048 + k * 1024); } while (0)
#define PG8_MMA(ai, bj, At, Bt) do { __builtin_amdgcn_s_setprio(1); _Pragma("unroll") for (int m = 0; m < 4; ++m) _Pragma("unroll") for (int n = 0; n < 2; ++n) _Pragma("unroll") for (int k = 0; k < 2; ++k) \
        acc[ai][bj][m][n] = __builtin_amdgcn_mfma_f32_16x16x32_bf16(Bt[n][k], At[m][k], acc[ai][bj][m][n], 0, 0, 0); __builtin_amdgcn_s_setprio(0); } while (0)
#define PG8_WAIT_V(n) asm volatile("s_waitcnt vmcnt(" #n ")" ::: "memory")
#define PG8_WAIT_L(n) asm volatile("s_waitcnt lgkmcnt(" #n ")" ::: "memory")
#define PG8_BAR __builtin_amdgcn_s_barrier()
#define PG8_SCHED __builtin_amdgcn_sched_barrier(0)
    Unit cur, nxt; int ui = 0;
    if (!S.next(0, cur)) return;
    f32x4 acc[2][2][4][2];
#pragma unroll
    for (int a = 0; a < 2; ++a)
#pragma unroll
        for (int b = 0; b < 2; ++b)
#pragma unroll
            for (int m = 0; m < 4; ++m)
#pragma unroll
                for (int n = 0; n < 2; ++n) acc[a][b][m][n] = (f32x4){0.f, 0.f, 0.f, 0.f};
    bf16x8 At[4][2], B0[2][2], B1[2][2];
    const char* cA = (const char*)g.A + (size_t)cur.pm * tstepA + (size_t)cur.ka * 2; const char* cB = (const char*)g.Bt + (size_t)cur.pn * tstepB + (size_t)cur.kb * 2;
#if PG8_USE_SP2
    PG8_STAGE(PG8_SB(0, 0), cB, voffB); PG8_STAGE(PG8_SB(0, 1), cB + hstepB, voffB); PG8_STAGE(PG8_SA(0, 0), cA, voffA); PG8_STAGE(PG8_SA(0, 1), cA + hstepA, voffA);
    if (wr == 1) PG8_BAR;
    PG8_WAIT_V(2); PG8_BAR;
#else
    PG8_STAGE(PG8_SB(0, 0), cB, voffB); PG8_STAGE(PG8_SA(0, 0), cA, voffA); PG8_STAGE(PG8_SB(0, 1), cB + hstepB, voffB); PG8_STAGE(PG8_SA(0, 1), cA + hstepA, voffA);
    if (wr == 1) PG8_BAR;
    PG8_WAIT_V(4); PG8_BAR;
#endif
    PG8_STAGE(PG8_SB(1, 0), cB + kstep, voffB); PG8_STAGE(PG8_SA(1, 0), cA + kstep, voffA); PG8_STAGE(PG8_SB(1, 1), cB + hstepB + kstep, voffB);
    PG8_WAIT_V(6); PG8_BAR;
    for (;;) {
        const bool has_next = S.next(ui + 1, nxt);
        const char* nA = has_next ? (const char*)g.A + (size_t)nxt.pm * tstepA + (size_t)nxt.ka * 2 : cA; const char* nB = has_next ? (const char*)g.Bt + (size_t)nxt.pn * tstepB + (size_t)nxt.kb * 2 : cB;
        for (int t = 0; t < nt; t += 2) {
            const bool last = (t == nt - 2);
            const char* a1 = cA + (size_t)(t + 1) * kstep;
            const char* a2 = last ? nA : cA + (size_t)(t + 2) * kstep; const char* b2 = last ? nB : cB + (size_t)(t + 2) * kstep;
            const char* a3 = a2 + kstep; const char* b3 = b2 + kstep;
#if PG8_USE_SP2
            PG8_LDB(B0, 0, 0); PG8_LDB(B1, 0, 1); PG8_SCHED; PG8_LDA(At, 0, 0); PG8_STAGE(PG8_SA(1, 1), a1 + hstepA, voffA);
            PG8_WAIT_V(8); PG8_WAIT_L(0); PG8_BAR; PG8_MMA(0, 0, At, B0); PG8_MMA(0, 1, At, B1); PG8_BAR; PG8_SCHED;
            PG8_LDA(At, 0, 1); PG8_STAGE(PG8_SB(0, 0), b2, voffB); PG8_STAGE(PG8_SB(0, 1), b2 + hstepB, voffB); PG8_STAGE(PG8_SA(0, 0), a2, voffA);
            PG8_WAIT_V(8); PG8_WAIT_L(0); PG8_BAR; PG8_MMA(1, 0, At, B0); PG8_MMA(1, 1, At, B1); PG8_BAR; PG8_SCHED;
            PG8_LDB(B0, 1, 0); PG8_LDB(B1, 1, 1); PG8_SCHED; PG8_LDA(At, 1, 0); PG8_STAGE(PG8_SA(0, 1), a2 + hstepA, voffA);
            PG8_WAIT_V(8); PG8_WAIT_L(0); PG8_BAR; PG8_MMA(0, 0, At, B0); PG8_MMA(0, 1, At, B1); PG8_BAR; PG8_SCHED;
            PG8_LDA(At, 1, 1); PG8_STAGE(PG8_SB(1, 0), b3, voffB); PG8_STAGE(PG8_SB(1, 1), b3 + hstepB, voffB); PG8_STAGE(PG8_SA(1, 0), a3, voffA);
            PG8_WAIT_V(8); PG8_WAIT_L(0); PG8_BAR; PG8_MMA(1, 0, At, B0); PG8_MMA(1, 1, At, B1); PG8_BAR; PG8_SCHED;
#else
            PG8_LDB(B0, 0, 0); PG8_SCHED; PG8_LDA(At, 0, 0); PG8_STAGE(PG8_SA(1, 1), a1 + hstepA, voffA);
            PG8_WAIT_L(8); PG8_BAR; PG8_WAIT_L(0); PG8_MMA(0, 0, At, B0); PG8_BAR; PG8_SCHED;
            PG8_LDB(B1, 0, 1); PG8_STAGE(PG8_SB(0, 0), b2, voffB);
            PG8_BAR; PG8_WAIT_L(0); PG8_MMA(0, 1, At, B1); PG8_BAR;
            PG8_LDA(At, 0, 1); PG8_STAGE(PG8_SA(0, 0), a2, voffA);
            PG8_BAR; PG8_WAIT_L(0); PG8_MMA(1, 0, At, B0); PG8_BAR; PG8_SCHED;
            PG8_STAGE(PG8_SB(0, 1), b2 + hstepB, voffB);
            PG8_WAIT_V(6); PG8_BAR; PG8_MMA(1, 1, At, B1); PG8_BAR;
            PG8_LDB(B0, 1, 0); PG8_SCHED; PG8_LDA(At, 1, 0); PG8_STAGE(PG8_SA(0, 1), a2 + hstepA, voffA);
            PG8_WAIT_L(8); PG8_BAR; PG8_WAIT_L(0); PG8_MMA(0, 0, At, B0); PG8_BAR; PG8_SCHED;
            PG8_LDB(B1, 1, 1); PG8_STAGE(PG8_SB(1, 0), b3, voffB);
            PG8_BAR; PG8_WAIT_L(0); PG8_MMA(0, 1, At, B1); PG8_BAR;
            PG8_LDA(At, 1, 1); PG8_STAGE(PG8_SA(1, 0), a3, voffA);
            PG8_BAR; PG8_WAIT_L(0); PG8_MMA(1, 0, At, B0); PG8_BAR; PG8_SCHED;
            PG8_STAGE(PG8_SB(1, 1), b3 + hstepB, voffB);
            PG8_WAIT_V(6); PG8_BAR; PG8_MMA(1, 1, At, B1); PG8_BAR;
#endif
        }
        if (wr == 0) PG8_BAR;
        { int l2 = threadIdx.x; asm volatile("" : "+v"(l2)); l2 &= 63;
          E(acc, cur, wr, wc, l2 & 15, l2 >> 4, lds + XL_OFF); }
        if (!has_next) break;
        if (!(Epi::CHAIN && cur.aux == 0)) {
#pragma unroll
            for (int a = 0; a < 2; ++a)
#pragma unroll
                for (int b = 0; b < 2; ++b)
#pragma unroll
                    for (int m = 0; m < 4; ++m)
#pragma unroll
                        for (int n = 0; n < 2; ++n) acc[a][b][m][n] = (f32x4){0.f, 0.f, 0.f, 0.f};
        }
        cur = nxt; cA = nA; cB = nB; ++ui;
        if (wr == 1) PG8_BAR;
    }
    PG8_WAIT_V(0);
    PG8_BAR;
}

template <class Epi, class SchedT>
DI void gemm_phase_drain(LAS unsigned char* lds, const Gemm g, const SchedT& S, const Epi& E) {
    int tid_ = threadIdx.x; asm volatile("" : "+v"(tid_));
    const int tid = tid_, wid = __builtin_amdgcn_readfirstlane(tid >> 6), lane = tid & 63, wr = wid >> 2, wc = wid & 3, fr = lane & 15, fq = lane >> 4;
    const int nt = g.K / BK;
    unsigned voffA, voffB;
    { int R, C; stage_rc(tid * 16, R, C); const int Rb = (R & ~31) + perm32(R & 31);
      voffA = (unsigned)(R * g.lda + C) * 2u; voffB = (unsigned)(Rb * g.ldb + C) * 2u; }
    const size_t dvoffA = (size_t)64 * g.lda * 2, dvoffB = (size_t)64 * g.ldb * 2;
    const size_t kstep = (size_t)(BK * 2);
    const size_t hstepA = (size_t)HALF * g.lda * 2, hstepB = (size_t)HALF * g.ldb * 2;
    const size_t tstepA = 2 * hstepA, tstepB = 2 * hstepB;
    const unsigned ldsw = (unsigned)wid * 1024u;
    const int aoff = lds_byte(wr * 64 + fr, fq * 8), boff = lds_byte(wc * 32 + fr, fq * 8);
    bool primed = false; Unit cur, nxt;
    bool have = S.next(0, cur);
    for (int ui = 0; have; ++ui) {
        f32x4 acc[2][2][4][2];
#pragma unroll
        for (int a = 0; a < 2; ++a)
#pragma unroll
            for (int b = 0; b < 2; ++b)
#pragma unroll
                for (int m = 0; m < 4; ++m)
#pragma unroll
                    for (int n = 0; n < 2; ++n) acc[a][b][m][n] = (f32x4){0.f, 0.f, 0.f, 0.f};
        bf16x8 At[4][2], B0[2][2], B1[2][2];
        const char* cA = (const char*)g.A + (size_t)cur.pm * tstepA + (size_t)cur.ka * 2; const char* cB = (const char*)g.Bt + (size_t)cur.pn * tstepB + (size_t)cur.kb * 2;
        if (!primed) {
#if PG8_USE_SP2
        PG8_STAGE(PG8_SB(0, 0), cB, voffB); PG8_STAGE(PG8_SB(0, 1), cB + hstepB, voffB); PG8_STAGE(PG8_SA(0, 0), cA, voffA); PG8_STAGE(PG8_SA(0, 1), cA + hstepA, voffA);
        if (wr == 1) PG8_BAR;
        PG8_WAIT_V(2); PG8_BAR;
#else
        PG8_STAGE(PG8_SB(0, 0), cB, voffB); PG8_STAGE(PG8_SA(0, 0), cA, voffA); PG8_STAGE(PG8_SB(0, 1), cB + hstepB, voffB); PG8_STAGE(PG8_SA(0, 1), cA + hstepA, voffA);
        if (wr == 1) PG8_BAR;
        PG8_WAIT_V(4); PG8_BAR;
#endif
        PG8_STAGE(PG8_SB(1, 0), cB + kstep, voffB); PG8_STAGE(PG8_SA(1, 0), cA + kstep, voffA); PG8_STAGE(PG8_SB(1, 1), cB + hstepB + kstep, voffB);
        PG8_WAIT_V(6); PG8_BAR;
        }
        const bool has_next = S.next(ui + 1, nxt); const bool pf = has_next && !E.uses_lds(cur);
        const char* nA = pf ? (const char*)g.A + (size_t)nxt.pm * tstepA + (size_t)nxt.ka * 2 : cA; const char* nB = pf ? (const char*)g.Bt + (size_t)nxt.pn * tstepB + (size_t)nxt.kb * 2 : cB;
        for (int t = 0; t < nt; t += 2) {
            const bool last = (t == nt - 2);
            const char* a1 = cA + (size_t)(t + 1) * kstep;
            const char* a2 = last ? nA : cA + (size_t)(t + 2) * kstep; const char* b2 = last ? nB : cB + (size_t)(t + 2) * kstep;
            const char* a3 = a2 + kstep; const char* b3 = b2 + kstep;
#if PG8_USE_SP2
            PG8_LDB(B0, 0, 0); PG8_LDB(B1, 0, 1); PG8_SCHED; PG8_LDA(At, 0, 0); PG8_STAGE(PG8_SA(1, 1), a1 + hstepA, voffA);
            PG8_WAIT_V(8); PG8_WAIT_L(0); PG8_BAR; PG8_MMA(0, 0, At, B0); PG8_MMA(0, 1, At, B1); PG8_BAR; PG8_SCHED;
            PG8_LDA(At, 0, 1); PG8_STAGE(PG8_SB(0, 0), b2, voffB); PG8_STAGE(PG8_SB(0, 1), b2 + hstepB, voffB); PG8_STAGE(PG8_SA(0, 0), a2, voffA);
            PG8_WAIT_V(8); PG8_WAIT_L(0); PG8_BAR; PG8_MMA(1, 0, At, B0); PG8_MMA(1, 1, At, B1); PG8_BAR; PG8_SCHED;
            PG8_LDB(B0, 1, 0); PG8_LDB(B1, 1, 1); PG8_SCHED; PG8_LDA(At, 1, 0); PG8_STAGE(PG8_SA(0, 1), a2 + hstepA, voffA);
            PG8_WAIT_V(8); PG8_WAIT_L(0); PG8_BAR; PG8_MMA(0, 0, At, B0); PG8_MMA(0, 1, At, B1); PG8_BAR; PG8_SCHED;
            PG8_LDA(At, 1, 1); PG8_STAGE(PG8_SB(1, 0), b3, voffB); PG8_STAGE(PG8_SB(1, 1), b3 + hstepB, voffB); PG8_STAGE(PG8_SA(1, 0), a3, voffA);
            PG8_WAIT_V(8); PG8_WAIT_L(0); PG8_BAR; PG8_MMA(1, 0, At, B0); PG8_MMA(1, 1, At, B1); PG8_BAR; PG8_SCHED;
#else
            PG8_LDB(B0, 0, 0); PG8_SCHED; PG8_LDA(At, 0, 0); PG8_STAGE(PG8_SA(1, 1), a1 + hstepA, voffA);
            PG8_WAIT_L(8); PG8_BAR; PG8_WAIT_L(0); PG8_MMA(0, 0, At, B0); PG8_BAR; PG8_SCHED;
            PG8_LDB(B1, 0, 1); PG8_STAGE(PG8_SB(0, 0), b2, voffB);
            PG8_BAR; PG8_WAIT_L(0); PG8_MMA(0, 1, At, B1); PG8_BAR;
            PG8_LDA(At, 0, 1); PG8_STAGE(PG8_SA(0, 0), a2, voffA);
            PG8_BAR; PG8_WAIT_L(0); PG8_MMA(1, 0, At, B0); PG8_BAR; PG8_SCHED;
            PG8_STAGE(PG8_SB(0, 1), b2 + hstepB, voffB);
            PG8_WAIT_V(6); PG8_BAR; PG8_MMA(1, 1, At, B1); PG8_BAR;
            PG8_LDB(B0, 1, 0); PG8_SCHED; PG8_LDA(At, 1, 0); PG8_STAGE(PG8_SA(0, 1), a2 + hstepA, voffA);
            PG8_WAIT_L(8); PG8_BAR; PG8_WAIT_L(0); PG8_MMA(0, 0, At, B0); PG8_BAR; PG8_SCHED;
            PG8_LDB(B1, 1, 1); PG8_STAGE(PG8_SB(1, 0), b3, voffB);
            PG8_BAR; PG8_WAIT_L(0); PG8_MMA(0, 1, At, B1); PG8_BAR;
            PG8_LDA(At, 1, 1); PG8_STAGE(PG8_SA(1, 0), a3, voffA);
            PG8_BAR; PG8_WAIT_L(0); PG8_MMA(1, 0, At, B0); PG8_BAR; PG8_SCHED;
            PG8_STAGE(PG8_SB(1, 1), b3 + hstepB, voffB);
            PG8_WAIT_V(6); PG8_BAR; PG8_MMA(1, 1, At, B1); PG8_BAR;
#endif
        }
        if (wr == 0) PG8_BAR;
        if (pf) {
            { int t2 = threadIdx.x; asm volatile("" : "+v"(t2)); E.drain(acc, cur, wr, wc, t2 & 15, (t2 & 63) >> 4, lds, t2); }
            if (wr == 1) PG8_BAR;
            primed = true;
        } else {
            PG8_WAIT_V(0); PG8_WAIT_L(0); PG8_BAR;
            { int t2 = threadIdx.x; asm volatile("" : "+v"(t2)); E.drain(acc, cur, wr, wc, t2 & 15, (t2 & 63) >> 4, lds, t2); }
            PG8_WAIT_L(0); PG8_BAR;
            primed = false;
        }
        have = has_next; cur = nxt;
    }
#undef PG8_SA
#undef PG8_SB
#undef PG8_STAGE
#undef PG8_LDA
#undef PG8_LDB
#undef PG8_MMA
#undef PG8_WAIT_V
#undef PG8_WAIT_L
#undef PG8_BAR
#undef PG8_SCHED
}
}
using pg8::Unit;
typedef f32x4 AccT[2][2][4][2];

constexpr int PT = 260;
struct Epi1 {
    static constexpr bool CHAIN = false;
    DI bool uses_lds(const Unit& u) const { return u.pn < 8; }
    bf16_t *q, *k, *v, *ub, *gates; float* kmean; const float *qg, *kg, *bgate;
    DI void drain(AccT& acc, const Unit& u, int wr, int wc, int fr, int fq, LAS unsigned char* lds, int tid) const {
        const int pn = u.pn; const int rowb = u.pm * 256 + wr * 64 + fr;
        bf16_t *pq = q, *pk = k, *pv = v, *pu = ub, *pg = gates; const float *pqg = qg, *pkg = kg;
        asm volatile("" : "+s"(pq), "+s"(pk), "+s"(pv), "+s"(pu), "+s"(pg), "+s"(pqg), "+s"(pkg));
        if (pn >= 16) {
            const int c0 = (pn - 16) * 128 + wc * 32 + fq * 8;
            f32x4 ba[2], bb[2];
#pragma unroll
            for (int n = 0; n < 2; ++n) { ba[n] = *(const f32x4*)(bgate + c0 + 4 * n); bb[n] = *(const f32x4*)(bgate + 2048 + c0 + 4 * n); }
#pragma unroll
            for (int ai = 0; ai < 2; ++ai)
#pragma unroll
                for (int m = 0; m < 4; ++m) { bf16_t* rowp = pg + (size_t)(rowb + ai * 128 + m * 16) * 4096 + c0;
                    f32x4 rr[2], gg[2];
#pragma unroll
                    for (int n = 0; n < 2; ++n)
#pragma unroll
                        for (int i = 0; i < 4; ++i) { const float ea = __builtin_amdgcn_exp2f((acc[ai][0][m][n][i] + ba[n][i]) * -1.4426950408889634f), eb = __builtin_amdgcn_exp2f((acc[ai][1][m][n][i] + bb[n][i]) * -1.4426950408889634f);
                            gg[n][i] = __builtin_amdgcn_rcpf(1.0f + eb); rr[n][i] = (1.0f + eb) * __builtin_amdgcn_rcpf(1.0f + ea); }
                    *(u32x4*)rowp = pack8(rr[0], rr[1]); *(u32x4*)(rowp + 2048) = pack8(gg[0], gg[1]); }
            return;
        }
        if (pn >= 8) {
            bf16_t* base; int ldc, col0; const bool sig = false;
            if (pn < 12) { base = pv; ldc = 1024; col0 = (pn - 8) * 256; } else { base = pu; ldc = 1024; col0 = (pn - 12) * 256; }
            col0 += wc * 32 + fq * 8;
            f32x4 bv[2][2];
#pragma unroll
            for (int bj = 0; bj < 2; ++bj)
#pragma unroll
                for (int n = 0; n < 2; ++n) bv[bj][n] = sig ? *(const f32x4*)(bgate + col0 + bj * 128 + 4 * n) : (f32x4){0.f, 0.f, 0.f, 0.f};
#pragma unroll
            for (int ai = 0; ai < 2; ++ai)
#pragma unroll
                for (int m = 0; m < 4; ++m) { bf16_t* rowp = base + (size_t)(rowb + ai * 128 + m * 16) * ldc + col0;
#pragma unroll
                    for (int bj = 0; bj < 2; ++bj) { f32x4 v0 = acc[ai][bj][m][0] + bv[bj][0], v1 = acc[ai][bj][m][1] + bv[bj][1];
                        if (sig) {
#pragma unroll
                            for (int i = 0; i < 4; ++i) { v0[i] = sigmoidf_(v0[i]); v1[i] = sigmoidf_(v1[i]); } }
                        *(u32x4*)(rowp + bj * 128) = pack8(v0, v1); } }
            return;
        }
        const bool isq = pn < 4; const int hp = (pn & 3) * 2;
        const float* g = isq ? pqg : pkg; bf16_t* dst = isq ? pq : pk;
        const float qs = isq ? 0.08838834764831845f * 1.4426950408889634f : 1.0f;
        LAS float* T = (LAS float*)lds;
        const int r = tid >> 2, part = tid & 3, bj2 = part >> 1, sub = part & 1;
        float ksum = 0.f;
#pragma unroll
        for (int ai = 0; ai < 2; ++ai) {
#pragma unroll
            for (int m = 0; m < 4; ++m)
#pragma unroll
                for (int bj = 0; bj < 2; ++bj)
#pragma unroll
                    for (int n = 0; n < 2; ++n) *(LAS f32x4*)(T + (64 * wr + 16 * m + fr) * PT + 128 * bj + 32 * wc + 8 * fq + 4 * n) = acc[ai][bj][m][n];
            RAW_BAR();
            LAS float* rowp = T + r * PT + 128 * bj2 + 32 * sub;
            float ss = 0.f;
#pragma unroll
            for (int j = 0; j < 8; ++j) { const f32x4 a = *(const LAS f32x4*)(rowp + 4 * j), b = *(const LAS f32x4*)(rowp + 64 + 4 * j);
                ss += (a[0] * a[0] + a[1] * a[1]) + (a[2] * a[2] + a[3] * a[3]) + (b[0] * b[0] + b[1] * b[1]) + (b[2] * b[2] + b[3] * b[3]); }
            ss += __shfl_xor(ss, 1);
            const float rr = __builtin_amdgcn_rsqf(ss * (1.0f / 128.0f) + EPS) * qs;
            const int row = u.pm * 256 + ai * 128 + r;
            bf16_t* op = dst + (size_t)row * 1024 + (hp + bj2) * 128 + 32 * sub;
#pragma unroll 1
            for (int j = 0; j < 8; j += 2) {
                f32x4 o1[2], o2[2];
#pragma unroll
                for (int jj = 0; jj < 2; ++jj) {
                    const int d = 32 * sub + 4 * (j + jj);
                    const f32x4 x1 = *(const LAS f32x4*)(rowp + 4 * (j + jj)), x2 = *(const LAS f32x4*)(rowp + 64 + 4 * (j + jj));
                    const f32x4 g0 = *(const f32x4*)(g + d), g1 = *(const f32x4*)(g + 64 + d);
                    f32x4 cs, sn;
#pragma unroll
                    for (int i = 0; i < 4; ++i) { double t = (double)row * ROPE_C[d + i]; t -= __builtin_floor(t); const float tf = (float)t; cs[i] = __builtin_amdgcn_cosf(tf); sn[i] = __builtin_amdgcn_sinf(tf); }
                    const f32x4 a = x1 * rr * g0, b = x2 * rr * g1;
                    o1[jj] = a * cs - b * sn; o2[jj] = b * cs + a * sn;
                    if (!isq) { *(LAS f32x4*)(rowp + 4 * (j + jj)) = o1[jj]; *(LAS f32x4*)(rowp + 64 + 4 * (j + jj)) = o2[jj]; }
                }
                *(u32x4*)(op + 4 * j) = pack8(o1[0], o1[1]); *(u32x4*)(op + 64 + 4 * j) = pack8(o2[0], o2[1]);
            }
            if (!isq) { RAW_BAR(); if (tid < 256) {
#pragma unroll 8
                for (int rr2 = 0; rr2 < 128; ++rr2) ksum += T[rr2 * PT + tid]; } }
            RAW_BAR();
        }
        if (!isq && tid < 256) kmean[((size_t)(hp + (tid >> 7)) * 64 + u.pm) * 128 + (tid & 127)] = ksum * (1.0f / 256.0f);
    }
};

struct Epi3 {
    static constexpr bool CHAIN = false;
    bf16_t* am; const float* ls;
    DI void drain(AccT& acc, const Unit& u, int wr, int wc, int fr, int fq, LAS unsigned char* l, int) const { (*this)(acc, u, wr, wc, fr, fq, l); }
    DI void operator()(AccT& acc, const Unit& u, int wr, int wc, int fr, int fq, LAS unsigned char*) const {
        const int col0 = u.pn * 256 + wc * 32 + fq * 8; const int rowb = u.pm * 256 + wr * 64 + fr;
        f32x4 sv[2][2];
#pragma unroll
        for (int bj = 0; bj < 2; ++bj)
#pragma unroll
            for (int n = 0; n < 2; ++n) sv[bj][n] = *(const f32x4*)(ls + col0 + bj * 128 + 4 * n);
#pragma unroll
        for (int ai = 0; ai < 2; ++ai)
#pragma unroll
            for (int m = 0; m < 4; ++m) { bf16_t* rowp = am + (size_t)(rowb + ai * 128 + m * 16) * 2048 + 1024 + col0;
#pragma unroll
                for (int bj = 0; bj < 2; ++bj) *(u32x4*)(rowp + bj * 128) = pack8(acc[ai][bj][m][0] * sv[bj][0], acc[ai][bj][m][1] * sv[bj][1]); }
    }
};

struct Epi5 {
    static constexpr bool CHAIN = true;
    const bf16_t* gates; bf16_t* merged;
    DI void operator()(AccT& acc, const Unit& u, int wr, int wc, int fr, int fq, LAS unsigned char*) const {
        const int col0 = u.pn * 256 + wc * 32 + fq * 8; const int rowb = u.pm * 256 + wr * 64 + fr;
        if (u.aux == 0) {
#pragma unroll
            for (int ai = 0; ai < 2; ++ai) {
                u32x4 gw[4][2];
#pragma unroll
                for (int m = 0; m < 4; ++m)
#pragma unroll
                    for (int bj = 0; bj < 2; ++bj) gw[m][bj] = *(const u32x4*)(gates + (size_t)(rowb + ai * 128 + m * 16) * 4096 + col0 + bj * 128);
#pragma unroll
                for (int m = 0; m < 4; ++m)
#pragma unroll
                    for (int bj = 0; bj < 2; ++bj) { float gr[8]; unpack8(gw[m][bj], gr);
#pragma unroll
                        for (int i = 0; i < 4; ++i) { acc[ai][bj][m][0][i] *= gr[i]; acc[ai][bj][m][1][i] *= gr[4 + i]; } }
                FENCE();
            }
        } else {
#pragma unroll
            for (int ai = 0; ai < 2; ++ai) {
                u32x4 gw[4][2];
#pragma unroll
                for (int m = 0; m < 4; ++m)
#pragma unroll
                    for (int bj = 0; bj < 2; ++bj) gw[m][bj] = *(const u32x4*)(gates + (size_t)(rowb + ai * 128 + m * 16) * 4096 + 2048 + col0 + bj * 128);
#pragma unroll
                for (int m = 0; m < 4; ++m)
#pragma unroll
                    for (int bj = 0; bj < 2; ++bj) { float gp[8]; unpack8(gw[m][bj], gp); f32x4 v0, v1;
#pragma unroll
                        for (int i = 0; i < 4; ++i) { v0[i] = acc[ai][bj][m][0][i] * gp[i]; v1[i] = acc[ai][bj][m][1][i] * gp[4 + i]; }
                        *(u32x4*)(merged + (size_t)(rowb + ai * 128 + m * 16) * 2048 + col0 + bj * 128) = pack8(v0, v1); }
                FENCE();
            }
        }
    }
};

struct Epi6 {
    static constexpr bool CHAIN = false;
    const float* x; float* out; bf16_t* xg; const float* modf; const float* nfg; float* rowss;
    DI void operator()(AccT& acc, const Unit& u, int wr, int wc, int fr, int fq, LAS unsigned char*) const {
        const int col0 = u.pn * 256 + wc * 32 + fq * 8; const int rowb = u.pm * 256 + wr * 64 + fr;
        f32x4 g1v[2][2], gmv[2][2];
#pragma unroll
        for (int bj = 0; bj < 2; ++bj)
#pragma unroll
            for (int n = 0; n < 2; ++n) { const int c = col0 + bj * 128 + 4 * n; g1v[bj][n] = *(const f32x4*)(modf + 2 * 2048 + c);
                gmv[bj][n] = *(const f32x4*)(nfg + c) * (*(const f32x4*)(modf + 4 * 2048 + c) + 1.0f); }
#pragma unroll
        for (int ag = 0; ag < 4; ++ag) { const int ai = ag >> 1, m0 = (ag & 1) * 2;
            f32x4 xr[4][2][2];
#pragma unroll
            for (int m = m0; m < m0 + 2; ++m)
#pragma unroll
                for (int bj = 0; bj < 2; ++bj) { const size_t off = (size_t)(rowb + ai * 128 + m * 16) * 2048 + col0 + bj * 128;
                    xr[m][bj][0] = *(const f32x4*)(x + off); xr[m][bj][1] = *(const f32x4*)(x + off + 4); }
            FENCE();
#pragma unroll
            for (int m = m0; m < m0 + 2; ++m) { const size_t row = (size_t)(rowb + ai * 128 + m * 16); float ss = 0.f;
#pragma unroll
                for (int bj = 0; bj < 2; ++bj) { const size_t off = row * 2048 + col0 + bj * 128;
                    const f32x4 y0 = xr[m][bj][0] + g1v[bj][0] * acc[ai][bj][m][0], y1 = xr[m][bj][1] + g1v[bj][1] * acc[ai][bj][m][1];
                    *(f32x4*)(out + off) = y0; *(f32x4*)(out + off + 4) = y1;
                    *(u32x4*)(xg + off) = pack8(y0 * gmv[bj][0], y1 * gmv[bj][1]);
                    ss += (y0[0] * y0[0] + y0[1] * y0[1]) + (y0[2] * y0[2] + y0[3] * y0[3]) + (y1[0] * y1[0] + y1[1] * y1[1]) + (y1[2] * y1[2] + y1[3] * y1[3]); }
                ss += __shfl_xor(ss, 16); ss += __shfl_xor(ss, 32);
                if (fq == 0) rowss[row * 32 + u.pn * 4 + wc] = ss; }
            FENCE();
        }
    }
};

struct Epi7 {
    static constexpr bool CHAIN = false;
    DI bool uses_lds(const Unit&) const { return true; }
    const float* rsb; const float* biasup; const float* cw; const float* cb; bf16_t* act; float* edge;
    DI void drain(AccT& acc, const Unit& u, int wr, int wc, int fr, int fq, LAS unsigned char* lds, int tid) const {
        LAS float* T = (LAS float*)lds;
        const int cgi = tid & 15, rg = tid >> 4;
        const int lcb = u.pn * 128;
#pragma unroll
        for (int ai = 0; ai < 2; ++ai) {
            {
                float rs[4];
#pragma unroll
                for (int m = 0; m < 4; ++m) rs[m] = rsb[u.pm * 256 + ai * 128 + 64 * wr + 16 * m + fr];
#pragma unroll
                for (int bj = 0; bj < 2; ++bj)
#pragma unroll
                    for (int n = 0; n < 2; ++n) { const f32x4 bi = *(const f32x4*)(biasup + u.pn * 256 + 128 * bj + 32 * wc + 8 * fq + 4 * n);
#pragma unroll
                        for (int m = 0; m < 4; ++m) *(LAS f32x4*)(T + (2 + 64 * wr + 16 * m + fr) * PT + 128 * bj + 32 * wc + 8 * fq + 4 * n) = acc[ai][bj][m][n] * rs[m] + bi; }
            }
            RAW_BAR();
            {
                const int cg8 = (tid >> 1) & 15, h4 = tid & 1, rgi = tid >> 5;
                const int cc = 8 * cg8 + 4 * h4, lca = lcb + cc, lcbb = DFF + lcb + cc;
                const f32x4 wa0 = *(const f32x4*)(cw + lca), wa1 = *(const f32x4*)(cw + NUP + lca), wa2 = *(const f32x4*)(cw + 2 * NUP + lca), ca0 = *(const f32x4*)(cb + lca);
                const f32x4 wb0 = *(const f32x4*)(cw + lcbb), wb1 = *(const f32x4*)(cw + NUP + lcbb), wb2 = *(const f32x4*)(cw + 2 * NUP + lcbb), cb0 = *(const f32x4*)(cb + lcbb);
#pragma unroll 1
                for (int ch = 0; ch < 2; ++ch) {
                    const int r0 = 8 * rgi + 4 * ch;
                    f32x4 xa[6], xb[6];
#pragma unroll
                    for (int kx = 0; kx < 6; ++kx) { xa[kx] = *(const LAS f32x4*)(T + (r0 + kx) * PT + cc); xb[kx] = *(const LAS f32x4*)(T + (r0 + kx) * PT + 128 + cc); }
                    u32x2 pw[4];
#pragma unroll
                    for (int kx = 0; kx < 4; ++kx) { const f32x4 av = ca0 + wa0 * xa[kx] + wa1 * xa[kx + 1] + wa2 * xa[kx + 2], bv = cb0 + wb0 * xb[kx] + wb1 * xb[kx + 1] + wb2 * xb[kx + 2];
                        float rv[4];
#pragma unroll
                        for (int i = 0; i < 4; ++i) rv[i] = av[i] * sigmoidf_(av[i]) * bv[i];
                        pw[kx].x = pk2(rv[0], rv[1]); pw[kx].y = pk2(rv[2], rv[3]); }
                    const u32x2 s0 = h4 ? pw[0] : pw[2], s1 = h4 ? pw[1] : pw[3];
                    u32x2 g0, g1; g0.x = __shfl_xor(s0.x, 1); g0.y = __shfl_xor(s0.y, 1); g1.x = __shfl_xor(s1.x, 1); g1.y = __shfl_xor(s1.y, 1);
                    const u32x2 m0 = h4 ? pw[2] : pw[0], m1 = h4 ? pw[3] : pw[1];
                    const u32x4 o0 = h4 ? (u32x4){g0.x, g0.y, m0.x, m0.y} : (u32x4){m0.x, m0.y, g0.x, g0.y};
                    const u32x4 o1 = h4 ? (u32x4){g1.x, g1.y, m1.x, m1.y} : (u32x4){m1.x, m1.y, g1.x, g1.y};
                    if (!(ai == 0 && rgi == 0 && ch == 0 && h4 == 0)) {
                        const size_t row = (size_t)(u.pm * 256 + ai * 128 + r0 + 2 * h4);
                        *(u32x4*)(act + row * DFF + lcb + 8 * cg8) = o0; *(u32x4*)(act + (row + 1) * DFF + lcb + 8 * cg8) = o1; }
                }
            }
            if (tid < 128) { const int sel = tid >> 6, col4 = (tid & 63) * 4; const int lc = (col4 < 128) ? (lcb + col4) : (DFF + lcb + col4 - 128);
                const f32x4 ev = *(const LAS f32x4*)(T + ((ai == 0 ? 2 : 128) + sel) * PT + col4);
                *(f32x4*)(edge + ((size_t)(u.pm * 4 + 2 * ai + sel)) * NUP + lc) = ev; }
            RAW_BAR();
            if (ai == 0) { if (tid < 128) { const int sel = tid >> 6, col4 = (tid & 63) * 4; *(LAS f32x4*)(T + sel * PT + col4) = *(const LAS f32x4*)(T + (128 + sel) * PT + col4); }
                RAW_BAR(); }
        }
    }
};

struct Epi9 {
    static constexpr bool CHAIN = false;
    float* out; const float* modf;
    DI void operator()(AccT& acc, const Unit& u, int wr, int wc, int fr, int fq, LAS unsigned char*) const {
        const int col0 = u.pn * 256 + wc * 32 + fq * 8; const int rowb = u.pm * 256 + wr * 64 + fr;
        f32x4 g2v[2][2];
#pragma unroll
        for (int bj = 0; bj < 2; ++bj)
#pragma unroll
            for (int n = 0; n < 2; ++n) g2v[bj][n] = *(const f32x4*)(modf + 5 * 2048 + col0 + bj * 128 + 4 * n);
#pragma unroll
        for (int ag = 0; ag < 4; ++ag) { const int ai = ag >> 1, m0 = (ag & 1) * 2;
            f32x4 xr[4][2][2];
#pragma unroll
            for (int m = m0; m < m0 + 2; ++m)
#pragma unroll
                for (int bj = 0; bj < 2; ++bj) { const size_t off = (size_t)(rowb + ai * 128 + m * 16) * 2048 + col0 + bj * 128;
                    xr[m][bj][0] = *(const f32x4*)(out + off); xr[m][bj][1] = *(const f32x4*)(out + off + 4); }
            FENCE();
#pragma unroll
            for (int m = m0; m < m0 + 2; ++m)
#pragma unroll
                for (int bj = 0; bj < 2; ++bj) { const size_t off = (size_t)(rowb + ai * 128 + m * 16) * 2048 + col0 + bj * 128;
                    *(f32x4*)(out + off) = xr[m][bj][0] + g2v[bj][0] * acc[ai][bj][m][0]; *(f32x4*)(out + off + 4) = xr[m][bj][1] + g2v[bj][1] * acc[ai][bj][m][1]; }
            FENCE();
        }
    }
};

DI int dest_row(int mode, int n) {
    if (mode == 1) { if (n >= 2048) return n; const int d = n & 127; return (n & ~127) + 32 * ((d >> 4) & 3) + 8 * ((d >> 2) & 3) + 4 * (d >> 6) + (d & 3); }
    if (mode == 2) { const int bj = n >= DFF ? 1 : 0, cc = n - bj * DFF; return 256 * (cc >> 7) + 128 * bj + (cc & 127); }
    if (mode == 3) { const int bj = n >= 2048 ? 1 : 0, cc = n - bj * 2048; return 256 * (cc >> 7) + 128 * bj + (cc & 127); }
    return n;
}
DI void transpose_item(const float* W, int N, bf16_t* WT, int ldd, int koff, int row_off, int mode, LAS float* scr, int item, int lane) {
    const int nblk = N / 64, kb = item / nblk, nb = item % nblk, k0 = 64 * kb, n0 = 64 * nb;
    const int kr = lane >> 4, n4 = (lane & 15) * 4;
    f32x4 v[16];
#pragma unroll
    for (int i = 0; i < 16; ++i) v[i] = __builtin_nontemporal_load((const f32x4*)(W + (size_t)(k0 + 4 * i + kr) * N + n0 + n4));
#pragma unroll
    for (int i = 0; i < 16; ++i) { LAS float* d = scr + (4 * i + kr) * 65 + n4; d[0] = v[i][0]; d[1] = v[i][1]; d[2] = v[i][2]; d[3] = v[i][3]; }
    LDS_WAIT(); asm volatile("" ::: "memory");
    const int c = lane & 7;
#pragma unroll
    for (int j = 0; j < 8; ++j) { const int n = (lane >> 3) + 8 * j; const LAS float* sp = scr + (8 * c) * 65 + n;
        u32x4 o; o.x = pk2(sp[0 * 65], sp[1 * 65]); o.y = pk2(sp[2 * 65], sp[3 * 65]); o.z = pk2(sp[4 * 65], sp[5 * 65]); o.w = pk2(sp[6 * 65], sp[7 * 65]);
        *(u32x4*)(WT + (size_t)(row_off + dest_row(mode, n0 + n)) * ldd + koff + k0 + 8 * c) = o; }
    LDS_WAIT(); asm volatile("" ::: "memory");
}

DI s16x4 vtr(const LAS unsigned char* p) { typedef short v4i16_t __attribute__((ext_vector_type(4))); return __builtin_bit_cast(s16x4, __builtin_amdgcn_ds_read_tr16_b64_v4i16((LAS v4i16_t*)p)); }
constexpr int KV_PITCH = 272;
constexpr int LDS_KS = 0, LDS_VS = 256 * KV_PITCH, LDS_TAB = 2 * 256 * KV_PITCH;


#define XB_TMO      128
#define XB_XCNT(j)  (256  + 64 * (j))
#define XB_XSUB(j)  (1280 + 64 * (j))
#define XB_XGEN(j)  (2304 + 64 * (j))
#define XB_TOP      3328
#define XB_TOPGEN   3392
#define XCD_BAR_WORDS 3456
#define XB_SPIN_CAP (1u << 18)
DI unsigned xb_ld(unsigned* p)              { return __hip_atomic_load(p, __ATOMIC_RELAXED, __HIP_MEMORY_SCOPE_AGENT); }
DI unsigned xb_add(unsigned* p, unsigned v) { return __hip_atomic_fetch_add(p, v, __ATOMIC_RELAXED, __HIP_MEMORY_SCOPE_AGENT); }
DI unsigned xb_xcc_id() { return (unsigned)__builtin_amdgcn_s_getreg((3 << 11) | 20) & 0xFu; }
#define XB_SPIN(cond, bar) do { unsigned _sp = 0; while (cond) { __builtin_amdgcn_s_sleep(1); \
    if ((++_sp & 255u) == 0u) { if (xb_ld(&(bar)[XB_TMO])) break; if (_sp > XB_SPIN_CAP) { atomicAdd(&(bar)[XB_TMO], 1u); break; } } } } while (0)
struct XcdBarrier { unsigned* bar; unsigned x; volatile LAS unsigned* st; };
DI XcdBarrier xcd_barrier_post(unsigned* bar, volatile LAS unsigned* st) {
    XcdBarrier b; b.bar = bar; b.x = xb_xcc_id(); b.st = st;
    if (threadIdx.x == 0) (void)xb_add(&bar[XB_XCNT(b.x)], 1u);
    return b;
}
DI void xcd_barrier_complete(unsigned* bar, unsigned x, unsigned& nloc, unsigned& nx) {
    const unsigned G = gridDim.x * gridDim.y * gridDim.z;
    unsigned sum, cnt, mine, sp = 0u;
    for (;;) {
        sum = 0u; cnt = 0u; mine = 0u;
#pragma unroll
        for (unsigned j = 0; j < 16; ++j) { const unsigned c = xb_ld(&bar[XB_XCNT(j)]); sum += c; cnt += (c > 0u) ? 1u : 0u; mine = (j == x) ? c : mine; }
        if (sum == G) break;
        __builtin_amdgcn_s_sleep(1);
        if ((++sp & 255u) == 0u) { if (xb_ld(&bar[XB_TMO])) break; if (sp > XB_SPIN_CAP) { atomicAdd(&bar[XB_TMO], 1u); break; } }
    }
    nloc = mine > 0u ? mine : 1u; nx = cnt > 0u ? cnt : 1u;
}
DI void xcd_barrier(const XcdBarrier& b) {
    asm volatile("s_waitcnt vmcnt(0)" ::: "memory");
    __syncthreads();
    if (threadIdx.x == 0) {
        unsigned* bar = b.bar;
        __builtin_amdgcn_s_waitcnt(0);
        unsigned nloc = b.st[0], nx = b.st[1];
        if (nloc == 0u) { xcd_barrier_complete(bar, b.x, nloc, nx); b.st[0] = nloc; b.st[1] = nx; }
        const unsigned old = xb_add(&bar[XB_XSUB(b.x)], 1u);
        const unsigned gen = old / nloc;
        if (old + 1u == (gen + 1u) * nloc) {
            __builtin_amdgcn_fence(__ATOMIC_RELEASE, "agent");
            asm volatile("s_waitcnt vmcnt(0)" ::: "memory");
            const unsigned og = xb_add(&bar[XB_TOP], 1u);
            const unsigned tg = og / nx;
            if (og + 1u == (tg + 1u) * nx) xb_add(&bar[XB_TOPGEN], 1u);
            else XB_SPIN(xb_ld(&bar[XB_TOPGEN]) == tg, bar);
            __builtin_amdgcn_fence(__ATOMIC_ACQUIRE, "agent");
            xb_add(&bar[XB_XGEN(b.x)], 1u);
            asm volatile("s_waitcnt vmcnt(0)" ::: "memory");
        } else {
            XB_SPIN(xb_ld(&bar[XB_XGEN(b.x)]) == gen, bar);
            __builtin_amdgcn_fence(__ATOMIC_ACQUIRE, "agent");
            asm volatile("s_waitcnt vmcnt(0)" ::: "memory");
        }
    }
    __syncthreads();
}

#ifndef PHMASK
#define PHMASK 0xFFFF
#endif
struct Params {
    const float* in[20]; float* out; unsigned char* ws;
};

__global__ void __launch_bounds__(NTHR, 2) fwd_megakernel(Params p) {
    extern __shared__ __attribute__((aligned(16))) unsigned char lds_raw[];
    LAS unsigned char* lds = (LAS unsigned char*)lds_raw;
    cg::grid_group grid = cg::this_grid();
    int tid = threadIdx.x, lane = tid & 63; const int wave = __builtin_amdgcn_readfirstlane(tid >> 6);
#define RELOAD_IDS() do { tid = threadIdx.x; asm volatile("" : "+v"(tid)); lane = tid & 63; } while (0)
    const int G = gridDim.x, bx = blockIdx.x;
    const int vcu = (G % 8 == 0) ? (bx % 8) * (G / 8) + bx / 8 : bx;
    const int gw = vcu * NWAVES + wave, NGW = G * NWAVES;
    unsigned char* ws = p.ws;
    volatile LAS unsigned* xst = (volatile LAS unsigned*)(lds + LDS_BYTES - 16);
    if (threadIdx.x < 4) xst[threadIdx.x] = 0u;
    __syncthreads();
    XcdBarrier xbar; xbar.bar = (unsigned*)(ws + WS_BAR); xbar.x = 0; xbar.st = xst;
    if (blockIdx.x == 0) {
        for (int i = threadIdx.x; i < 512; i += NTHR) ((unsigned*)(ws + WS_CNT))[i] = 0u;
        for (int i = threadIdx.x; i < XCD_BAR_WORDS; i += NTHR) ((unsigned*)(ws + WS_BAR))[i] = 0u;
    }
#define xin (p.in[0])
#define cvec (p.in[1])
#define w_ada (p.in[2])
#define b_ada (p.in[3])
#define nmg (p.in[4])
#define w_in (p.in[5])
#define qng (p.in[6])
#define kng (p.in[7])
#define w_pgrp (p.in[8])
#define pscale (p.in[9])
#define w_abr (p.in[10])
#define w_pbr (p.in[11])
#define w_gate (p.in[12])
#define b_gate (p.in[13])
#define w_o (p.in[14])
#define nfg (p.in[15])
#define w_up (p.in[16])
#define conv_w (p.in[17])
#define conv_b (p.in[18])
#define w_down (p.in[19])
#define outp (p.out)
#define cnt ((unsigned*)(ws + WS_CNT))
#define kmean ((float*)(ws + WS_KMEAN))
#define modp ((float*)(ws + WS_MODP))
#define modf ((float*)(ws + WS_MODF))
#define biasup ((float*)(ws + WS_BIASUP))
#define rowss ((float*)(ws + WS_ROWSS))
#define lsum ((float*)(ws + WS_LSUM))
#define qlist ((unsigned*)(ws + WS_LIST))
#define W1t ((bf16_t*)(ws + WS_W1))
#define Wyt ((bf16_t*)(ws + WS_WY))
#define Wot ((bf16_t*)(ws + WS_WO))
#define Wgt ((bf16_t*)(ws + WS_WG))
#define Wdt ((bf16_t*)(ws + WS_WD))
#define Wut ((bf16_t*)(ws + WS_WU))
#define hbuf ((bf16_t*)(ws + WS_HB))
#define qb ((bf16_t*)(ws + WS_Q))
#define kb ((bf16_t*)(ws + WS_K))
#define vb ((bf16_t*)(ws + WS_V))
#define ub ((bf16_t*)(ws + WS_U))
#define gates ((bf16_t*)(ws + WS_GATES))
#define dbuf ((bf16_t*)(ws + WS_DB))
#define am ((bf16_t*)(ws + WS_AM))
#define merged ((bf16_t*)(ws + WS_MERGED))
#define xg ((bf16_t*)(ws + WS_XG))
#define act ((bf16_t*)(ws + WS_ACT))
#define edge ((float*)(ws + WS_EDGE))
#define slots ((bf16_t*)p.out)
#define rsb ((float*)(ws + WS_LSUM))
#if PHMASK & 1
    {
        LAS float* scr = (LAS float*)(lds + wave * 16640);
        constexpr int I_IN = 32 * 64, I_GT = 32 * 64, I_AB = 16 * 32, I_PB = 16 * 32, I_O = 32 * 32, I_UP = 32 * 176, I_DN = 88 * 32, I_G = 4 * 4;
        constexpr int NIT = I_IN + I_GT + I_AB + I_PB + I_O + I_UP + I_DN + 4 * I_G;
        for (int it = gw; it < NIT; it += NGW) {
            int r = it;
            if (r < I_UP) { transpose_item(w_up, NUP, Wut, 2048, 0, 0, 2, scr, r, lane); continue; } r -= I_UP;
            if (r < I_DN) { transpose_item(w_down, 2048, Wdt, DFF, 0, 0, 0, scr, r, lane); continue; } r -= I_DN;
            if (r < I_IN) { transpose_item(w_in, 4096, W1t, 2048, 0, 0, 0, scr, r, lane); continue; } r -= I_IN;
            if (r < I_GT) { transpose_item(w_gate, 4096, W1t, 2048, 0, 4096, 3, scr, r, lane); continue; } r -= I_GT;
            if (r < I_AB) { transpose_item(w_abr, 2048, Wyt, 2048, 0, 0, 0, scr, r, lane); continue; } r -= I_AB;
            if (r < I_PB) { transpose_item(w_pbr, 2048, Wyt, 2048, 1024, 0, 0, scr, r, lane); continue; } r -= I_PB;
            if (r < I_O) { transpose_item(w_o, 2048, Wot, 2048, 0, 0, 0, scr, r, lane); continue; } r -= I_O;
            { const int gI = r / I_G; transpose_item(w_pgrp + (size_t)gI * 65536, 256, Wgt, 1024, 0, gI * 256, 0, scr, r % I_G, lane); }
        }
        for (int it = gw; it < 768; it += NGW) {
            const int kc = it / 48, cgi = it % 48; const int col = cgi * 256 + lane * 4;
            f32x4 a = (f32x4){0.f, 0.f, 0.f, 0.f};
#pragma unroll 8
            for (int kk = 0; kk < 128; ++kk) { const int kx = kc * 128 + kk; const float cv = cvec[kx]; const float sv = cv * sigmoidf_(cv);
                a += __builtin_nontemporal_load((const f32x4*)(w_ada + (size_t)kx * 12288 + col)) * sv; }
            *(f32x4*)(modp + (size_t)kc * 12288 + col) = a;
        }
    }
    grid.sync();
    xbar = xcd_barrier_post((unsigned*)(ws + WS_BAR), xst);
    RELOAD_IDS();

#endif
#if PHMASK & 2
    {
        LAS float* sh1 = (LAS float*)lds; LAS float* gm1 = sh1 + 2048;
        for (int e = tid; e < 4096; e += NTHR) { float s = b_ada[e];
#pragma unroll
            for (int kc = 0; kc < 16; ++kc) s += modp[(size_t)kc * 12288 + e];
            if (e < 2048) sh1[e] = s; else gm1[e - 2048] = nmg[e - 2048] * (1.0f + s); }
        if (tid < 48) { const int e = bx * 48 + tid; if (e < 12288 && bx < 256) { float s = b_ada[e];
#pragma unroll
            for (int kc = 0; kc < 16; ++kc) s += modp[(size_t)kc * 12288 + e];
            modf[e] = s; } }
        if (G < 256 && bx == 0) { for (int e = G * 48 + tid; e < 12288; e += NTHR) { float s = b_ada[e]; for (int kc = 0; kc < 16; ++kc) s += modp[(size_t)kc * 12288 + e]; modf[e] = s; } }
        __syncthreads();
        for (int m = gw; m < S; m += 2 * NGW) {
            const int m2 = (m + NGW < S) ? m + NGW : m;
            const f32x4* xr0 = (const f32x4*)(xin + (size_t)m * DM) + lane; const f32x4* xr1 = (const f32x4*)(xin + (size_t)m2 * DM) + lane;
            f32x4 v0[8], v1[8]; float s0 = 0.f, s1 = 0.f;
#pragma unroll
            for (int j = 0; j < 8; ++j) { v0[j] = xr0[64 * j]; v1[j] = xr1[64 * j]; }
#pragma unroll
            for (int j = 0; j < 8; ++j) { s0 += (v0[j][0] * v0[j][0] + v0[j][1] * v0[j][1]) + (v0[j][2] * v0[j][2] + v0[j][3] * v0[j][3]);
                s1 += (v1[j][0] * v1[j][0] + v1[j][1] * v1[j][1]) + (v1[j][2] * v1[j][2] + v1[j][3] * v1[j][3]); }
            const float r0 = __builtin_amdgcn_rsqf(wave_sum(s0) * (1.0f / DM) + EPS), r1 = __builtin_amdgcn_rsqf(wave_sum(s1) * (1.0f / DM) + EPS);
            u32x2* o0 = (u32x2*)(hbuf + (size_t)m * DM) + lane; u32x2* o1 = (u32x2*)(hbuf + (size_t)m2 * DM) + lane;
#pragma unroll
            for (int j = 0; j < 8; ++j) { const int c = 4 * lane + 256 * j; const f32x4 gmv = *(const LAS f32x4*)(gm1 + c), shv = *(const LAS f32x4*)(sh1 + c);
                const f32x4 h0 = v0[j] * r0 * gmv + shv, h1 = v1[j] * r1 * gmv + shv;
                u32x2 w0, w1; w0.x = pk2(h0[0], h0[1]); w0.y = pk2(h0[2], h0[3]); w1.x = pk2(h1[0], h1[1]); w1.y = pk2(h1[2], h1[3]); o0[64 * j] = w0; o1[64 * j] = w1; }
        }
    }
    xcd_barrier(xbar);
    RELOAD_IDS();

#endif
#if PHMASK & 4
    {
        pg8::Gemm g{hbuf, W1t, 2048, 2048, 2048}; pg8::Sched<0> Sc; Sc.init(S, N1, G, bx);
        Epi1 E{qb, kb, vb, ub, gates, kmean, qng, kng, b_gate};
        pg8::gemm_phase_drain<Epi1>(lds, g, Sc, E);
    }
    xcd_barrier(xbar);
    RELOAD_IDS();

#endif
#if PHMASK & 8
    {
        LAS unsigned char* kmb = lds;
        LAS unsigned* hist = (LAS unsigned*)(lds + 32768); LAS unsigned* basep = hist + 64;
        for (int base = bx * 8; base < 2048; base += G * 8) {
            const int h = base >> 8;
            __syncthreads();
            { const int jr = tid >> 3, c0 = (tid & 7) * 16; const f32x4* src = (const f32x4*)(kmean + (size_t)h * 8192 + jr * 128 + c0);
              const f32x4 k0 = src[0], k1 = src[1], k2 = src[2], k3 = src[3];
              *(LAS u32x4*)(kmb + jr * KV_PITCH + c0 * 2) = pack8(k0, k1); *(LAS u32x4*)(kmb + jr * KV_PITCH + c0 * 2 + 16) = pack8(k2, k3); }
            if (tid < 64) hist[tid] = 0u;
            __syncthreads();
            const int item = base + wave, qgi = item & 255, own = qgi >> 2, ns = own < 3 ? own : 3;
            const int r32 = lane & 31, hh = lane >> 5;
            int selj[2][3]; unsigned selp[2][3];
#pragma unroll
            for (int sub = 0; sub < 2; ++sub) {
                const int qi = qgi * 64 + sub * 32 + r32;
                const bf16_t* qp = qb + (size_t)qi * 1024 + h * 128 + 8 * hh;
                f32x16 ac[2];
#pragma unroll
                for (int jt = 0; jt < 2; ++jt)
#pragma unroll
                    for (int i = 0; i < 16; ++i) ac[jt][i] = 0.f;
#pragma unroll
                for (int ks = 0; ks < 8; ++ks) { const bf16x8 qf = *(const bf16x8*)(qp + 16 * ks);
#pragma unroll
                    for (int jt = 0; jt < 2; ++jt) { const bf16x8 kf = *(const LAS bf16x8*)(kmb + (32 * jt + r32) * KV_PITCH + 32 * ks + 16 * hh);
                        ac[jt] = __builtin_amdgcn_mfma_f32_32x32x16_bf16(kf, qf, ac[jt], 0, 0, 0); } }
                float b0 = -3.0e38f, b1 = -3.0e38f, b2 = -3.0e38f; int i0 = 255, i1 = 255, i2 = 255;
#pragma unroll
                for (int jt = 0; jt < 2; ++jt)
#pragma unroll
                    for (int i = 0; i < 16; ++i) { const int j = 32 * jt + (i & 3) + 8 * (i >> 2) + 4 * hh; const float vj = (j < own) ? ac[jt][i] : -3.0e38f;
                        if (vj > b0) { b2 = b1; i2 = i1; b1 = b0; i1 = i0; b0 = vj; i0 = j; }
                        else if (vj > b1) { b2 = b1; i2 = i1; b1 = vj; i1 = j; }
                        else if (vj > b2) { b2 = vj; i2 = j; } }
                const float p0 = __shfl_xor(b0, 32), p1 = __shfl_xor(b1, 32), p2 = __shfl_xor(b2, 32);
                const int q0 = __shfl_xor(i0, 32), q1 = __shfl_xor(i1, 32), q2 = __shfl_xor(i2, 32);
#pragma unroll
                for (int t = 0; t < 3; ++t) { const float vj = t == 0 ? p0 : (t == 1 ? p1 : p2); const int j = t == 0 ? q0 : (t == 1 ? q1 : q2);
                    if (vj > b0 || (vj == b0 && j < i0)) { b2 = b1; i2 = i1; b1 = b0; i1 = i0; b0 = vj; i0 = j; }
                    else if (vj > b1 || (vj == b1 && j < i1)) { b2 = b1; i2 = i1; b1 = vj; i1 = j; }
                    else if (vj > b2 || (vj == b2 && j < i2)) { b2 = vj; i2 = j; } }
                selj[sub][0] = i0; selj[sub][1] = i1; selj[sub][2] = i2;
#pragma unroll
                for (int t = 0; t < 3; ++t) selp[sub][t] = (hh == 0 && t < ns) ? __hip_atomic_fetch_add((unsigned*)(hist + selj[sub][t]), 1u, __ATOMIC_RELAXED, __HIP_MEMORY_SCOPE_WORKGROUP) : 0u;
            }
            __syncthreads();
            if (tid < 64) { const unsigned c = hist[tid]; basep[tid] = c ? atomicAdd(cnt + h * 64 + tid, c) : 0u; }
            __syncthreads();
            if (hh == 0) {
#pragma unroll
                for (int sub = 0; sub < 2; ++sub)
#pragma unroll
                    for (int t = 0; t < 3; ++t) if (t < ns) { const int j = selj[sub][t]; const unsigned qi = (unsigned)(qgi * 64 + sub * 32 + r32);
                        qlist[(size_t)(h * 64 + j) * 16384 + basep[j] + selp[sub][t]] = qi * 4u + (unsigned)t; }
            }
        }
        for (int idx = vcu * NTHR + tid; idx < 2048 * 128; idx += G * NTHR) {
            const int cgi = idx & 127, rc = idx >> 7, w = 2 << (cgi >> 5), t0 = rc * 8;
            const bf16_t* __restrict__ up = ub + cgi * 8; bf16_t* __restrict__ dp = dbuf + cgi * 8;
            float sum[8];
#pragma unroll
            for (int i = 0; i < 8; ++i) sum[i] = 0.f;
            for (int i = 1; i <= w; ++i) { const int t = t0 - i; if (t >= 0) { float f[8]; unpack8(*(const u32x4*)(up + (size_t)t * 1024), f);
#pragma unroll
                for (int e = 0; e < 8; ++e) sum[e] += f[e]; } }
#pragma unroll
            for (int t = t0; t < t0 + 8; ++t) {
                float f[8]; unpack8(*(const u32x4*)(up + (size_t)t * 1024), f);
#pragma unroll
                for (int e = 0; e < 8; ++e) sum[e] += f[e];
                if (t - w >= 0) { float o[8]; unpack8(*(const u32x4*)(up + (size_t)(t - w) * 1024), o);
#pragma unroll
                    for (int e = 0; e < 8; ++e) sum[e] -= o[e]; }
                const float inv = 1.0f / (float)((t + 1) < w ? (t + 1) : w);
                u32x4 o4; o4.x = pk2(sum[0] * inv - f[0], sum[1] * inv - f[1]); o4.y = pk2(sum[2] * inv - f[2], sum[3] * inv - f[3]);
                o4.z = pk2(sum[4] * inv - f[4], sum[5] * inv - f[5]); o4.w = pk2(sum[6] * inv - f[6], sum[7] * inv - f[7]);
                *(u32x4*)(dp + (size_t)t * 1024) = o4;
            }
        }
        for (int rho = gw; rho < NUP; rho += NGW) {
            float s = 0.f;
#pragma unroll
            for (int j = 0; j < 4; ++j) { const int k0 = j * 512 + lane * 8; float f[8]; unpack8(*(const u32x4*)(Wut + (size_t)rho * 2048 + k0), f);
                const f32x4 s0 = *(const f32x4*)(modf + 3 * 2048 + k0), s1 = *(const f32x4*)(modf + 3 * 2048 + k0 + 4);
                s += (f[0] * s0[0] + f[1] * s0[1]) + (f[2] * s0[2] + f[3] * s0[3]) + (f[4] * s1[0] + f[5] * s1[1]) + (f[6] * s1[2] + f[7] * s1[3]); }
            s = wave_sum(s);
            if (lane == 0) biasup[rho] = s;
        }
    }
    xcd_barrier(xbar);
    RELOAD_IDS();

#endif
#if PHMASK & 16
    {
        RELOAD_IDS();
        __syncthreads();
        LAS int* pre = (LAS int*)(lds + LDS_TAB); LAS int* tmp = pre + 520;
        { const int n = 1 + (int)((cnt[tid] + 255u) >> 8); tmp[tid] = n; __syncthreads();
          for (int o = 1; o < 512; o <<= 1) { const int v = tmp[tid] + (tid >= o ? tmp[tid - o] : 0); __syncthreads(); tmp[tid] = v; __syncthreads(); }
          pre[tid + 1] = tmp[tid]; if (tid == 0) pre[0] = 0; __syncthreads(); }
        const int total = pre[512];
        int lane_ = lane; asm volatile("" : "+v"(lane_));
        const int r32 = lane_ & 31, hh = lane_ >> 5, i16 = lane_ & 15, qq = i16 >> 2, pp = i16 & 3, blk = (lane_ >> 4) & 1;
#define ATT_DECODE(UN, HJ, LI) do { int lo_ = 0, hi_ = 511; while (lo_ < hi_) { const int mid_ = (lo_ + hi_ + 1) >> 1; if (pre[mid_] <= (UN)) lo_ = mid_; else hi_ = mid_ - 1; } HJ = lo_; LI = (UN) - pre[lo_]; } while (0)
#define ATT_KVLOAD(HJ) do { const int h_ = (HJ) >> 6, j_ = (HJ) & 63; const bf16_t* kg = kb + (size_t)(j_ * 256) * 1024 + h_ * 128; const bf16_t* vg = vb + (size_t)(j_ * 256) * 1024 + h_ * 128; \
        _Pragma("unroll") for (int i = 0; i < 8; ++i) { const int idx = tid + NTHR * i, row = idx >> 4, c16 = idx & 15; \
            kreg[i] = *(const u32x4*)(kg + (size_t)row * 1024 + c16 * 8); vreg[i] = *(const u32x4*)(vg + (size_t)row * 1024 + c16 * 8); } } while (0)
#define ATT_ENT(HJ, LI, ENT, NL) do { NL = ((LI) == 0) ? 256 : (int)cnt[HJ] - ((LI) - 1) * 256; const int e_ = wave * 32 + r32; \
        if ((LI) == 0) ENT = (unsigned)(((HJ) & 63) * 256 + e_) * 4u + 3u; else ENT = qlist[(size_t)(HJ) * 16384 + (size_t)((LI) - 1) * 256 + (e_ < NL ? e_ : 0)]; } while (0)
        u32x4 kreg[8], vreg[8];
        int hj = 0, li = 0, nlist = 0; unsigned ent = 0u;
        if (bx < total) { ATT_DECODE(bx, hj, li); ATT_KVLOAD(hj); ATT_ENT(hj, li, ent, nlist); }
        for (int un = bx; un < total; un += G) {
            const int h = hj >> 6, j = hj & 63;
            const bool ownu = (li == 0);
            const int e = wave * 32 + r32;
            const bool valid = e < nlist;
            const int qi = (int)(ent >> 2), slot = (int)(ent & 3u);
            const bf16_t* qp = qb + (size_t)qi * 1024 + h * 128 + 8 * hh;
            bf16x8 qf[8];
#pragma unroll
            for (int ks = 0; ks < 8; ++ks) qf[ks] = *(const bf16x8*)(qp + 16 * ks);
            __syncthreads();
#pragma unroll
            for (int i = 0; i < 8; ++i) { const int idx = tid + NTHR * i, row = idx >> 4, c16 = idx & 15;
                *(LAS u32x4*)(lds + LDS_KS + row * KV_PITCH + c16 * 16) = kreg[i]; *(LAS u32x4*)(lds + LDS_VS + row * KV_PITCH + c16 * 16) = vreg[i]; }
            __syncthreads();
            int hj2, li2, nlist2; unsigned ent2;
            { const int unn = (un + G < total) ? un + G : un; ATT_DECODE(unn, hj2, li2); ATT_KVLOAD(hj2); ATT_ENT(hj2, li2, ent2, nlist2); }
            if (wave * 32 < nlist) {
                const int nq = ownu ? ((wave * 32 + 31) >> 6) + 1 : 4;
                f32x16 o[4];
#pragma unroll
                for (int dt = 0; dt < 4; ++dt)
#pragma unroll
                    for (int i = 0; i < 16; ++i) o[dt][i] = 0.f;
                float lacc = 0.f;
                const int qloc = e;
#pragma unroll 1
                for (int hf = 0; hf < nq; ++hf) {
                    f32x16 sa[2];
#pragma unroll
                    for (int i = 0; i < 16; ++i) { sa[0][i] = 0.f; sa[1][i] = 0.f; }
                    {
                        const LAS unsigned char* kp0 = lds + LDS_KS + (64 * hf + r32) * KV_PITCH + 16 * hh;
                        const LAS unsigned char* kp1 = kp0 + 32 * KV_PITCH;
                        bf16x8 a0 = *(const LAS bf16x8*)kp0, a1 = *(const LAS bf16x8*)kp1;
#pragma unroll
                        for (int ks = 0; ks < 8; ++ks) {
                            bf16x8 n0 = a0, n1 = a1;
                            if (ks < 7) { n0 = *(const LAS bf16x8*)(kp0 + 32 * (ks + 1)); n1 = *(const LAS bf16x8*)(kp1 + 32 * (ks + 1)); }
                            sa[0] = __builtin_amdgcn_mfma_f32_32x32x16_bf16(a0, qf[ks], sa[0], 0, 0, 0);
                            sa[1] = __builtin_amdgcn_mfma_f32_32x32x16_bf16(a1, qf[ks], sa[1], 0, 0, 0);
                            a0 = n0; a1 = n1;
                        }
                    }
                    if (ownu) {
#pragma unroll
                        for (int kt = 0; kt < 2; ++kt)
#pragma unroll
                            for (int i = 0; i < 16; ++i) { const int key = 64 * hf + 32 * kt + (i & 3) + 8 * (i >> 2) + 4 * hh;
                                float pv = __builtin_amdgcn_exp2f(sa[kt][i]); if (key > qloc) pv = 0.f; sa[kt][i] = pv; lacc += pv; }
                    } else {
#pragma unroll
                        for (int kt = 0; kt < 2; ++kt)
#pragma unroll
                            for (int i = 0; i < 16; ++i) { const float pv = __builtin_amdgcn_exp2f(sa[kt][i]); sa[kt][i] = pv; lacc += pv; }
                    }
                    bf16x8 pb[4];
#pragma unroll
                    for (int st = 0; st < 4; ++st) { const int kt = st >> 1, s2 = st & 1;
                        u32x4 pw; pw.x = pk2(sa[kt][8 * s2 + 0], sa[kt][8 * s2 + 1]); pw.y = pk2(sa[kt][8 * s2 + 2], sa[kt][8 * s2 + 3]);
                        pw.z = pk2(sa[kt][8 * s2 + 4], sa[kt][8 * s2 + 5]); pw.w = pk2(sa[kt][8 * s2 + 6], sa[kt][8 * s2 + 7]);
                        pb[st] = __builtin_bit_cast(bf16x8, pw); }
                    const LAS unsigned char* vp = lds + LDS_VS + (64 * hf + 4 * hh + qq) * KV_PITCH + 32 * blk + 8 * pp;
                    s16x4 cl[4], ch[4];
#pragma unroll
                    for (int dt = 0; dt < 4; ++dt) { cl[dt] = vtr(vp + 64 * dt); ch[dt] = vtr(vp + 8 * KV_PITCH + 64 * dt); }
#pragma unroll
                    for (int st = 0; st < 4; ++st) {
                        s16x4 nl[4], nh[4];
#pragma unroll
                        for (int dt = 0; dt < 4; ++dt) { nl[dt] = cl[dt]; nh[dt] = ch[dt]; }
                        if (st < 3) { const LAS unsigned char* vn = vp + 16 * (st + 1) * KV_PITCH;
#pragma unroll
                            for (int dt = 0; dt < 4; ++dt) { nl[dt] = vtr(vn + 64 * dt); nh[dt] = vtr(vn + 8 * KV_PITCH + 64 * dt); } }
#pragma unroll
                        for (int dt = 0; dt < 4; ++dt) { const bf16x8 vf = __builtin_shufflevector(cl[dt], ch[dt], 0, 1, 2, 3, 4, 5, 6, 7);
                            o[dt] = __builtin_amdgcn_mfma_f32_32x32x16_bf16(vf, pb[st], o[dt], 0, 0, 0); }
#pragma unroll
                        for (int dt = 0; dt < 4; ++dt) { cl[dt] = nl[dt]; ch[dt] = nh[dt]; }
                    }
                }
                lacc += __shfl_xor(lacc, 32);
                u32x4 ow[8];
#pragma unroll
                for (int dt = 0; dt < 4; ++dt)
#pragma unroll
                    for (int gp2 = 0; gp2 < 2; ++gp2) { const int g0 = 2 * gp2, g1 = g0 + 1;
                        unsigned ax = pk2(o[dt][4 * g0], o[dt][4 * g0 + 1]), ay = pk2(o[dt][4 * g0 + 2], o[dt][4 * g0 + 3]);
                        unsigned bxw = pk2(o[dt][4 * g1], o[dt][4 * g1 + 1]), by = pk2(o[dt][4 * g1 + 2], o[dt][4 * g1 + 3]);
                        { const auto rsw = __builtin_amdgcn_permlane32_swap(ax, bxw, false, false); ax = rsw[0]; bxw = rsw[1]; }
                        { const auto rsw = __builtin_amdgcn_permlane32_swap(ay, by, false, false); ay = rsw[0]; by = rsw[1]; }
                        ow[dt * 2 + gp2] = (u32x4){ax, ay, bxw, by}; }
                if (valid) {
                    bf16_t* op = slots + ((size_t)qi * 4 + slot) * 1024 + h * 128 + 8 * hh;
#pragma unroll
                    for (int dt = 0; dt < 4; ++dt)
#pragma unroll
                        for (int gp2 = 0; gp2 < 2; ++gp2) *(u32x4*)(op + 32 * dt + 16 * gp2) = ow[dt * 2 + gp2];
                    if (hh == 0) lsum[((size_t)qi * 4 + slot) * 8 + h] = lacc;
                }
            }
            hj = hj2; li = li2; ent = ent2; nlist = nlist2;
        }
        RELOAD_IDS();
        for (int base = vcu * 8; base < 2048; base += G * 8) {
            const int gI = base >> 9;
            __syncthreads();
#pragma unroll
            for (int i = 0; i < 16; ++i) { const int idx = tid + NTHR * i, row = idx >> 5, c16 = idx & 31;
                *(LAS u32x4*)(lds + row * 528 + c16 * 16) = *(const u32x4*)(Wgt + (size_t)(gI * 256 + row) * 1024 + c16 * 8); }
            __syncthreads();
            const int item = base + wave, s0 = (item & 511) * 32, r = lane & 31, hh = lane >> 5;
            bf16x8 af[16];
            const bf16_t* ap = dbuf + (size_t)(s0 + r) * 1024 + gI * 256 + 8 * hh;
#pragma unroll
            for (int ks = 0; ks < 16; ++ks) af[ks] = *(const bf16x8*)(ap + 16 * ks);
#pragma unroll 1
            for (int nt = 0; nt < 8; nt += 2) {
                f32x16 ac[2];
#pragma unroll
                for (int i = 0; i < 16; ++i) { ac[0][i] = 0.f; ac[1][i] = 0.f; }
                const LAS unsigned char* bp = lds + (nt * 32 + r) * 528 + 16 * hh;
#pragma unroll
                for (int ks = 0; ks < 16; ++ks) { const bf16x8 b0 = *(const LAS bf16x8*)(bp + 32 * ks), b1 = *(const LAS bf16x8*)(bp + 32 * 528 + 32 * ks);
                    ac[0] = __builtin_amdgcn_mfma_f32_32x32x16_bf16(b0, af[ks], ac[0], 0, 0, 0); ac[1] = __builtin_amdgcn_mfma_f32_32x32x16_bf16(b1, af[ks], ac[1], 0, 0, 0); }
#pragma unroll
                for (int t2 = 0; t2 < 2; ++t2) {
                    bf16_t* op = am + (size_t)(s0 + r) * 2048 + 1024 + gI * 256 + (nt + t2) * 32 + 4 * hh;
#pragma unroll
                    for (int q4 = 0; q4 < 4; ++q4) { const f32x4 lsv = *(const f32x4*)(pscale + gI * 256 + (nt + t2) * 32 + 8 * q4 + 4 * hh);
                        u32x2 w; w.x = pk2(ac[t2][4 * q4] * lsv[0], ac[t2][4 * q4 + 1] * lsv[1]); w.y = pk2(ac[t2][4 * q4 + 2] * lsv[2], ac[t2][4 * q4 + 3] * lsv[3]); *(u32x2*)(op + 8 * q4) = w; }
                }
            }
        }
    }
    xcd_barrier(xbar);
    RELOAD_IDS();

#endif
#if PHMASK & 32
    {
    }
    RELOAD_IDS();
#pragma unroll 2
    for (int idx = vcu * NTHR + tid; idx < S * 128; idx += G * NTHR) {
        const int qi = idx >> 7, c8 = idx & 127, h = c8 >> 4, own = qi >> 8, ns = own < 3 ? own : 3;
        float a[8]; float l = 0.f;
#pragma unroll
        for (int i = 0; i < 8; ++i) a[i] = 0.f;
#pragma unroll
        for (int s = 0; s < 4; ++s) if (s == 3 || s < ns) { float f[8]; unpack8(*(const u32x4*)(slots + ((size_t)qi * 4 + s) * 1024 + c8 * 8), f);
#pragma unroll
            for (int i = 0; i < 8; ++i) a[i] += f[i];
            l += lsum[((size_t)qi * 4 + s) * 8 + h]; }
        const float inv = 1.0f / l;
        u32x4 w; w.x = pk2(a[0] * inv, a[1] * inv); w.y = pk2(a[2] * inv, a[3] * inv); w.z = pk2(a[4] * inv, a[5] * inv); w.w = pk2(a[6] * inv, a[7] * inv);
        *(u32x4*)(am + (size_t)qi * 2048 + c8 * 8) = w;
    }
    xcd_barrier(xbar);
    RELOAD_IDS();

#endif
#if PHMASK & 64
    { pg8::Gemm g{am, Wyt, 2048, 2048, 1024}; pg8::Sched<1> Sc; Sc.init(S, 2048, G, bx); Epi5 E{gates, merged}; pg8::gemm_phase<Epi5>(lds, g, Sc, E); }
    xcd_barrier(xbar);
    RELOAD_IDS();

#endif
#if PHMASK & 128
    { pg8::Gemm g{merged, Wot, 2048, 2048, 2048}; pg8::Sched<0> Sc; Sc.init(S, 2048, G, bx); Epi6 E{xin, outp, xg, modf, nfg, rowss}; pg8::gemm_phase<Epi6>(lds, g, Sc, E); }
    xcd_barrier(xbar);
    RELOAD_IDS();

#endif
#if PHMASK & 256
    for (int row = vcu * NTHR + tid; row < S; row += G * NTHR) { const f32x4* pr = (const f32x4*)(rowss + (size_t)row * 32); f32x4 sm = pr[0];
#pragma unroll
        for (int j = 1; j < 8; ++j) sm += pr[j];
        rsb[row] = __builtin_amdgcn_rsqf(((sm[0] + sm[1]) + (sm[2] + sm[3])) * (1.0f / 2048.0f) + EPS); }
    xcd_barrier(xbar);
    RELOAD_IDS();
    { pg8::Gemm g{xg, Wut, 2048, 2048, 2048}; pg8::Sched<0> Sc; Sc.init(S, NUP, G, bx); Epi7 E{rsb, biasup, conv_w, conv_b, act, edge}; pg8::gemm_phase_drain<Epi7>(lds, g, Sc, E); }
    xcd_barrier(xbar);
    RELOAD_IDS();

#endif
#if PHMASK & 512
    {
        pg8::Sched<0> Sf; Sf.init(S, 2048, G, bx);
        for (int ui = 0;; ++ui) {
            Unit uf; if (!Sf.next(ui, uf)) break;
            const int tl = uf.pm;
            for (int idx = tid; idx < DFF / 4; idx += NTHR) {
                const int c = idx * 4;
                f32x4 r0[2], r1[2];
#pragma unroll
                for (int bj = 0; bj < 2; ++bj) {
                    const int lc = bj * DFF + c;
                    const f32x4 z = (f32x4){0.f, 0.f, 0.f, 0.f};
                    const f32x4 pm2 = tl > 0 ? *(const f32x4*)(edge + ((size_t)((tl - 1) * 4 + 2)) * NUP + lc) : z;
                    const f32x4 pm1 = tl > 0 ? *(const f32x4*)(edge + ((size_t)((tl - 1) * 4 + 3)) * NUP + lc) : z;
                    const f32x4 e0 = *(const f32x4*)(edge + ((size_t)(tl * 4 + 0)) * NUP + lc), e1 = *(const f32x4*)(edge + ((size_t)(tl * 4 + 1)) * NUP + lc);
                    const f32x4 w0 = *(const f32x4*)(conv_w + lc), w1 = *(const f32x4*)(conv_w + NUP + lc), w2 = *(const f32x4*)(conv_w + 2 * NUP + lc), cbv = *(const f32x4*)(conv_b + lc);
                    r0[bj] = cbv + w0 * pm2 + w1 * pm1 + w2 * e0;
                    r1[bj] = cbv + w0 * pm1 + w1 * e0 + w2 * e1;
                }
                u32x2 o0, o1; float t0[4], t1[4];
#pragma unroll
                for (int i = 0; i < 4; ++i) { t0[i] = r0[0][i] * sigmoidf_(r0[0][i]) * r0[1][i]; t1[i] = r1[0][i] * sigmoidf_(r1[0][i]) * r1[1][i]; }
                o0.x = pk2(t0[0], t0[1]); o0.y = pk2(t0[2], t0[3]); o1.x = pk2(t1[0], t1[1]); o1.y = pk2(t1[2], t1[3]);
                *(u32x2*)(act + (size_t)(tl * 256) * DFF + c) = o0; *(u32x2*)(act + (size_t)(tl * 256 + 1) * DFF + c) = o1;
            }
        }
        asm volatile("s_waitcnt vmcnt(0)" ::: "memory");
        __syncthreads();
        RELOAD_IDS();
    }
    { pg8::Gemm g{act, Wdt, DFF, DFF, DFF}; pg8::Sched<0> Sc; Sc.init(S, 2048, G, bx); Epi9 E{outp, modf}; pg8::gemm_phase<Epi9>(lds, g, Sc, E); }
#endif
}

extern "C" void kernel_launch(void* const* d_in, const int* in_sizes, int n_in, void* d_out, int out_size, void* d_ws, size_t ws_size, hipStream_t stream) {
    static int grid_blocks = 0;
    if (grid_blocks == 0) {
        if (n_in != 20 || out_size != S * DM || ws_size < WS_END) { fprintf(stderr, "kernel_launch: unexpected shapes (n_in %d out %d ws %zu)\n", n_in, out_size, ws_size); grid_blocks = -1; return; }
        int dev = 0, cus = 0, per_cu = 0;
        hipGetDevice(&dev);
        hipDeviceGetAttribute(&cus, hipDeviceAttributeMultiprocessorCount, dev);
        hipFuncSetAttribute((const void*)fwd_megakernel, hipFuncAttributeMaxDynamicSharedMemorySize, LDS_BYTES);
        hipOccupancyMaxActiveBlocksPerMultiprocessor(&per_cu, (const void*)fwd_megakernel, NTHR, LDS_BYTES);
        if (per_cu < 1) { fprintf(stderr, "kernel_launch: occupancy query reports %d blocks per CU\n", per_cu); grid_blocks = -1; return; }
        if (per_cu > 1) per_cu = 1;
        grid_blocks = cus * per_cu;
        if (grid_blocks > 256) grid_blocks = 256;
    }
    if (grid_blocks < 0) return;
    Params p{};
    for (int i = 0; i < 20; ++i) p.in[i] = (const float*)d_in[i];
    p.out = (float*)d_out; p.ws = (unsigned char*)d_ws;
    void* args[] = {&p};
    hipError_t e = hipLaunchCooperativeKernel((const void*)fwd_megakernel, dim3(grid_blocks), dim3(NTHR), args, LDS_BYTES, stream);
    if (e != hipSuccess) fprintf(stderr, "cooperative launch failed: %s (grid %d)\n", hipGetErrorString(e), grid_blocks);
}
```

```cpp
#include <hip/hip_runtime.h>
#include <hip/hip_cooperative_groups.h>
#include <cstdio>
#include <cstdint>
namespace cg = cooperative_groups;

#define LAS __attribute__((address_space(3)))
#define DI __device__ __forceinline__
typedef unsigned short bf16_t;
typedef short bf16x8 __attribute__((ext_vector_type(8)));
typedef short s16x4 __attribute__((ext_vector_type(4)));
typedef float f32x2 __attribute__((ext_vector_type(2)));
typedef float f32x4 __attribute__((ext_vector_type(4)));
typedef float f32x16 __attribute__((ext_vector_type(16)));
typedef unsigned u32x2 __attribute__((ext_vector_type(2)));
typedef unsigned u32x4 __attribute__((ext_vector_type(4)));
typedef __bf16 bf16x2_t __attribute__((ext_vector_type(2)));

constexpr int S = 16384, DM = 2048, NH = 8, HD = 128, AW = 1024, PW = 1024, DFF = 5632, NUP = 2 * DFF, N1 = 8192;
constexpr float EPS = 1e-6f;
constexpr int NWAVES = 8, NTHR = 512;
constexpr int LDS_BYTES = 147456;
constexpr int XL_OFF = 131072;

constexpr size_t MiB = 1u << 20;
constexpr size_t WS_ZERO = 0, ZERO_BYTES = 1 * MiB;
constexpr size_t WS_CNT = 0, WS_KMEAN = 65536, WS_BAR = 524288;
constexpr size_t WS_MODP = 1 * MiB;
constexpr size_t WS_MODF = 2 * MiB;
constexpr size_t WS_BIASUP = 2 * MiB + 65536;
constexpr size_t WS_ROWSS = 3 * MiB;
constexpr size_t WS_LSUM = 5 * MiB;
constexpr size_t WS_LIST = 8 * MiB;
constexpr size_t WS_W1 = 40 * MiB;
constexpr size_t WS_WY = 72 * MiB;
constexpr size_t WS_WO = 80 * MiB;
constexpr size_t WS_WG = 88 * MiB;
constexpr size_t WS_WD = 90 * MiB;
constexpr size_t WS_WU = 112 * MiB;
constexpr size_t WS_HB = 156 * MiB;
constexpr size_t WS_Q = 220 * MiB, WS_K = 252 * MiB, WS_V = 284 * MiB, WS_U = 316 * MiB;
constexpr size_t WS_GATES = 348 * MiB;
constexpr size_t WS_DB = 476 * MiB;
constexpr size_t WS_AM = WS_HB;
constexpr size_t WS_MERGED = 284 * MiB;
constexpr size_t WS_XG = WS_HB;
constexpr size_t WS_ACT = 220 * MiB;
constexpr size_t WS_EDGE = 400 * MiB;
constexpr size_t WS_END = 508 * MiB;

__constant__ double ROPE_C[64] = {
1.59154943091895346e-01, 1.37822502603982849e-01, 1.19349370211248862e-01, 1.03352296618434064e-01,
8.94994016088910133e-02, 7.75032887553740585e-02, 6.71150830052272551e-02, 5.81192674418762462e-02,
5.03292121044870353e-02, 4.35833021053073297e-02, 3.77415847174197711e-02, 3.26828658723569976e-02,
2.83022014470915797e-02, 2.45087088680224316e-02, 2.12236869570126724e-02, 1.83789788427912383e-02,
1.59154943091895346e-02, 1.37822502603982859e-02, 1.19349370211248869e-02, 1.03352296618434061e-02,
8.94994016088910168e-03, 7.75032887553740620e-03, 6.71150830052272551e-03, 5.81192674418762497e-03,
5.03292121044870353e-03, 4.35833021053073314e-03, 3.77415847174197694e-03, 3.26828658723569993e-03,
2.83022014470915797e-03, 2.45087088680224316e-03, 2.12236869570126715e-03, 1.83789788427912387e-03,
1.59154943091895346e-03, 1.37822502603982855e-03, 1.19349370211248860e-03, 1.03352296618434065e-03,
8.94994016088910125e-04, 7.75032887553740577e-04, 6.71150830052272594e-04, 5.81192674418762454e-04,
5.03292121044870353e-04, 4.35833021053073336e-04, 3.77415847174197716e-04, 3.26828658723569971e-04,
2.83022014470915775e-04, 2.45087088680224327e-04, 2.12236869570126726e-04, 1.83789788427912376e-04,
1.59154943091895335e-04, 1.37822502603982850e-04, 1.19349370211248865e-04, 1.03352296618434062e-04,
8.94994016088910179e-05, 7.75032887553740523e-05, 6.71150830052272540e-05, 5.81192674418762481e-05,
5.03292121044870380e-05, 4.35833021053073309e-05, 3.77415847174197689e-05, 3.26828658723569984e-05,
2.83022014470915789e-05, 2.45087088680224307e-05, 2.12236869570126719e-05, 1.83789788427912390e-05 };

DI unsigned pk2(float lo, float hi) { f32x2 v = {lo, hi}; bf16x2_t b = __builtin_convertvector(v, bf16x2_t); return __builtin_bit_cast(unsigned, b); }
DI float bflo(unsigned w) { return __uint_as_float(w << 16); }
DI float bfhi(unsigned w) { return __uint_as_float(w & 0xffff0000u); }
DI void unpack8(const u32x4 w, float* f) { f[0] = bflo(w.x); f[1] = bfhi(w.x); f[2] = bflo(w.y); f[3] = bfhi(w.y); f[4] = bflo(w.z); f[5] = bfhi(w.z); f[6] = bflo(w.w); f[7] = bfhi(w.w); }
DI u32x4 pack8(const f32x4 a, const f32x4 b) { u32x4 w; w.x = pk2(a[0], a[1]); w.y = pk2(a[2], a[3]); w.z = pk2(b[0], b[1]); w.w = pk2(b[2], b[3]); return w; }
DI float wave_sum(float v) {
#pragma unroll
    for (int o = 1; o < 64; o <<= 1) v += __shfl_xor(v, o);
    return v;
}
DI float sigmoidf_(float x) { return __builtin_amdgcn_rcpf(1.0f + __builtin_amdgcn_exp2f(x * -1.4426950408889634f)); }
#define LDS_WAIT() asm volatile("s_waitcnt lgkmcnt(0)" ::: "memory")
#define FENCE() do { asm volatile("" ::: "memory"); __builtin_amdgcn_sched_barrier(0); } while (0)
#define TIE(var, dep) asm volatile("" : "+v"(var) : "v"(dep))
#define RAW_BAR() do { asm volatile("s_waitcnt lgkmcnt(0)" ::: "memory"); __builtin_amdgcn_s_barrier(); asm volatile("" ::: "memory"); } while (0)

#ifndef PG8_USE_SP2
#define PG8_USE_SP2 1
#endif
namespace pg8 {
constexpr int BM = 256, BK = 64, HALF = 128, HTB = HALF * BK * 2, STAGE_BYTES = 8 * HTB, NXCD = 8, WGM = 8;
__host__ __device__ __forceinline__ int lds_byte(int r, int c) { const int st = (r >> 4) * 2 + (c >> 5), rr = r & 15, cc = c & 31, ob = rr * 64 + cc * 2; return st * 1024 + (ob ^ (((ob >> 9) & 1) << 5)); }
__host__ __device__ __forceinline__ void stage_rc(int b, int& R, int& C) { const int st = b / 1024, sb = b % 1024, swz = sb ^ (((sb >> 9) & 1) << 5); R = (st >> 1) * 16 + swz / 64; C = (st & 1) * 32 + (swz % 64) / 2; }
__host__ __device__ __forceinline__ int perm32(int rho) { const int n = rho >> 4, i = rho & 15; return 8 * (i >> 2) + 4 * n + (i & 3); }

struct Unit { int pm, pn, ka, kb, aux; };
struct Gemm { const bf16_t* A; const bf16_t* Bt; int lda, ldb, K; };

template <int mode> struct Sched {
    int nM, nN, nwg, G, c;
    __device__ void init(int M, int N, int G_, int c_) { nM = M / BM; nN = N / BM; nwg = nM * nN; G = G_; c = c_; }
    __device__ bool next(int i, Unit& u) const {
        const int ii = (mode == 1) ? (i >> 1) : i;
        const long L = (long)ii * G + c; if (L >= nwg) return false;
        int wgid = (int)L; { const int q = nwg / NXCD, r = nwg % NXCD, xcd = wgid % NXCD, off = wgid / NXCD; wgid = (xcd < r ? xcd * (q + 1) : r * (q + 1) + (xcd - r) * q) + off; }
        const int nig = WGM * nN, gid = wgid / nig, fm = gid * WGM, gsz = (nM - fm) < WGM ? (nM - fm) : WGM;
        u.pm = fm + ((wgid % nig) % gsz); u.pn = (wgid % nig) / gsz;
        u.aux = (mode == 1) ? (i & 1) : 0; u.ka = (mode == 1) ? 1024 * (i & 1) : ((mode == 2) ? 256 * u.pn : 0); u.kb = (mode == 1) ? 1024 * (i & 1) : 0;
        return true;
    }
};

template <class Epi, class SchedT>
DI void gemm_phase(LAS unsigned char* lds, const Gemm g, const SchedT& S, const Epi& E) {
    int tid_ = threadIdx.x; asm volatile("" : "+v"(tid_));
    const int tid = tid_, wid = __builtin_amdgcn_readfirstlane(tid >> 6), lane = tid & 63, wr = wid >> 2, wc = wid & 3, fr = lane & 15, fq = lane >> 4;
    const int nt = g.K / BK;
    unsigned voffA, voffB;
    { int R, C; stage_rc(tid * 16, R, C); const int Rb = (R & ~31) + perm32(R & 31);
      voffA = (unsigned)(R * g.lda + C) * 2u; voffB = (unsigned)(Rb * g.ldb + C) * 2u; }
    const size_t dvoffA = (size_t)64 * g.lda * 2, dvoffB = (size_t)64 * g.ldb * 2;
    const size_t kstep = (size_t)(BK * 2);
    const size_t hstepA = (size_t)HALF * g.lda * 2, hstepB = (size_t)HALF * g.ldb * 2;
    const size_t tstepA = 2 * hstepA, tstepB = 2 * hstepB;
    const unsigned ldsw = (unsigned)wid * 1024u;
    const int aoff = lds_byte(wr * 64 + fr, fq * 8), boff = lds_byte(wc * 32 + fr, fq * 8);
#define PG8_SA(b, h) (((b) * 2 + (h)) * HTB)
#define PG8_SB(b, h) ((4 + (b) * 2 + (h)) * HTB)
#define PG8_STAGE(bufoff, gbase, voff) do { _Pragma("unroll") for (int _i = 0; _i < 2; ++_i) \
        __builtin_amdgcn_global_load_lds((const unsigned*)((const char*)(gbase) + (size_t)_i * d##voff + (voff)), (LAS unsigned*)(lds + (bufoff) + ldsw + _i * 8192), 16, 0, 0); } while (0)
#define PG8_LDA(dst, b, h) do { _Pragma("unroll") for (int m = 0; m < 4; ++m) _Pragma("unroll") for (int k = 0; k < 2; ++k) dst[m][k] = *(const LAS bf16x8*)(lds + PG8_SA(b, h) + aoff + m * 2048 + k * 1024); } while (0)
#define PG8_LDB(dst, b, h) do { _Pragma("unroll") for (int n = 0; n < 2; ++n) _Pragma("unroll") for (int k = 0; k < 2; ++k) dst[n][k] = *(const LAS bf16x8*)(lds + PG8_SB(b, h) + boff + n * 2048 + k * 1024); } while (0)
#define PG8_MMA(ai, bj, At, Bt) do { __builtin_amdgcn_s_setprio(1); _Pragma("unroll") for (int m = 0; m < 4; ++m) _Pragma("unroll") for (int n = 0; n < 2; ++n) _Pragma("unroll") for (int k = 0; k < 2; ++k) \
        acc[ai][bj][m][n] = __builtin_amdgcn_mfma_f32_16x16x32_bf16(Bt[n][k], At[m][k], acc[ai][bj][m][n], 0, 0, 0); __builtin_amdgcn_s_setprio(0); } while (0)
#define PG8_WAIT_V(n) asm volatile("s_waitcnt vmcnt(" #n ")" ::: "memory")
#define PG8_WAIT_L(n) asm volatile("s_waitcnt lgkmcnt(" #n ")" ::: "memory")
#define PG8_BAR __builtin_amdgcn_s_barrier()
#define PG8_SCHED __builtin_amdgcn_sched_barrier(0)
    Unit cur, nxt; int ui = 0;
    if (!S.next(0, cur)) return;
    f32x4 acc[2][2][4][2];
#pragma unroll
    for (int a = 0; a < 2; ++a)
#pragma unroll
        for (int b = 0; b < 2; ++b)
#pragma unroll
            for (int m = 0; m < 4; ++m)
#pragma unroll
                for (int n = 0; n < 2; ++n) acc[a][b][m][n] = (f32x4){0.f, 0.f, 0.f, 0.f};
    bf16x8 At[4][2], B0[2][2], B1[2][2];
    const char* cA = (const char*)g.A + (size_t)cur.pm * tstepA + (size_t)cur.ka * 2; const char* cB = (const char*)g.Bt + (size_t)cur.pn * tstepB + (size_t)cur.kb * 2;
#if PG8_USE_SP2
    PG8_STAGE(PG8_SB(0, 0), cB, voffB); PG8_STAGE(PG8_SB(0, 1), cB + hstepB, voffB); PG8_STAGE(PG8_SA(0, 0), cA, voffA); PG8_STAGE(PG8_SA(0, 1), cA + hstepA, voffA);
    if (wr == 1) PG8_BAR;
    PG8_WAIT_V(2); PG8_BAR;
#else
    PG8_STAGE(PG8_SB(0, 0), cB, voffB); PG8_STAGE(PG8_SA(0, 0), cA, voffA); PG8_STAGE(PG8_SB(0, 1), cB + hstepB, voffB); PG8_STAGE(PG8_SA(0, 1), cA + hstepA, voffA);
    if (wr == 1) PG8_BAR;
    PG8_WAIT_V(4); PG8_BAR;
#endif
    PG8_STAGE(PG8_SB(1, 0), cB + kstep, voffB); PG8_STAGE(PG8_SA(1, 0), cA + kstep, voffA); PG8_STAGE(PG8_SB(1, 1), cB + hstepB + kstep, voffB);
    PG8_WAIT_V(6); PG8_BAR;
    for (;;) {
        const bool has_next = S.next(ui + 1, nxt);
        const char* nA = has_next ? (const char*)g.A + (size_t)nxt.pm * tstepA + (size_t)nxt.ka * 2 : cA; const char* nB = has_next ? (const char*)g.Bt + (size_t)nxt.pn * tstepB + (size_t)nxt.kb * 2 : cB;
        for (int t = 0; t < nt; t += 2) {
            const bool last = (t == nt - 2);
            const char* a1 = cA + (size_t)(t + 1) * kstep;
            const char* a2 = last ? nA : cA + (size_t)(t + 2) * kstep; const char* b2 = last ? nB : cB + (size_t)(t + 2) * kstep;
            const char* a3 = a2 + kstep; const char* b3 = b2 + kstep;
#if PG8_USE_SP2
            PG8_LDB(B0, 0, 0); PG8_LDB(B1, 0, 1); PG8_SCHED; PG8_LDA(At, 0, 0); PG8_STAGE(PG8_SA(1, 1), a1 + hstepA, voffA);
            PG8_WAIT_V(8); PG8_WAIT_L(0); PG8_BAR; PG8_MMA(0, 0, At, B0); PG8_MMA(0, 1, At, B1); PG8_BAR; PG8_SCHED;
            PG8_LDA(At, 0, 1); PG8_STAGE(PG8_SB(0, 0), b2, voffB); PG8_STAGE(PG8_SB(0, 1), b2 + hstepB, voffB); PG8_STAGE(PG8_SA(0, 0), a2, voffA);
            PG8_WAIT_V(8); PG8_WAIT_L(0); PG8_BAR; PG8_MMA(1, 0, At, B0); PG8_MMA(1, 1, At, B1); PG8_BAR; PG8_SCHED;
            PG8_LDB(B0, 1, 0); PG8_LDB(B1, 1, 1); PG8_SCHED; PG8_LDA(At, 1, 0); PG8_STAGE(PG8_SA(0, 1), a2 + hstepA, voffA);
            PG8_WAIT_V(8); PG8_WAIT_L(0); PG8_BAR; PG8_MMA(0, 0, At, B0); PG8_MMA(0, 1, At, B1); PG8_BAR; PG8_SCHED;
            PG8_LDA(At, 1, 1); PG8_STAGE(PG8_SB(1, 0), b3, voffB); PG8_STAGE(PG8_SB(1, 1), b3 + hstepB, voffB); PG8_STAGE(PG8_SA(1, 0), a3, voffA);
            PG8_WAIT_V(8); PG8_WAIT_L(0); PG8_BAR; PG8_MMA(1, 0, At, B0); PG8_MMA(1, 1, At, B1); PG8_BAR; PG8_SCHED;
#else
            PG8_LDB(B0, 0, 0); PG8_SCHED; PG8_LDA(At, 0, 0); PG8_STAGE(PG8_SA(1, 1), a1 + hstepA, voffA);
            PG8_WAIT_L(8); PG8_BAR; PG8_WAIT_L(0); PG8_MMA(0, 0, At, B0); PG8_BAR; PG8_SCHED;
            PG8_LDB(B1, 0, 1); PG8_STAGE(PG8_SB(0, 0), b2, voffB);
            PG8_BAR; PG8_WAIT_L(0); PG8_MMA(0, 1, At, B1); PG8_BAR;
            PG8_LDA(At, 0, 1); PG8_STAGE(PG8_SA(0, 0), a2, voffA);
            PG8_BAR; PG8_WAIT_L(0); PG8_MMA(1, 0, At, B0); PG8_BAR; PG8_SCHED;
            PG8_STAGE(PG8_SB(0, 1), b2 + hstepB, voffB);
            PG8_WAIT_V(6); PG8_BAR; PG8_MMA(1, 1, At, B1); PG8_BAR;
            PG8_LDB(B0, 1, 0); PG8_SCHED; PG8_LDA(At, 1, 0); PG8_STAGE(PG8_SA(0, 1), a2 + hstepA, voffA);
            PG8_WAIT_L(8); PG8_BAR; PG8_WAIT_L(0); PG8_MMA(0, 0, At, B0); PG8_BAR; PG8_SCHED;
            PG8_LDB(B1, 1, 1); PG8_STAGE(PG8_SB(1, 0), b3, voffB);
            PG8_BAR; PG8_WAIT_L(0); PG8_MMA(0, 1, At, B1); PG8_BAR;
            PG8_LDA(At, 1, 1); PG8_STAGE(PG8_SA(1, 0), a3, voffA);
            PG8_BAR; PG8_WAIT_L(0); PG8_MMA(1, 0, At, B0); PG8_BAR; PG8_SCHED;
            PG8_STAGE(PG8_SB(1, 1), b3 + hstepB, voffB);
            PG8_WAIT_V(6); PG8_BAR; PG8_MMA(1, 1, At, B1); PG8_BAR;
#endif
        }
        if (wr == 0) PG8_BAR;
        { int l2 = threadIdx.x; asm volatile("" : "+v"(l2)); l2 &= 63;
          E(acc, cur, wr, wc, l2 & 15, l2 >> 4, lds + XL_OFF); }
        if (!has_next) break;
        if (!(Epi::CHAIN && cur.aux == 0)) {
#pragma unroll
            for (int a = 0; a < 2; ++a)
#pragma unroll
                for (int b = 0; b < 2; ++b)
#pragma unroll
                    for (int m = 0; m < 4; ++m)
#pragma unroll
                        for (int n = 0; n < 2; ++n) acc[a][b][m][n] = (f32x4){0.f, 0.f, 0.f, 0.f};
        }
        cur = nxt; cA = nA; cB = nB; ++ui;
        if (wr == 1) PG8_BAR;
    }
    PG8_WAIT_V(0);
    PG8_BAR;
}

template <class Epi, class SchedT>
DI void gemm_phase_drain(LAS unsigned char* lds, const Gemm g, const SchedT& S, const Epi& E) {
    int tid_ = threadIdx.x; asm volatile("" : "+v"(tid_));
    const int tid = tid_, wid = __builtin_amdgcn_readfirstlane(tid >> 6), lane = tid & 63, wr = wid >> 2, wc = wid & 3, fr = lane & 15, fq = lane >> 4;
    const int nt = g.K / BK;
    unsigned voffA, voffB;
    { int R, C; stage_rc(tid * 16, R, C); const int Rb = (R & ~31) + perm32(R & 31);
      voffA = (unsigned)(R * g.lda + C) * 2u; voffB = (unsigned)(Rb * g.ldb + C) * 2u; }
    const size_t dvoffA = (size_t)64 * g.lda * 2, dvoffB = (size_t)64 * g.ldb * 2;
    const size_t kstep = (size_t)(BK * 2);
    const size_t hstepA = (size_t)HALF * g.lda * 2, hstepB = (size_t)HALF * g.ldb * 2;
    const size_t tstepA = 2 * hstepA, tstepB = 2 * hstepB;
    const unsigned ldsw = (unsigned)wid * 1024u;
    const int aoff = lds_byte(wr * 64 + fr, fq * 8), boff = lds_byte(wc * 32 + fr, fq * 8);
    bool primed = false; Unit cur, nxt;
    bool have = S.next(0, cur);
    for (int ui = 0; have; ++ui) {
        f32x4 acc[2][2][4][2];
#pragma unroll
        for (int a = 0; a < 2; ++a)
#pragma unroll
            for (int b = 0; b < 2; ++b)
#pragma unroll
                for (int m = 0; m < 4; ++m)
#pragma unroll
                    for (int n = 0; n < 2; ++n) acc[a][b][m][n] = (f32x4){0.f, 0.f, 0.f, 0.f};
        bf16x8 At[4][2], B0[2][2], B1[2][2];
        const char* cA = (const char*)g.A + (size_t)cur.pm * tstepA + (size_t)cur.ka * 2; const char* cB = (const char*)g.Bt + (size_t)cur.pn * tstepB + (size_t)cur.kb * 2;
        if (!primed) {
#if PG8_USE_SP2
        PG8_STAGE(PG8_SB(0, 0), cB, voffB); PG8_STAGE(PG8_SB(0, 1), cB + hstepB, voffB); PG8_STAGE(PG8_SA(0, 0), cA, voffA); PG8_STAGE(PG8_SA(0, 1), cA + hstepA, voffA);
        if (wr == 1) PG8_BAR;
        PG8_WAIT_V(2); PG8_BAR;
#else
        PG8_STAGE(PG8_SB(0, 0), cB, voffB); PG8_STAGE(PG8_SA(0, 0), cA, voffA); PG8_STAGE(PG8_SB(0, 1), cB + hstepB, voffB); PG8_STAGE(PG8_SA(0, 1), cA + hstepA, voffA);
        if (wr == 1) PG8_BAR;
        PG8_WAIT_V(4); PG8_BAR;
#endif
        PG8_STAGE(PG8_SB(1, 0), cB + kstep, voffB); PG8_STAGE(PG8_SA(1, 0), cA + kstep, voffA); PG8_STAGE(PG8_SB(1, 1), cB + hstepB + kstep, voffB);
        PG8_WAIT_V(6); PG8_BAR;
        }
        const bool has_next = S.next(ui + 1, nxt); const bool pf = has_next && !E.uses_lds(cur);
        const char* nA = pf ? (const char*)g.A + (size_t)nxt.pm * tstepA + (size_t)nxt.ka * 2 : cA; const char* nB = pf ? (const char*)g.Bt + (size_t)nxt.pn * tstepB + (size_t)nxt.kb * 2 : cB;
        for (int t = 0; t < nt; t += 2) {
            const bool last = (t == nt - 2);
            const char* a1 = cA + (size_t)(t + 1) * kstep;
            const char* a2 = last ? nA : cA + (size_t)(t + 2) * kstep; const char* b2 = last ? nB : cB + (size_t)(t + 2) * kstep;
            const char* a3 = a2 + kstep; const char* b3 = b2 + kstep;
#if PG8_USE_SP2
            PG8_LDB(B0, 0, 0); PG8_LDB(B1, 0, 1); PG8_SCHED; PG8_LDA(At, 0, 0); PG8_STAGE(PG8_SA(1, 1), a1 + hstepA, voffA);
            PG8_WAIT_V(8); PG8_WAIT_L(0); PG8_BAR; PG8_MMA(0, 0, At, B0); PG8_MMA(0, 1, At, B1); PG8_BAR; PG8_SCHED;
            PG8_LDA(At, 0, 1); PG8_STAGE(PG8_SB(0, 0), b2, voffB); PG8_STAGE(PG8_SB(0, 1), b2 + hstepB, voffB); PG8_STAGE(PG8_SA(0, 0), a2, voffA);
            PG8_WAIT_V(8); PG8_WAIT_L(0); PG8_BAR; PG8_MMA(1, 0, At, B0); PG8_MMA(1, 1, At, B1); PG8_BAR; PG8_SCHED;
            PG8_LDB(B0, 1, 0); PG8_LDB(B1, 1, 1); PG8_SCHED; PG8_LDA(At, 1, 0); PG8_STAGE(PG8_SA(0, 1), a2 + hstepA, voffA);
            PG8_WAIT_V(8); PG8_WAIT_L(0); PG8_BAR; PG8_MMA(0, 0, At, B0); PG8_MMA(0, 1, At, B1); PG8_BAR; PG8_SCHED;
            PG8_LDA(At, 1, 1); PG8_STAGE(PG8_SB(1, 0), b3, voffB); PG8_STAGE(PG8_SB(1, 1), b3 + hstepB, voffB); PG8_STAGE(PG8_SA(1, 0), a3, voffA);
            PG8_WAIT_V(8); PG8_WAIT_L(0); PG8_BAR; PG8_MMA(1, 0, At, B0); PG8_MMA(1, 1, At, B1); PG8_BAR; PG8_SCHED;
#else
            PG8_LDB(B0, 0, 0); PG8_SCHED; PG8_LDA(At, 0, 0); PG8_STAGE(PG8_SA(1, 1), a1 + hstepA, voffA);
            PG8_WAIT_L(8); PG8_BAR; PG8_WAIT_L(0); PG8_MMA(0, 0, At, B0); PG8_BAR; PG8_SCHED;
            PG8_LDB(B1, 0, 1); PG8_STAGE(PG8_SB(0, 0), b2, voffB);
            PG8_BAR; PG8_WAIT_L(0); PG8_MMA(0, 1, At, B1); PG8_BAR;
            PG8_LDA(At, 0, 1); PG8_STAGE(PG8_SA(0, 0), a2, voffA);
            PG8_BAR; PG8_WAIT_L(0); PG8_MMA(1, 0, At, B0); PG8_BAR; PG8_SCHED;
            PG8_STAGE(PG8_SB(0, 1), b2 + hstepB, voffB);
            PG8_WAIT_V(6); PG8_BAR; PG8_MMA(1, 1, At, B1); PG8_BAR;
            PG8_LDB(B0, 1, 0); PG8_SCHED; PG8_LDA(At, 1, 0); PG8_STAGE(PG8_SA(0, 1), a2 + hstepA, voffA);
            PG8_WAIT_L(8); PG8_BAR; PG8_WAIT_L(0); PG8_MMA(0, 0, At, B0); PG8_BAR; PG8_SCHED;
            PG8_LDB(B1, 1, 1); PG8_STAGE(PG8_SB(1, 0), b3, voffB);
            PG8_BAR; PG8_WAIT_L(0); PG8_MMA(0, 1, At, B1); PG8_BAR;
            PG8_LDA(At, 1, 1); PG8_STAGE(PG8_SA(1, 0), a3, voffA);
            PG8_BAR; PG8_WAIT_L(0); PG8_MMA(1, 0, At, B0); PG8_BAR; PG8_SCHED;
            PG8_STAGE(PG8_SB(1, 1), b3 + hstepB, voffB);
            PG8_WAIT_V(6); PG8_BAR; PG8_MMA(1, 1, At, B1); PG8_BAR;
#endif
        }
        if (wr == 0) PG8_BAR;
        if (pf) {
            { int t2 = threadIdx.x; asm volatile("" : "+v"(t2)); E.drain(acc, cur, wr, wc, t2 & 15, (t2 & 63) >> 4, lds, t2); }
            if (wr == 1) PG8_BAR;
            primed = true;
        } else {
            PG8_WAIT_V(0); PG8_WAIT_L(0); PG8_BAR;
            { int t2 = threadIdx.x; asm volatile("" : "+v"(t2)); E.drain(acc, cur, wr, wc, t2 & 15, (t2 & 63) >> 4, lds, t2); }
            PG8_WAIT_L(0); PG8_BAR;
            primed = false;
        }
        have = has_next; cur = nxt;
    }
#undef PG8_SA
#undef PG8_SB
#undef PG8_STAGE
#undef PG8_LDA
#undef PG8_LDB
#undef PG8_MMA
#undef PG8_WAIT_V
#undef PG8_WAIT_L
#undef PG8_BAR
#undef PG8_SCHED
}
}
using pg8::Unit;
typedef f32x4 AccT[2][2][4][2];

constexpr int PT = 260;
struct Epi1 {
    static constexpr bool CHAIN = false;
    DI bool uses_lds(const Unit& u) const { return u.pn < 8; }
    bf16_t *q, *k, *v, *ub, *gates; float* kmean; const float *qg, *kg, *bgate;
    DI void drain(AccT& acc, const Unit& u, int wr, int wc, int fr, int fq, LAS unsigned char* lds, int tid) const {
        const int pn = u.pn; const int rowb = u.pm * 256 + wr * 64 + fr;
        bf16_t *pq = q, *pk = k, *pv = v, *pu = ub, *pg = gates; const float *pqg = qg, *pkg = kg;
        asm volatile("" : "+s"(pq), "+s"(pk), "+s"(pv), "+s"(pu), "+s"(pg), "+s"(pqg), "+s"(pkg));
        if (pn >= 16) {
            const int c0 = (pn - 16) * 128 + wc * 32 + fq * 8;
            f32x4 ba[2], bb[2];
#pragma unroll
            for (int n = 0; n < 2; ++n) { ba[n] = *(const f32x4*)(bgate + c0 + 4 * n); bb[n] = *(const f32x4*)(bgate + 2048 + c0 + 4 * n); }
#pragma unroll
            for (int ai = 0; ai < 2; ++ai)
#pragma unroll
                for (int m = 0; m < 4; ++m) { bf16_t* rowp = pg + (size_t)(rowb + ai * 128 + m * 16) * 4096 + c0;
                    f32x4 rr[2], gg[2];
#pragma unroll
                    for (int n = 0; n < 2; ++n)
#pragma unroll
                        for (int i = 0; i < 4; ++i) { const float ea = __builtin_amdgcn_exp2f((acc[ai][0][m][n][i] + ba[n][i]) * -1.4426950408889634f), eb = __builtin_amdgcn_exp2f((acc[ai][1][m][n][i] + bb[n][i]) * -1.4426950408889634f);
                            gg[n][i] = __builtin_amdgcn_rcpf(1.0f + eb); rr[n][i] = (1.0f + eb) * __builtin_amdgcn_rcpf(1.0f + ea); }
                    *(u32x4*)rowp = pack8(rr[0], rr[1]); *(u32x4*)(rowp + 2048) = pack8(gg[0], gg[1]); }
            return;
        }
        if (pn >= 8) {
            bf16_t* base; int ldc, col0; const bool sig = false;
            if (pn < 12) { base = pv; ldc = 1024; col0 = (pn - 8) * 256; } else { base = pu; ldc = 1024; col0 = (pn - 12) * 256; }
            col0 += wc * 32 + fq * 8;
            f32x4 bv[2][2];
#pragma unroll
            for (int bj = 0; bj < 2; ++bj)
#pragma unroll
                for (int n = 0; n < 2; ++n) bv[bj][n] = sig ? *(const f32x4*)(bgate + col0 + bj * 128 + 4 * n) : (f32x4){0.f, 0.f, 0.f, 0.f};
#pragma unroll
            for (int ai = 0; ai < 2; ++ai)
#pragma unroll
                for (int m = 0; m < 4; ++m) { bf16_t* rowp = base + (size_t)(rowb + ai * 128 + m * 16) * ldc + col0;
#pragma unroll
                    for (int bj = 0; bj < 2; ++bj) { f32x4 v0 = acc[ai][bj][m][0] + bv[bj][0], v1 = acc[ai][bj][m][1] + bv[bj][1];
                        if (sig) {
#pragma unroll
                            for (int i = 0; i < 4; ++i) { v0[i] = sigmoidf_(v0[i]); v1[i] = sigmoidf_(v1[i]); } }
                        *(u32x4*)(rowp + bj * 128) = pack8(v0, v1); } }
            return;
        }
        const bool isq = pn < 4; const int hp = (pn & 3) * 2;
        const float* g = isq ? pqg : pkg; bf16_t* dst = isq ? pq : pk;
        const float qs = isq ? 0.08838834764831845f * 1.4426950408889634f : 1.0f;
        LAS float* T = (LAS float*)lds;
        const int r = tid >> 2, part = tid & 3, bj2 = part >> 1, sub = part & 1;
        float ksum = 0.f;
#pragma unroll
        for (int ai = 0; ai < 2; ++ai) {
#pragma unroll
            for (int m = 0; m < 4; ++m)
#pragma unroll
                for (int bj = 0; bj < 2; ++bj)
#pragma unroll
                    for (int n = 0; n < 2; ++n) *(LAS f32x4*)(T + (64 * wr + 16 * m + fr) * PT + 128 * bj + 32 * wc + 8 * fq + 4 * n) = acc[ai][bj][m][n];
            RAW_BAR();
            LAS float* rowp = T + r * PT + 128 * bj2 + 32 * sub;
            float ss = 0.f;
#pragma unroll
            for (int j = 0; j < 8; ++j) { const f32x4 a = *(const LAS f32x4*)(rowp + 4 * j), b = *(const LAS f32x4*)(rowp + 64 + 4 * j);
                ss += (a[0] * a[0] + a[1] * a[1]) + (a[2] * a[2] + a[3] * a[3]) + (b[0] * b[0] + b[1] * b[1]) + (b[2] * b[2] + b[3] * b[3]); }
            ss += __shfl_xor(ss, 1);
            const float rr = __builtin_amdgcn_rsqf(ss * (1.0f / 128.0f) + EPS) * qs;
            const int row = u.pm * 256 + ai * 128 + r;
            bf16_t* op = dst + (size_t)row * 1024 + (hp + bj2) * 128 + 32 * sub;
#pragma unroll 1
            for (int j = 0; j < 8; j += 2) {
                f32x4 o1[2], o2[2];
#pragma unroll
                for (int jj = 0; jj < 2; ++jj) {
                    const int d = 32 * sub + 4 * (j + jj);
                    const f32x4 x1 = *(const LAS f32x4*)(rowp + 4 * (j + jj)), x2 = *(const LAS f32x4*)(rowp + 64 + 4 * (j + jj));
                    const f32x4 g0 = *(const f32x4*)(g + d), g1 = *(const f32x4*)(g + 64 + d);
                    f32x4 cs, sn;
#pragma unroll
                    for (int i = 0; i < 4; ++i) { double t = (double)row * ROPE_C[d + i]; t -= __builtin_floor(t); const float tf = (float)t; cs[i] = __builtin_amdgcn_cosf(tf); sn[i] = __builtin_amdgcn_sinf(tf); }
                    const f32x4 a = x1 * rr * g0, b = x2 * rr * g1;
                    o1[jj] = a * cs - b * sn; o2[jj] = b * cs + a * sn;
                    if (!isq) { *(LAS f32x4*)(rowp + 4 * (j + jj)) = o1[jj]; *(LAS f32x4*)(rowp + 64 + 4 * (j + jj)) = o2[jj]; }
                }
                *(u32x4*)(op + 4 * j) = pack8(o1[0], o1[1]); *(u32x4*)(op + 64 + 4 * j) = pack8(o2[0], o2[1]);
            }
            if (!isq) { RAW_BAR(); if (tid < 256) {
#pragma unroll 8
                for (int rr2 = 0; rr2 < 128; ++rr2) ksum += T[rr2 * PT + tid]; } }
            RAW_BAR();
        }
        if (!isq && tid < 256) kmean[((size_t)(hp + (tid >> 7)) * 64 + u.pm) * 128 + (tid & 127)] = ksum * (1.0f / 256.0f);
    }
};

struct Epi3 {
    static constexpr bool CHAIN = false;
    bf16_t* am; const float* ls;
    DI void drain(AccT& acc, const Unit& u, int wr, int wc, int fr, int fq, LAS unsigned char* l, int) const { (*this)(acc, u, wr, wc, fr, fq, l); }
    DI void operator()(AccT& acc, const Unit& u, int wr, int wc, int fr, int fq, LAS unsigned char*) const {
        const int col0 = u.pn * 256 + wc * 32 + fq * 8; const int rowb = u.pm * 256 + wr * 64 + fr;
        f32x4 sv[2][2];
#pragma unroll
        for (int bj = 0; bj < 2; ++bj)
#pragma unroll
            for (int n = 0; n < 2; ++n) sv[bj][n] = *(const f32x4*)(ls + col0 + bj * 128 + 4 * n);
#pragma unroll
        for (int ai = 0; ai < 2; ++ai)
#pragma unroll
            for (int m = 0; m < 4; ++m) { bf16_t* rowp = am + (size_t)(rowb + ai * 128 + m * 16) * 2048 + 1024 + col0;
#pragma unroll
                for (int bj = 0; bj < 2; ++bj) *(u32x4*)(rowp + bj * 128) = pack8(acc[ai][bj][m][0] * sv[bj][0], acc[ai][bj][m][1] * sv[bj][1]); }
    }
};

struct Epi5 {
    static constexpr bool CHAIN = true;
    const bf16_t* gates; bf16_t* merged;
    DI void operator()(AccT& acc, const Unit& u, int wr, int wc, int fr, int fq, LAS unsigned char*) const {
        const int col0 = u.pn * 256 + wc * 32 + fq * 8; const int rowb = u.pm * 256 + wr * 64 + fr;
        if (u.aux == 0) {
#pragma unroll
            for (int ai = 0; ai < 2; ++ai) {
                u32x4 gw[4][2];
#pragma unroll
                for (int m = 0; m < 4; ++m)
#pragma unroll
                    for (int bj = 0; bj < 2; ++bj) gw[m][bj] = *(const u32x4*)(gates + (size_t)(rowb + ai * 128 + m * 16) * 4096 + col0 + bj * 128);
#pragma unroll
                for (int m = 0; m < 4; ++m)
#pragma unroll
                    for (int bj = 0; bj < 2; ++bj) { float gr[8]; unpack8(gw[m][bj], gr);
#pragma unroll
                        for (int i = 0; i < 4; ++i) { acc[ai][bj][m][0][i] *= gr[i]; acc[ai][bj][m][1][i] *= gr[4 + i]; } }
                FENCE();
            }
        } else {
#pragma unroll
            for (int ai = 0; ai < 2; ++ai) {
                u32x4 gw[4][2];
#pragma unroll
                for (int m = 0; m < 4; ++m)
#pragma unroll
                    for (int bj = 0; bj < 2; ++bj) gw[m][bj] = *(const u32x4*)(gates + (size_t)(rowb + ai * 128 + m * 16) * 4096 + 2048 + col0 + bj * 128);
#pragma unroll
                for (int m = 0; m < 4; ++m)
#pragma unroll
                    for (int bj = 0; bj < 2; ++bj) { float gp[8]; unpack8(gw[m][bj], gp); f32x4 v0, v1;
#pragma unroll
                        for (int i = 0; i < 4; ++i) { v0[i] = acc[ai][bj][m][0][i] * gp[i]; v1[i] = acc[ai][bj][m][1][i] * gp[4 + i]; }
                        *(u32x4*)(merged + (size_t)(rowb + ai * 128 + m * 16) * 2048 + col0 + bj * 128) = pack8(v0, v1); }
                FENCE();
            }
        }
    }
};

struct Epi6 {
    static constexpr bool CHAIN = false;
    const float* x; float* out; bf16_t* xg; const float* modf; const float* nfg; float* rowss;
    DI void operator()(AccT& acc, const Unit& u, int wr, int wc, int fr, int fq, LAS unsigned char*) const {
        const int col0 = u.pn * 256 + wc * 32 + fq * 8; const int rowb = u.pm * 256 + wr * 64 + fr;
        f32x4 g1v[2][2], gmv[2][2];
#pragma unroll
        for (int bj = 0; bj < 2; ++bj)
#pragma unroll
            for (int n = 0; n < 2; ++n) { const int c = col0 + bj * 128 + 4 * n; g1v[bj][n] = *(const f32x4*)(modf + 2 * 2048 + c);
                gmv[bj][n] = *(const f32x4*)(nfg + c) * (*(const f32x4*)(modf + 4 * 2048 + c) + 1.0f); }
#pragma unroll
        for (int ag = 0; ag < 4; ++ag) { const int ai = ag >> 1, m0 = (ag & 1) * 2;
            f32x4 xr[4][2][2];
#pragma unroll
            for (int m = m0; m < m0 + 2; ++m)
#pragma unroll
                for (int bj = 0; bj < 2; ++bj) { const size_t off = (size_t)(rowb + ai * 128 + m * 16) * 2048 + col0 + bj * 128;
                    xr[m][bj][0] = *(const f32x4*)(x + off); xr[m][bj][1] = *(const f32x4*)(x + off + 4); }
            FENCE();
#pragma unroll
            for (int m = m0; m < m0 + 2; ++m) { const size_t row = (size_t)(rowb + ai * 128 + m * 16); float ss = 0.f;
#pragma unroll
                for (int bj = 0; bj < 2; ++bj) { const size_t off = row * 2048 + col0 + bj * 128;
                    const f32x4 y0 = xr[m][bj][0] + g1v[bj][0] * acc[ai][bj][m][0], y1 = xr[m][bj][1] + g1v[bj][1] * acc[ai][bj][m][1];
                    *(f32x4*)(out + off) = y0; *(f32x4*)(out + off + 4) = y1;
                    *(u32x4*)(xg + off) = pack8(y0 * gmv[bj][0], y1 * gmv[bj][1]);
                    ss += (y0[0] * y0[0] + y0[1] * y0[1]) + (y0[2] * y0[2] + y0[3] * y0[3]) + (y1[0] * y1[0] + y1[1] * y1[1]) + (y1[2] * y1[2] + y1[3] * y1[3]); }
                ss += __shfl_xor(ss, 16); ss += __shfl_xor(ss, 32);
                if (fq == 0) rowss[row * 32 + u.pn * 4 + wc] = ss; }
            FENCE();
        }
    }
};

struct Epi7 {
    static constexpr bool CHAIN = false;
    DI bool uses_lds(const Unit&) const { return true; }
    const float* rsb; const float* biasup; const float* cw; const float* cb; bf16_t* act; float* edge;
    DI void drain(AccT& acc, const Unit& u, int wr, int wc, int fr, int fq, LAS unsigned char* lds, int tid) const {
        LAS float* T = (LAS float*)lds;
        const int cgi = tid & 15, rg = tid >> 4;
        const int lcb = u.pn * 128;
#pragma unroll
        for (int ai = 0; ai < 2; ++ai) {
            {
                float rs[4];
#pragma unroll
                for (int m = 0; m < 4; ++m) rs[m] = rsb[u.pm * 256 + ai * 128 + 64 * wr + 16 * m + fr];
#pragma unroll
                for (int bj = 0; bj < 2; ++bj)
#pragma unroll
                    for (int n = 0; n < 2; ++n) { const f32x4 bi = *(const f32x4*)(biasup + u.pn * 256 + 128 * bj + 32 * wc + 8 * fq + 4 * n);
#pragma unroll
                        for (int m = 0; m < 4; ++m) *(LAS f32x4*)(T + (2 + 64 * wr + 16 * m + fr) * PT + 128 * bj + 32 * wc + 8 * fq + 4 * n) = acc[ai][bj][m][n] * rs[m] + bi; }
            }
            RAW_BAR();
            {
                const int cg8 = (tid >> 1) & 15, h4 = tid & 1, rgi = tid >> 5;
                const int cc = 8 * cg8 + 4 * h4, lca = lcb + cc, lcbb = DFF + lcb + cc;
                const f32x4 wa0 = *(const f32x4*)(cw + lca), wa1 = *(const f32x4*)(cw + NUP + lca), wa2 = *(const f32x4*)(cw + 2 * NUP + lca), ca0 = *(const f32x4*)(cb + lca);
                const f32x4 wb0 = *(const f32x4*)(cw + lcbb), wb1 = *(const f32x4*)(cw + NUP + lcbb), wb2 = *(const f32x4*)(cw + 2 * NUP + lcbb), cb0 = *(const f32x4*)(cb + lcbb);
#pragma unroll 1
                for (int ch = 0; ch < 2; ++ch) {
                    const int r0 = 8 * rgi + 4 * ch;
                    f32x4 xa[6], xb[6];
#pragma unroll
                    for (int kx = 0; kx < 6; ++kx) { xa[kx] = *(const LAS f32x4*)(T + (r0 + kx) * PT + cc); xb[kx] = *(const LAS f32x4*)(T + (r0 + kx) * PT + 128 + cc); }
                    u32x2 pw[4];
#pragma unroll
                    for (int kx = 0; kx < 4; ++kx) { const f32x4 av = ca0 + wa0 * xa[kx] + wa1 * xa[kx + 1] + wa2 * xa[kx + 2], bv = cb0 + wb0 * xb[kx] + wb1 * xb[kx + 1] + wb2 * xb[kx + 2];
                        float rv[4];
#pragma unroll
                        for (int i = 0; i < 4; ++i) rv[i] = av[i] * sigmoidf_(av[i]) * bv[i];
                        pw[kx].x = pk2(rv[0], rv[1]); pw[kx].y = pk2(rv[2], rv[3]); }
                    const u32x2 s0 = h4 ? pw[0] : pw[2], s1 = h4 ? pw[1] : pw[3];
                    u32x2 g0, g1; g0.x = __shfl_xor(s0.x, 1); g0.y = __shfl_xor(s0.y, 1); g1.x = __shfl_xor(s1.x, 1); g1.y = __shfl_xor(s1.y, 1);
                    const u32x2 m0 = h4 ? pw[2] : pw[0], m1 = h4 ? pw[3] : pw[1];
                    const u32x4 o0 = h4 ? (u32x4){g0.x, g0.y, m0.x, m0.y} : (u32x4){m0.x, m0.y, g0.x, g0.y};
                    const u32x4 o1 = h4 ? (u32x4){g1.x, g1.y, m1.x, m1.y} : (u32x4){m1.x, m1.y, g1.x, g1.y};
                    if (!(ai == 0 && rgi == 0 && ch == 0 && h4 == 0)) {
                        const size_t row = (size_t)(u.pm * 256 + ai * 128 + r0 + 2 * h4);
                        *(u32x4*)(act + row * DFF + lcb + 8 * cg8) = o0; *(u32x4*)(act + (row + 1) * DFF + lcb + 8 * cg8) = o1; }
                }
            }
            if (tid < 128) { const int sel = tid >> 6, col4 = (tid & 63) * 4; const int lc = (col4 < 128) ? (lcb + col4) : (DFF + lcb + col4 - 128);
                const f32x4 ev = *(const LAS f32x4*)(T + ((ai == 0 ? 2 : 128) + sel) * PT + col4);
                *(f32x4*)(edge + ((size_t)(u.pm * 4 + 2 * ai + sel)) * NUP + lc) = ev; }
            RAW_BAR();
            if (ai == 0) { if (tid < 128) { const int sel = tid >> 6, col4 = (tid & 63) * 4; *(LAS f32x4*)(T + sel * PT + col4) = *(const LAS f32x4*)(T + (128 + sel) * PT + col4); }
                RAW_BAR(); }
        }
    }
};

struct Epi9 {
    static constexpr bool CHAIN = false;
    float* out; const float* modf;
    DI void operator()(AccT& acc, const Unit& u, int wr, int wc, int fr, int fq, LAS unsigned char*) const {
        const int col0 = u.pn * 256 + wc * 32 + fq * 8; const int rowb = u.pm * 256 + wr * 64 + fr;
        f32x4 g2v[2][2];
#pragma unroll
        for (int bj = 0; bj < 2; ++bj)
#pragma unroll
            for (int n = 0; n < 2; ++n) g2v[bj][n] = *(const f32x4*)(modf + 5 * 2048 + col0 + bj * 128 + 4 * n);
#pragma unroll
        for (int ag = 0; ag < 4; ++ag) { const int ai = ag >> 1, m0 = (ag & 1) * 2;
            f32x4 xr[4][2][2];
#pragma unroll
            for (int m = m0; m < m0 + 2; ++m)
#pragma unroll
                for (int bj = 0; bj < 2; ++bj) { const size_t off = (size_t)(rowb + ai * 128 + m * 16) * 2048 + col0 + bj * 128;
                    xr[m][bj][0] = *(const f32x4*)(out + off); xr[m][bj][1] = *(const f32x4*)(out + off + 4); }
            FENCE();
#pragma unroll
            for (int m = m0; m < m0 + 2; ++m)
#pragma unroll
                for (int bj = 0; bj < 2; ++bj) { const size_t off = (size_t)(rowb + ai * 128 + m * 16) * 2048 + col0 + bj * 128;
                    *(f32x4*)(out + off) = xr[m][bj][0] + g2v[bj][0] * acc[ai][bj][m][0]; *(f32x4*)(out + off + 4) = xr[m][bj][1] + g2v[bj][1] * acc[ai][bj][m][1]; }
            FENCE();
        }
    }
};

DI int dest_row(int mode, int n) {
    if (mode == 1) { if (n >= 2048) return n; const int d = n & 127; return (n & ~127) + 32 * ((d >> 4) & 3) + 8 * ((d >> 2) & 3) + 4 * (d >> 6) + (d & 3); }
    if (mode == 2) { const int bj = n >= DFF ? 1 : 0, cc = n - bj * DFF; return 256 * (cc >> 7) + 128 * bj + (cc & 127); }
    if (mode == 3) { const int bj = n >= 2048 ? 1 : 0, cc = n - bj * 2048; return 256 * (cc >> 7) + 128 * bj + (cc & 127); }
    return n;
}
DI void transpose_item(const float* W, int N, bf16_t* WT, int ldd, int koff, int row_off, int mode, LAS float* scr, int item, int lane) {
    const int nblk = N / 64, kb = item / nblk, nb = item % nblk, k0 = 64 * kb, n0 = 64 * nb;
    const int kr = lane >> 4, n4 = (lane & 15) * 4;
    f32x4 v[16];
#pragma unroll
    for (int i = 0; i < 16; ++i) v[i] = __builtin_nontemporal_load((const f32x4*)(W + (size_t)(k0 + 4 * i + kr) * N + n0 + n4));
#pragma unroll
    for (int i = 0; i < 16; ++i) { LAS float* d = scr + (4 * i + kr) * 65 + n4; d[0] = v[i][0]; d[1] = v[i][1]; d[2] = v[i][2]; d[3] = v[i][3]; }
    LDS_WAIT(); asm volatile("" ::: "memory");
    const int c = lane & 7;
#pragma unroll
    for (int j = 0; j < 8; ++j) { const int n = (lane >> 3) + 8 * j; const LAS float* sp = scr + (8 * c) * 65 + n;
        u32x4 o; o.x = pk2(sp[0 * 65], sp[1 * 65]); o.y = pk2(sp[2 * 65], sp[3 * 65]); o.z = pk2(sp[4 * 65], sp[5 * 65]); o.w = pk2(sp[6 * 65], sp[7 * 65]);
        *(u32x4*)(WT + (size_t)(row_off + dest_row(mode, n0 + n)) * ldd + koff + k0 + 8 * c) = o; }
    LDS_WAIT(); asm volatile("" ::: "memory");
}

DI s16x4 vtr(const LAS unsigned char* p) { typedef short v4i16_t __attribute__((ext_vector_type(4))); return __builtin_bit_cast(s16x4, __builtin_amdgcn_ds_read_tr16_b64_v4i16((LAS v4i16_t*)p)); }
constexpr int KV_PITCH = 272;
constexpr int LDS_KS = 0, LDS_VS = 256 * KV_PITCH, LDS_TAB = 2 * 256 * KV_PITCH;


#define XB_TMO      128
#define XB_XCNT(j)  (256  + 64 * (j))
#define XB_XSUB(j)  (1280 + 64 * (j))
#define XB_XGEN(j)  (2304 + 64 * (j))
#define XB_TOP      3328
#define XB_TOPGEN   3392
#define XCD_BAR_WORDS 3456
#define XB_SPIN_CAP (1u << 18)
DI unsigned xb_ld(unsigned* p)              { return __hip_atomic_load(p, __ATOMIC_RELAXED, __HIP_MEMORY_SCOPE_AGENT); }
DI unsigned xb_add(unsigned* p, unsigned v) { return __hip_atomic_fetch_add(p, v, __ATOMIC_RELAXED, __HIP_MEMORY_SCOPE_AGENT); }
DI unsigned xb_xcc_id() { return (unsigned)__builtin_amdgcn_s_getreg((3 << 11) | 20) & 0xFu; }
#define XB_SPIN(cond, bar) do { unsigned _sp = 0; while (cond) { __builtin_amdgcn_s_sleep(1); \
    if ((++_sp & 255u) == 0u) { if (xb_ld(&(bar)[XB_TMO])) break; if (_sp > XB_SPIN_CAP) { atomicAdd(&(bar)[XB_TMO], 1u); break; } } } } while (0)
struct XcdBarrier { unsigned* bar; unsigned x; volatile LAS unsigned* st; };
DI XcdBarrier xcd_barrier_post(unsigned* bar, volatile LAS unsigned* st) {
    XcdBarrier b; b.bar = bar; b.x = xb_xcc_id(); b.st = st;
    if (threadIdx.x == 0) (void)xb_add(&bar[XB_XCNT(b.x)], 1u);
    return b;
}
DI void xcd_barrier_complete(unsigned* bar, unsigned x, unsigned& nloc, unsigned& nx) {
    const unsigned G = gridDim.x * gridDim.y * gridDim.z;
    unsigned sum, cnt, mine, sp = 0u;
    for (;;) {
        sum = 0u; cnt = 0u; mine = 0u;
#pragma unroll
        for (unsigned j = 0; j < 16; ++j) { const unsigned c = xb_ld(&bar[XB_XCNT(j)]); sum += c; cnt += (c > 0u) ? 1u : 0u; mine = (j == x) ? c : mine; }
        if (sum == G) break;
        __builtin_amdgcn_s_sleep(1);
        if ((++sp & 255u) == 0u) { if (xb_ld(&bar[XB_TMO])) break; if (sp > XB_SPIN_CAP) { atomicAdd(&bar[XB_TMO], 1u); break; } }
    }
    nloc = mine > 0u ? mine : 1u; nx = cnt > 0u ? cnt : 1u;
}
DI void xcd_barrier(const XcdBarrier& b) {
    asm volatile("s_waitcnt vmcnt(0)" ::: "memory");
    __syncthreads();
    if (threadIdx.x == 0) {
        unsigned* bar = b.bar;
        __builtin_amdgcn_s_waitcnt(0);
        unsigned nloc = b.st[0], nx = b.st[1];
        if (nloc == 0u) { xcd_barrier_complete(bar, b.x, nloc, nx); b.st[0] = nloc; b.st[1] = nx; }
        const unsigned old = xb_add(&bar[XB_XSUB(b.x)], 1u);
        const unsigned gen = old / nloc;
        if (old + 1u == (gen + 1u) * nloc) {
            __builtin_amdgcn_fence(__ATOMIC_RELEASE, "agent");
            asm volatile("s_waitcnt vmcnt(0)" ::: "memory");
            const unsigned og = xb_add(&bar[XB_TOP], 1u);
            const unsigned tg = og / nx;
            if (og + 1u == (tg + 1u) * nx) xb_add(&bar[XB_TOPGEN], 1u);
            else XB_SPIN(xb_ld(&bar[XB_TOPGEN]) == tg, bar);
            __builtin_amdgcn_fence(__ATOMIC_ACQUIRE, "agent");
            xb_add(&bar[XB_XGEN(b.x)], 1u);
            asm volatile("s_waitcnt vmcnt(0)" ::: "memory");
        } else {
            XB_SPIN(xb_ld(&bar[XB_XGEN(b.x)]) == gen, bar);
            __builtin_amdgcn_fence(__ATOMIC_ACQUIRE, "agent");
            asm volatile("s_waitcnt vmcnt(0)" ::: "memory");
        }
    }
    __syncthreads();
}

#ifndef PHMASK
#define PHMASK 0xFFFF
#endif
struct Params {
    const float* in[20]; float* out; unsigned char* ws;
};

__global__ void __launch_bounds__(NTHR, 2) fwd_megakernel(Params p) {
    extern __shared__ __attribute__((aligned(16))) unsigned char lds_raw[];
    LAS unsigned char* lds = (LAS unsigned char*)lds_raw;
    cg::grid_group grid = cg::this_grid();
    int tid = threadIdx.x, lane = tid & 63; const int wave = __builtin_amdgcn_readfirstlane(tid >> 6);
#define RELOAD_IDS() do { tid = threadIdx.x; asm volatile("" : "+v"(tid)); lane = tid & 63; } while (0)
    const int G = gridDim.x, bx = blockIdx.x;
    const int vcu = (G % 8 == 0) ? (bx % 8) * (G / 8) + bx / 8 : bx;
    const int gw = vcu * NWAVES + wave, NGW = G * NWAVES;
    unsigned char* ws = p.ws;
    volatile LAS unsigned* xst = (volatile LAS unsigned*)(lds + LDS_BYTES - 16);
    if (threadIdx.x < 4) xst[threadIdx.x] = 0u;
    __syncthreads();
    XcdBarrier xbar; xbar.bar = (unsigned*)(ws + WS_BAR); xbar.x = 0; xbar.st = xst;
    if (blockIdx.x == 0) {
        for (int i = threadIdx.x; i < 512; i += NTHR) ((unsigned*)(ws + WS_CNT))[i] = 0u;
        for (int i = threadIdx.x; i < XCD_BAR_WORDS; i += NTHR) ((unsigned*)(ws + WS_BAR))[i] = 0u;
    }
#define xin (p.in[0])
#define cvec (p.in[1])
#define w_ada (p.in[2])
#define b_ada (p.in[3])
#define nmg (p.in[4])
#define w_in (p.in[5])
#define qng (p.in[6])
#define kng (p.in[7])
#define w_pgrp (p.in[8])
#define pscale (p.in[9])
#define w_abr (p.in[10])
#define w_pbr (p.in[11])
#define w_gate (p.in[12])
#define b_gate (p.in[13])
#define w_o (p.in[14])
#define nfg (p.in[15])
#define w_up (p.in[16])
#define conv_w (p.in[17])
#define conv_b (p.in[18])
#define w_down (p.in[19])
#define outp (p.out)
#define cnt ((unsigned*)(ws + WS_CNT))
#define kmean ((float*)(ws + WS_KMEAN))
#define modp ((float*)(ws + WS_MODP))
#define modf ((float*)(ws + WS_MODF))
#define biasup ((float*)(ws + WS_BIASUP))
#define rowss ((float*)(ws + WS_ROWSS))
#define lsum ((float*)(ws + WS_LSUM))
#define qlist ((unsigned*)(ws + WS_LIST))
#define W1t ((bf16_t*)(ws + WS_W1))
#define Wyt ((bf16_t*)(ws + WS_WY))
#define Wot ((bf16_t*)(ws + WS_WO))
#define Wgt ((bf16_t*)(ws + WS_WG))
#define Wdt ((bf16_t*)(ws + WS_WD))
#define Wut ((bf16_t*)(ws + WS_WU))
#define hbuf ((bf16_t*)(ws + WS_HB))
#define qb ((bf16_t*)(ws + WS_Q))
#define kb ((bf16_t*)(ws + WS_K))
#define vb ((bf16_t*)(ws + WS_V))
#define ub ((bf16_t*)(ws + WS_U))
#define gates ((bf16_t*)(ws + WS_GATES))
#define dbuf ((bf16_t*)(ws + WS_DB))
#define am ((bf16_t*)(ws + WS_AM))
#define merged ((bf16_t*)(ws + WS_MERGED))
#define xg ((bf16_t*)(ws + WS_XG))
#define act ((bf16_t*)(ws + WS_ACT))
#define edge ((float*)(ws + WS_EDGE))
#define slots ((bf16_t*)p.out)
#define rsb ((float*)(ws + WS_LSUM))
#if PHMASK & 1
    {
        LAS float* scr = (LAS float*)(lds + wave * 16640);
        constexpr int I_IN = 32 * 64, I_GT = 32 * 64, I_AB = 16 * 32, I_PB = 16 * 32, I_O = 32 * 32, I_UP = 32 * 176, I_DN = 88 * 32, I_G = 4 * 4;
        constexpr int NIT = I_IN + I_GT + I_AB + I_PB + I_O + I_UP + I_DN + 4 * I_G;
        for (int it = gw; it < NIT; it += NGW) {
            int r = it;
            if (r < I_UP) { transpose_item(w_up, NUP, Wut, 2048, 0, 0, 2, scr, r, lane); continue; } r -= I_UP;
            if (r < I_DN) { transpose_item(w_down, 2048, Wdt, DFF, 0, 0, 0, scr, r, lane); continue; } r -= I_DN;
            if (r < I_IN) { transpose_item(w_in, 4096, W1t, 2048, 0, 0, 0, scr, r, lane); continue; } r -= I_IN;
            if (r < I_GT) { transpose_item(w_gate, 4096, W1t, 2048, 0, 4096, 3, scr, r, lane); continue; } r -= I_GT;
            if (r < I_AB) { transpose_item(w_abr, 2048, Wyt, 2048, 0, 0, 0, scr, r, lane); continue; } r -= I_AB;
            if (r < I_PB) { transpose_item(w_pbr, 2048, Wyt, 2048, 1024, 0, 0, scr, r, lane); continue; } r -= I_PB;
            if (r < I_O) { transpose_item(w_o, 2048, Wot, 2048, 0, 0, 0, scr, r, lane); continue; } r -= I_O;
            { const int gI = r / I_G; transpose_item(w_pgrp + (size_t)gI * 65536, 256, Wgt, 1024, 0, gI * 256, 0, scr, r % I_G, lane); }
        }
        for (int it = gw; it < 768; it += NGW) {
            const int kc = it / 48, cgi = it % 48; const int col = cgi * 256 + lane * 4;
            f32x4 a = (f32x4){0.f, 0.f, 0.f, 0.f};
#pragma unroll 8
            for (int kk = 0; kk < 128; ++kk) { const int kx = kc * 128 + kk; const float cv = cvec[kx]; const float sv = cv * sigmoidf_(cv);
                a += __builtin_nontemporal_load((const f32x4*)(w_ada + (size_t)kx * 12288 + col)) * sv; }
            *(f32x4*)(modp + (size_t)kc * 12288 + col) = a;
        }
    }
    grid.sync();
    xbar = xcd_barrier_post((unsigned*)(ws + WS_BAR), xst);
    RELOAD_IDS();

#endif
#if PHMASK & 2
    {
        LAS float* sh1 = (LAS float*)lds; LAS float* gm1 = sh1 + 2048;
        for (int e = tid; e < 4096; e += NTHR) { float s = b_ada[e];
#pragma unroll
            for (int kc = 0; kc < 16; ++kc) s += modp[(size_t)kc * 12288 + e];
            if (e < 2048) sh1[e] = s; else gm1[e - 2048] = nmg[e - 2048] * (1.0f + s); }
        if (tid < 48) { const int e = bx * 48 + tid; if (e < 12288 && bx < 256) { float s = b_ada[e];
#pragma unroll
            for (int kc = 0; kc < 16; ++kc) s += modp[(size_t)kc * 12288 + e];
            modf[e] = s; } }
        if (G < 256 && bx == 0) { for (int e = G * 48 + tid; e < 12288; e += NTHR) { float s = b_ada[e]; for (int kc = 0; kc < 16; ++kc) s += modp[(size_t)kc * 12288 + e]; modf[e] = s; } }
        __syncthreads();
        for (int m = gw; m < S; m += 2 * NGW) {
            const int m2 = (m + NGW < S) ? m + NGW : m;
            const f32x4* xr0 = (const f32x4*)(xin + (size_t)m * DM) + lane; const f32x4* xr1 = (const f32x4*)(xin + (size_t)m2 * DM) + lane;
            f32x4 v0[8], v1[8]; float s0 = 0.f, s1 = 0.f;
#pragma unroll
            for (int j = 0; j < 8; ++j) { v0[j] = xr0[64 * j]; v1[j] = xr1[64 * j]; }
#pragma unroll
            for (int j = 0; j < 8; ++j) { s0 += (v0[j][0] * v0[j][0] + v0[j][1] * v0[j][1]) + (v0[j][2] * v0[j][2] + v0[j][3] * v0[j][3]);
                s1 += (v1[j][0] * v1[j][0] + v1[j][1] * v1[j][1]) + (v1[j][2] * v1[j][2] + v1[j][3] * v1[j][3]); }
            const float r0 = __builtin_amdgcn_rsqf(wave_sum(s0) * (1.0f / DM) + EPS), r1 = __builtin_amdgcn_rsqf(wave_sum(s1) * (1.0f / DM) + EPS);
            u32x2* o0 = (u32x2*)(hbuf + (size_t)m * DM) + lane; u32x2* o1 = (u32x2*)(hbuf + (size_t)m2 * DM) + lane;
#pragma unroll
            for (int j = 0; j < 8; ++j) { const int c = 4 * lane + 256 * j; const f32x4 gmv = *(const LAS f32x4*)(gm1 + c), shv = *(const LAS f32x4*)(sh1 + c);
                const f32x4 h0 = v0[j] * r0 * gmv + shv, h1 = v1[j] * r1 * gmv + shv;
                u32x2 w0, w1; w0.x = pk2(h0[0], h0[1]); w0.y = pk2(h0[2], h0[3]); w1.x = pk2(h1[0], h1[1]); w1.y = pk2(h1[2], h1[3]); o0[64 * j] = w0; o1[64 * j] = w1; }
        }
    }
    xcd_barrier(xbar);
    RELOAD_IDS();

#endif
#if PHMASK & 4
    {
        pg8::Gemm g{hbuf, W1t, 2048, 2048, 2048}; pg8::Sched<0> Sc; Sc.init(S, N1, G, bx);
        Epi1 E{qb, kb, vb, ub, gates, kmean, qng, kng, b_gate};
        pg8::gemm_phase_drain<Epi1>(lds, g, Sc, E);
    }
    xcd_barrier(xbar);
    RELOAD_IDS();

#endif
#if PHMASK & 8
    {
        LAS unsigned char* kmb = lds;
        LAS unsigned* hist = (LAS unsigned*)(lds + 32768); LAS unsigned* basep = hist + 64;
        for (int base = bx * 8; base < 2048; base += G * 8) {
            const int h = base >> 8;
            __syncthreads();
            { const int jr = tid >> 3, c0 = (tid & 7) * 16; const f32x4* src = (const f32x4*)(kmean + (size_t)h * 8192 + jr * 128 + c0);
              const f32x4 k0 = src[0], k1 = src[1], k2 = src[2], k3 = src[3];
              *(LAS u32x4*)(kmb + jr * KV_PITCH + c0 * 2) = pack8(k0, k1); *(LAS u32x4*)(kmb + jr * KV_PITCH + c0 * 2 + 16) = pack8(k2, k3); }
            if (tid < 64) hist[tid] = 0u;
            __syncthreads();
            const int item = base + wave, qgi = item & 255, own = qgi >> 2, ns = own < 3 ? own : 3;
            const int r32 = lane & 31, hh = lane >> 5;
            int selj[2][3]; unsigned selp[2][3];
#pragma unroll
            for (int sub = 0; sub < 2; ++sub) {
                const int qi = qgi * 64 + sub * 32 + r32;
                const bf16_t* qp = qb + (size_t)qi * 1024 + h * 128 + 8 * hh;
                f32x16 ac[2];
#pragma unroll
                for (int jt = 0; jt < 2; ++jt)
#pragma unroll
                    for (int i = 0; i < 16; ++i) ac[jt][i] = 0.f;
#pragma unroll
                for (int ks = 0; ks < 8; ++ks) { const bf16x8 qf = *(const bf16x8*)(qp + 16 * ks);
#pragma unroll
                    for (int jt = 0; jt < 2; ++jt) { const bf16x8 kf = *(const LAS bf16x8*)(kmb + (32 * jt + r32) * KV_PITCH + 32 * ks + 16 * hh);
                        ac[jt] = __builtin_amdgcn_mfma_f32_32x32x16_bf16(kf, qf, ac[jt], 0, 0, 0); } }
                float b0 = -3.0e38f, b1 = -3.0e38f, b2 = -3.0e38f; int i0 = 255, i1 = 255, i2 = 255;
#pragma unroll
                for (int jt = 0; jt < 2; ++jt)
#pragma unroll
                    for (int i = 0; i < 16; ++i) { const int j = 32 * jt + (i & 3) + 8 * (i >> 2) + 4 * hh; const float vj = (j < own) ? ac[jt][i] : -3.0e38f;
                        if (vj > b0) { b2 = b1; i2 = i1; b1 = b0; i1 = i0; b0 = vj; i0 = j; }
                        else if (vj > b1) { b2 = b1; i2 = i1; b1 = vj; i1 = j; }
                        else if (vj > b2) { b2 = vj; i2 = j; } }
                const float p0 = __shfl_xor(b0, 32), p1 = __shfl_xor(b1, 32), p2 = __shfl_xor(b2, 32);
                const int q0 = __shfl_xor(i0, 32), q1 = __shfl_xor(i1, 32), q2 = __shfl_xor(i2, 32);
#pragma unroll
                for (int t = 0; t < 3; ++t) { const float vj = t == 0 ? p0 : (t == 1 ? p1 : p2); const int j = t == 0 ? q0 : (t == 1 ? q1 : q2);
                    if (vj > b0 || (vj == b0 && j < i0)) { b2 = b1; i2 = i1; b1 = b0; i1 = i0; b0 = vj; i0 = j; }
                    else if (vj > b1 || (vj == b1 && j < i1)) { b2 = b1; i2 = i1; b1 = vj; i1 = j; }
                    else if (vj > b2 || (vj == b2 && j < i2)) { b2 = vj; i2 = j; } }
                selj[sub][0] = i0; selj[sub][1] = i1; selj[sub][2] = i2;
#pragma unroll
                for (int t = 0; t < 3; ++t) selp[sub][t] = (hh == 0 && t < ns) ? __hip_atomic_fetch_add((unsigned*)(hist + selj[sub][t]), 1u, __ATOMIC_RELAXED, __HIP_MEMORY_SCOPE_WORKGROUP) : 0u;
            }
            __syncthreads();
            if (tid < 64) { const unsigned c = hist[tid]; basep[tid] = c ? atomicAdd(cnt + h * 64 + tid, c) : 0u; }
            __syncthreads();
            if (hh == 0) {
#pragma unroll
                for (int sub = 0; sub < 2; ++sub)
#pragma unroll
                    for (int t = 0; t < 3; ++t) if (t < ns) { const int j = selj[sub][t]; const unsigned qi = (unsigned)(qgi * 64 + sub * 32 + r32);
                        qlist[(size_t)(h * 64 + j) * 16384 + basep[j] + selp[sub][t]] = qi * 4u + (unsigned)t; }
            }
        }
        for (int idx = vcu * NTHR + tid; idx < 2048 * 128; idx += G * NTHR) {
            const int cgi = idx & 127, rc = idx >> 7, w = 2 << (cgi >> 5), t0 = rc * 8;
            const bf16_t* __restrict__ up = ub + cgi * 8; bf16_t* __restrict__ dp = dbuf + cgi * 8;
            float sum[8];
#pragma unroll
            for (int i = 0; i < 8; ++i) sum[i] = 0.f;
            for (int i = 1; i <= w; ++i) { const int t = t0 - i; if (t >= 0) { float f[8]; unpack8(*(const u32x4*)(up + (size_t)t * 1024), f);
#pragma unroll
                for (int e = 0; e < 8; ++e) sum[e] += f[e]; } }
#pragma unroll
            for (int t = t0; t < t0 + 8; ++t) {
                float f[8]; unpack8(*(const u32x4*)(up + (size_t)t * 1024), f);
#pragma unroll
                for (int e = 0; e < 8; ++e) sum[e] += f[e];
                if (t - w >= 0) { float o[8]; unpack8(*(const u32x4*)(up + (size_t)(t - w) * 1024), o);
#pragma unroll
                    for (int e = 0; e < 8; ++e) sum[e] -= o[e]; }
                const float inv = 1.0f / (float)((t + 1) < w ? (t + 1) : w);
                u32x4 o4; o4.x = pk2(sum[0] * inv - f[0], sum[1] * inv - f[1]); o4.y = pk2(sum[2] * inv - f[2], sum[3] * inv - f[3]);
                o4.z = pk2(sum[4] * inv - f[4], sum[5] * inv - f[5]); o4.w = pk2(sum[6] * inv - f[6], sum[7] * inv - f[7]);
                *(u32x4*)(dp + (size_t)t * 1024) = o4;
            }
        }
        for (int rho = gw; rho < NUP; rho += NGW) {
            float s = 0.f;
#pragma unroll
            for (int j = 0; j < 4; ++j) { const int k0 = j * 512 + lane * 8; float f[8]; unpack8(*(const u32x4*)(Wut + (size_t)rho * 2048 + k0), f);
                const f32x4 s0 = *(const f32x4*)(modf + 3 * 2048 + k0), s1 = *(const f32x4*)(modf + 3 * 2048 + k0 + 4);
                s += (f[0] * s0[0] + f[1] * s0[1]) + (f[2] * s0[2] + f[3] * s0[3]) + (f[4] * s1[0] + f[5] * s1[1]) + (f[6] * s1[2] + f[7] * s1[3]); }
            s = wave_sum(s);
            if (lane == 0) biasup[rho] = s;
        }
    }
    xcd_barrier(xbar);
    RELOAD_IDS();

#endif
#if PHMASK & 16
    {
        RELOAD_IDS();
        __syncthreads();
        LAS int* pre = (LAS int*)(lds + LDS_TAB); LAS int* tmp = pre + 520;
        { const int n = 1 + (int)((cnt[tid] + 255u) >> 8); tmp[tid] = n; __syncthreads();
          for (int o = 1; o < 512; o <<= 1) { const int v = tmp[tid] + (tid >= o ? tmp[tid - o] : 0); __syncthreads(); tmp[tid] = v; __syncthreads(); }
          pre[tid + 1] = tmp[tid]; if (tid == 0) pre[0] = 0; __syncthreads(); }
        const int total = pre[512];
        int lane_ = lane; asm volatile("" : "+v"(lane_));
        const int r32 = lane_ & 31, hh = lane_ >> 5, i16 = lane_ & 15, qq = i16 >> 2, pp = i16 & 3, blk = (lane_ >> 4) & 1;
#define ATT_DECODE(UN, HJ, LI) do { int lo_ = 0, hi_ = 511; while (lo_ < hi_) { const int mid_ = (lo_ + hi_ + 1) >> 1; if (pre[mid_] <= (UN)) lo_ = mid_; else hi_ = mid_ - 1; } HJ = lo_; LI = (UN) - pre[lo_]; } while (0)
#define ATT_KVLOAD(HJ) do { const int h_ = (HJ) >> 6, j_ = (HJ) & 63; const bf16_t* kg = kb + (size_t)(j_ * 256) * 1024 + h_ * 128; const bf16_t* vg = vb + (size_t)(j_ * 256) * 1024 + h_ * 128; \
        _Pragma("unroll") for (int i = 0; i < 8; ++i) { const int idx = tid + NTHR * i, row = idx >> 4, c16 = idx & 15; \
            kreg[i] = *(const u32x4*)(kg + (size_t)row * 1024 + c16 * 8); vreg[i] = *(const u32x4*)(vg + (size_t)row * 1024 + c16 * 8); } } while (0)
#define ATT_ENT(HJ, LI, ENT, NL) do { NL = ((LI) == 0) ? 256 : (int)cnt[HJ] - ((LI) - 1) * 256; const int e_ = wave * 32 + r32; \
        if ((LI) == 0) ENT = (unsigned)(((HJ) & 63) * 256 + e_) * 4u + 3u; else ENT = qlist[(size_t)(HJ) * 16384 + (size_t)((LI) - 1) * 256 + (e_ < NL ? e_ : 0)]; } while (0)
        u32x4 kreg[8], vreg[8];
        int hj = 0, li = 0, nlist = 0; unsigned ent = 0u;
        if (bx < total) { ATT_DECODE(bx, hj, li); ATT_KVLOAD(hj); ATT_ENT(hj, li, ent, nlist); }
        for (int un = bx; un < total; un += G) {
            const int h = hj >> 6, j = hj & 63;
            const bool ownu = (li == 0);
            const int e = wave * 32 + r32;
            const bool valid = e < nlist;
            const int qi = (int)(ent >> 2), slot = (int)(ent & 3u);
            const bf16_t* qp = qb + (size_t)qi * 1024 + h * 128 + 8 * hh;
            bf16x8 qf[8];
#pragma unroll
            for (int ks = 0; ks < 8; ++ks) qf[ks] = *(const bf16x8*)(qp + 16 * ks);
            __syncthreads();
#pragma unroll
            for (int i = 0; i < 8; ++i) { const int idx = tid + NTHR * i, row = idx >> 4, c16 = idx & 15;
                *(LAS u32x4*)(lds + LDS_KS + row * KV_PITCH + c16 * 16) = kreg[i]; *(LAS u32x4*)(lds + LDS_VS + row * KV_PITCH + c16 * 16) = vreg[i]; }
            __syncthreads();
            int hj2, li2, nlist2; unsigned ent2;
            { const int unn = (un + G < total) ? un + G : un; ATT_DECODE(unn, hj2, li2); ATT_KVLOAD(hj2); ATT_ENT(hj2, li2, ent2, nlist2); }
            if (wave * 32 < nlist) {
                const int nq = ownu ? ((wave * 32 + 31) >> 6) + 1 : 4;
                f32x16 o[4];
#pragma unroll
                for (int dt = 0; dt < 4; ++dt)
#pragma unroll
                    for (int i = 0; i < 16; ++i) o[dt][i] = 0.f;
                float lacc = 0.f;
                const int qloc = e;
#pragma unroll 1
                for (int hf = 0; hf < nq; ++hf) {
                    f32x16 sa[2];
#pragma unroll
                    for (int i = 0; i < 16; ++i) { sa[0][i] = 0.f; sa[1][i] = 0.f; }
                    {
                        const LAS unsigned char* kp0 = lds + LDS_KS + (64 * hf + r32) * KV_PITCH + 16 * hh;
                        const LAS unsigned char* kp1 = kp0 + 32 * KV_PITCH;
                        bf16x8 a0 = *(const LAS bf16x8*)kp0, a1 = *(const LAS bf16x8*)kp1;
#pragma unroll
                        for (int ks = 0; ks < 8; ++ks) {
                            bf16x8 n0 = a0, n1 = a1;
                            if (ks < 7) { n0 = *(const LAS bf16x8*)(kp0 + 32 * (ks + 1)); n1 = *(const LAS bf16x8*)(kp1 + 32 * (ks + 1)); }
                            sa[0] = __builtin_amdgcn_mfma_f32_32x32x16_bf16(a0, qf[ks], sa[0], 0, 0, 0);
                            sa[1] = __builtin_amdgcn_mfma_f32_32x32x16_bf16(a1, qf[ks], sa[1], 0, 0, 0);
                            a0 = n0; a1 = n1;
                        }
                    }
                    if (ownu) {
#pragma unroll
                        for (int kt = 0; kt < 2; ++kt)
#pragma unroll
                            for (int i = 0; i < 16; ++i) { const int key = 64 * hf + 32 * kt + (i & 3) + 8 * (i >> 2) + 4 * hh;
                                float pv = __builtin_amdgcn_exp2f(sa[kt][i]); if (key > qloc) pv = 0.f; sa[kt][i] = pv; lacc += pv; }
                    } else {
#pragma unroll
                        for (int kt = 0; kt < 2; ++kt)
#pragma unroll
                            for (int i = 0; i < 16; ++i) { const float pv = __builtin_amdgcn_exp2f(sa[kt][i]); sa[kt][i] = pv; lacc += pv; }
                    }
                    bf16x8 pb[4];
#pragma unroll
                    for (int st = 0; st < 4; ++st) { const int kt = st >> 1, s2 = st & 1;
                        u32x4 pw; pw.x = pk2(sa[kt][8 * s2 + 0], sa[kt][8 * s2 + 1]); pw.y = pk2(sa[kt][8 * s2 + 2], sa[kt][8 * s2 + 3]);
                        pw.z = pk2(sa[kt][8 * s2 + 4], sa[kt][8 * s2 + 5]); pw.w = pk2(sa[kt][8 * s2 + 6], sa[kt][8 * s2 + 7]);
                        pb[st] = __builtin_bit_cast(bf16x8, pw); }
                    const LAS unsigned char* vp = lds + LDS_VS + (64 * hf + 4 * hh + qq) * KV_PITCH + 32 * blk + 8 * pp;
                    s16x4 cl[4], ch[4];
#pragma unroll
                    for (int dt = 0; dt < 4; ++dt) { cl[dt] = vtr(vp + 64 * dt); ch[dt] = vtr(vp + 8 * KV_PITCH + 64 * dt); }
#pragma unroll
                    for (int st = 0; st < 4; ++st) {
                        s16x4 nl[4], nh[4];
#pragma unroll
                        for (int dt = 0; dt < 4; ++dt) { nl[dt] = cl[dt]; nh[dt] = ch[dt]; }
                        if (st < 3) { const LAS unsigned char* vn = vp + 16 * (st + 1) * KV_PITCH;
#pragma unroll
                            for (int dt = 0; dt < 4; ++dt) { nl[dt] = vtr(vn + 64 * dt); nh[dt] = vtr(vn + 8 * KV_PITCH + 64 * dt); } }
#pragma unroll
                        for (int dt = 0; dt < 4; ++dt) { const bf16x8 vf = __builtin_shufflevector(cl[dt], ch[dt], 0, 1, 2, 3, 4, 5, 6, 7);
                            o[dt] = __builtin_amdgcn_mfma_f32_32x32x16_bf16(vf, pb[st], o[dt], 0, 0, 0); }
#pragma unroll
                        for (int dt = 0; dt < 4; ++dt) { cl[dt] = nl[dt]; ch[dt] = nh[dt]; }
                    }
                }
                lacc += __shfl_xor(lacc, 32);
                u32x4 ow[8];
#pragma unroll
                for (int dt = 0; dt < 4; ++dt)
#pragma unroll
                    for (int gp2 = 0; gp2 < 2; ++gp2) { const int g0 = 2 * gp2, g1 = g0 + 1;
                        unsigned ax = pk2(o[dt][4 * g0], o[dt][4 * g0 + 1]), ay = pk2(o[dt][4 * g0 + 2], o[dt][4 * g0 + 3]);
                        unsigned bxw = pk2(o[dt][4 * g1], o[dt][4 * g1 + 1]), by = pk2(o[dt][4 * g1 + 2], o[dt][4 * g1 + 3]);
                        { const auto rsw = __builtin_amdgcn_permlane32_swap(ax, bxw, false, false); ax = rsw[0]; bxw = rsw[1]; }
                        { const auto rsw = __builtin_amdgcn_permlane32_swap(ay, by, false, false); ay = rsw[0]; by = rsw[1]; }
                        ow[dt * 2 + gp2] = (u32x4){ax, ay, bxw, by}; }
                if (valid) {
                    bf16_t* op = slots + ((size_t)qi * 4 + slot) * 1024 + h * 128 + 8 * hh;
#pragma unroll
                    for (int dt = 0; dt < 4; ++dt)
#pragma unroll
                        for (int gp2 = 0; gp2 < 2; ++gp2) *(u32x4*)(op + 32 * dt + 16 * gp2) = ow[dt * 2 + gp2];
                    if (hh == 0) lsum[((size_t)qi * 4 + slot) * 8 + h] = lacc;
                }
            }
            hj = hj2; li = li2; ent = ent2; nlist = nlist2;
        }
        RELOAD_IDS();
        for (int base = vcu * 8; base < 2048; base += G * 8) {
            const int gI = base >> 9;
            __syncthreads();
#pragma unroll
            for (int i = 0; i < 16; ++i) { const int idx = tid + NTHR * i, row = idx >> 5, c16 = idx & 31;
                *(LAS u32x4*)(lds + row * 528 + c16 * 16) = *(const u32x4*)(Wgt + (size_t)(gI * 256 + row) * 1024 + c16 * 8); }
            __syncthreads();
            const int item = base + wave, s0 = (item & 511) * 32, r = lane & 31, hh = lane >> 5;
            bf16x8 af[16];
            const bf16_t* ap = dbuf + (size_t)(s0 + r) * 1024 + gI * 256 + 8 * hh;
#pragma unroll
            for (int ks = 0; ks < 16; ++ks) af[ks] = *(const bf16x8*)(ap + 16 * ks);
#pragma unroll 1
            for (int nt = 0; nt < 8; nt += 2) {
                f32x16 ac[2];
#pragma unroll
                for (int i = 0; i < 16; ++i) { ac[0][i] = 0.f; ac[1][i] = 0.f; }
                const LAS unsigned char* bp = lds + (nt * 32 + r) * 528 + 16 * hh;
#pragma unroll
                for (int ks = 0; ks < 16; ++ks) { const bf16x8 b0 = *(const LAS bf16x8*)(bp + 32 * ks), b1 = *(const LAS bf16x8*)(bp + 32 * 528 + 32 * ks);
                    ac[0] = __builtin_amdgcn_mfma_f32_32x32x16_bf16(b0, af[ks], ac[0], 0, 0, 0); ac[1] = __builtin_amdgcn_mfma_f32_32x32x16_bf16(b1, af[ks], ac[1], 0, 0, 0); }
                f32x4 lsv[2][4];
#pragma unroll
                for (int t2 = 0; t2 < 2; ++t2)
#pragma unroll
                    for (int q4 = 0; q4 < 4; ++q4) lsv[t2][q4] = *(const f32x4*)(pscale + gI * 256 + (nt + t2) * 32 + 8 * q4 + 4 * hh);
#pragma unroll
                for (int t2 = 0; t2 < 2; ++t2) {
                    bf16_t* op = am + (size_t)(s0 + r) * 2048 + 1024 + gI * 256 + (nt + t2) * 32 + 4 * hh;
#pragma unroll
                    for (int q4 = 0; q4 < 4; ++q4) { const f32x4 lv = lsv[t2][q4];
                        u32x2 w; w.x = pk2(ac[t2][4 * q4] * lv[0], ac[t2][4 * q4 + 1] * lv[1]); w.y = pk2(ac[t2][4 * q4 + 2] * lv[2], ac[t2][4 * q4 + 3] * lv[3]); *(u32x2*)(op + 8 * q4) = w; }
                }
            }
        }
    }
    xcd_barrier(xbar);
    RELOAD_IDS();

#endif
#if PHMASK & 32
    {
    }
    RELOAD_IDS();
#pragma unroll 2
    for (int idx = vcu * NTHR + tid; idx < S * 128; idx += G * NTHR) {
        const int qi = idx >> 7, c8 = idx & 127, h = c8 >> 4, own = qi >> 8, ns = own < 3 ? own : 3;
        float a[8]; float l = 0.f;
#pragma unroll
        for (int i = 0; i < 8; ++i) a[i] = 0.f;
#pragma unroll
        for (int s = 0; s < 4; ++s) if (s == 3 || s < ns) { float f[8]; unpack8(*(const u32x4*)(slots + ((size_t)qi * 4 + s) * 1024 + c8 * 8), f);
#pragma unroll
            for (int i = 0; i < 8; ++i) a[i] += f[i];
            l += lsum[((size_t)qi * 4 + s) * 8 + h]; }
        const float inv = 1.0f / l;
        u32x4 w; w.x = pk2(a[0] * inv, a[1] * inv); w.y = pk2(a[2] * inv, a[3] * inv); w.z = pk2(a[4] * inv, a[5] * inv); w.w = pk2(a[6] * inv, a[7] * inv);
        *(u32x4*)(am + (size_t)qi * 2048 + c8 * 8) = w;
    }
    xcd_barrier(xbar);
    RELOAD_IDS();

#endif
#if PHMASK & 64
    { pg8::Gemm g{am, Wyt, 2048, 2048, 1024}; pg8::Sched<1> Sc; Sc.init(S, 2048, G, bx); Epi5 E{gates, merged}; pg8::gemm_phase<Epi5>(lds, g, Sc, E); }
    xcd_barrier(xbar);
    RELOAD_IDS();

#endif
#if PHMASK & 128
    { pg8::Gemm g{merged, Wot, 2048, 2048, 2048}; pg8::Sched<0> Sc; Sc.init(S, 2048, G, bx); Epi6 E{xin, outp, xg, modf, nfg, rowss}; pg8::gemm_phase<Epi6>(lds, g, Sc, E); }
    xcd_barrier(xbar);
    RELOAD_IDS();

#endif
#if PHMASK & 256
    for (int row = vcu * NTHR + tid; row < S; row += G * NTHR) { const f32x4* pr = (const f32x4*)(rowss + (size_t)row * 32); f32x4 sm = pr[0];
#pragma unroll
        for (int j = 1; j < 8; ++j) sm += pr[j];
        rsb[row] = __builtin_amdgcn_rsqf(((sm[0] + sm[1]) + (sm[2] + sm[3])) * (1.0f / 2048.0f) + EPS); }
    xcd_barrier(xbar);
    RELOAD_IDS();
    { pg8::Gemm g{xg, Wut, 2048, 2048, 2048}; pg8::Sched<0> Sc; Sc.init(S, NUP, G, bx); Epi7 E{rsb, biasup, conv_w, conv_b, act, edge}; pg8::gemm_phase_drain<Epi7>(lds, g, Sc, E); }
    xcd_barrier(xbar);
    RELOAD_IDS();

#endif
#if PHMASK & 512
    {
        pg8::Sched<0> Sf; Sf.init(S, 2048, G, bx);
        int lastpm = -1;
        for (int ui = 0;; ++ui) {
            Unit uf; if (!Sf.next(ui, uf)) break;
            const int tl = uf.pm; if (tl == lastpm) continue; lastpm = tl;
            for (int idx = tid; idx < DFF / 4; idx += NTHR) {
                const int c = idx * 4;
                f32x4 r0[2], r1[2];
#pragma unroll
                for (int bj = 0; bj < 2; ++bj) {
                    const int lc = bj * DFF + c;
                    const f32x4 z = (f32x4){0.f, 0.f, 0.f, 0.f};
                    const f32x4 pm2 = tl > 0 ? *(const f32x4*)(edge + ((size_t)((tl - 1) * 4 + 2)) * NUP + lc) : z;
                    const f32x4 pm1 = tl > 0 ? *(const f32x4*)(edge + ((size_t)((tl - 1) * 4 + 3)) * NUP + lc) : z;
                    const f32x4 e0 = *(const f32x4*)(edge + ((size_t)(tl * 4 + 0)) * NUP + lc), e1 = *(const f32x4*)(edge + ((size_t)(tl * 4 + 1)) * NUP + lc);
                    const f32x4 w0 = *(const f32x4*)(conv_w + lc), w1 = *(const f32x4*)(conv_w + NUP + lc), w2 = *(const f32x4*)(conv_w + 2 * NUP + lc), cbv = *(const f32x4*)(conv_b + lc);
                    r0[bj] = cbv + w0 * pm2 + w1 * pm1 + w2 * e0;
                    r1[bj] = cbv + w0 * pm1 + w1 * e0 + w2 * e1;
                }
                u32x2 o0, o1; float t0[4], t1[4];
#pragma unroll
                for (int i = 0; i < 4; ++i) { t0[i] = r0[0][i] * sigmoidf_(r0[0][i]) * r0[1][i]; t1[i] = r1[0][i] * sigmoidf_(r1[0][i]) * r1[1][i]; }
                o0.x = pk2(t0[0], t0[1]); o0.y = pk2(t0[2], t0[3]); o1.x = pk2(t1[0], t1[1]); o1.y = pk2(t1[2], t1[3]);
                *(u32x2*)(act + (size_t)(tl * 256) * DFF + c) = o0; *(u32x2*)(act + (size_t)(tl * 256 + 1) * DFF + c) = o1;
            }
        }
        asm volatile("s_waitcnt vmcnt(0)" ::: "memory");
        __syncthreads();
        RELOAD_IDS();
    }
    { pg8::Gemm g{act, Wdt, DFF, DFF, DFF}; pg8::Sched<0> Sc; Sc.init(S, 2048, G, bx); Epi9 E{outp, modf}; pg8::gemm_phase<Epi9>(lds, g, Sc, E); }
#endif
}

extern "C" void kernel_launch(void* const* d_in, const int* in_sizes, int n_in, void* d_out, int out_size, void* d_ws, size_t ws_size, hipStream_t stream) {
    static int grid_blocks = 0;
    if (grid_blocks == 0) {
        if (n_in != 20 || out_size != S * DM || ws_size < WS_END) { fprintf(stderr, "kernel_launch: unexpected shapes (n_in %d out %d ws %zu)\n", n_in, out_size, ws_size); grid_blocks = -1; return; }
        int dev = 0, cus = 0, per_cu = 0;
        hipGetDevice(&dev);
        hipDeviceGetAttribute(&cus, hipDeviceAttributeMultiprocessorCount, dev);
        hipFuncSetAttribute((const void*)fwd_megakernel, hipFuncAttributeMaxDynamicSharedMemorySize, LDS_BYTES);
        hipOccupancyMaxActiveBlocksPerMultiprocessor(&per_cu, (const void*)fwd_megakernel, NTHR, LDS_BYTES);
        if (per_cu < 1) { fprintf(stderr, "kernel_launch: occupancy query reports %d blocks per CU\n", per_cu); grid_blocks = -1; return; }
        if (per_cu > 1) per_cu = 1;
        grid_blocks = cus * per_cu;
        if (grid_blocks > 256) grid_blocks = 256;
    }
    if (grid_blocks < 0) return;
    Params p{};
    for (int i = 0; i < 20; ++i) p.in[i] = (const float*)d_in[i];
    p.out = (float*)d_out; p.ws = (unsigned char*)d_ws;
    void* args[] = {&p};
    hipError_t e = hipLaunchCooperativeKernel((const void*)fwd_megakernel, dim3(grid_blocks), dim3(NTHR), args, LDS_BYTES, stream);
    if (e != hipSuccess) fprintf(stderr, "cooperative launch failed: %s (grid %d)\n", hipGetErrorString(e), grid_blocks);
}
```

```cpp
#include <hip/hip_runtime.h>
#include <hip/hip_cooperative_groups.h>
#include <cstdio>
#include <cstdint>
namespace cg = cooperative_groups;

#define LAS __attribute__((address_space(3)))
#define DI __device__ __forceinline__
typedef unsigned short bf16_t;
typedef short bf16x8 __attribute__((ext_vector_type(8)));
typedef short s16x4 __attribute__((ext_vector_type(4)));
typedef float f32x2 __attribute__((ext_vector_type(2)));
typedef float f32x4 __attribute__((ext_vector_type(4)));
typedef float f32x16 __attribute__((ext_vector_type(16)));
typedef unsigned u32x2 __attribute__((ext_vector_type(2)));
typedef unsigned u32x4 __attribute__((ext_vector_type(4)));
typedef __bf16 bf16x2_t __attribute__((ext_vector_type(2)));

constexpr int S = 16384, DM = 2048, NH = 8, HD = 128, AW = 1024, PW = 1024, DFF = 5632, NUP = 2 * DFF, N1 = 8192;
constexpr float EPS = 1e-6f;
constexpr int NWAVES = 8, NTHR = 512;
constexpr int LDS_BYTES = 147456;
constexpr int XL_OFF = 131072;

constexpr size_t MiB = 1u << 20;
constexpr size_t WS_ZERO = 0, ZERO_BYTES = 1 * MiB;
constexpr size_t WS_CNT = 0, WS_KMEAN = 65536, WS_BAR = 524288;
constexpr size_t WS_MODP = 1 * MiB;
constexpr size_t WS_MODF = 2 * MiB;
constexpr size_t WS_BIASUP = 2 * MiB + 65536;
constexpr size_t WS_ROWSS = 3 * MiB;
constexpr size_t WS_LSUM = 5 * MiB;
constexpr size_t WS_LIST = 8 * MiB;
constexpr size_t WS_W1 = 40 * MiB;
constexpr size_t WS_WY = 72 * MiB;
constexpr size_t WS_WO = 80 * MiB;
constexpr size_t WS_WG = 88 * MiB;
constexpr size_t WS_WD = 90 * MiB;
constexpr size_t WS_WU = 112 * MiB;
constexpr size_t WS_HB = 156 * MiB;
constexpr size_t WS_Q = 220 * MiB, WS_K = 252 * MiB, WS_V = 284 * MiB, WS_U = 316 * MiB;
constexpr size_t WS_GATES = 348 * MiB;
constexpr size_t WS_DB = 476 * MiB;
constexpr size_t WS_AM = WS_HB;
constexpr size_t WS_MERGED = 284 * MiB;
constexpr size_t WS_XG = WS_HB;
constexpr size_t WS_ACT = 220 * MiB;
constexpr size_t WS_EDGE = 400 * MiB;
constexpr size_t WS_END = 508 * MiB;

__constant__ double ROPE_C[64] = {
1.59154943091895346e-01, 1.37822502603982849e-01, 1.19349370211248862e-01, 1.03352296618434064e-01,
8.94994016088910133e-02, 7.75032887553740585e-02, 6.71150830052272551e-02, 5.81192674418762462e-02,
5.03292121044870353e-02, 4.35833021053073297e-02, 3.77415847174197711e-02, 3.26828658723569976e-02,
2.83022014470915797e-02, 2.45087088680224316e-02, 2.12236869570126724e-02, 1.83789788427912383e-02,
1.59154943091895346e-02, 1.37822502603982859e-02, 1.19349370211248869e-02, 1.03352296618434061e-02,
8.94994016088910168e-03, 7.75032887553740620e-03, 6.71150830052272551e-03, 5.81192674418762497e-03,
5.03292121044870353e-03, 4.35833021053073314e-03, 3.77415847174197694e-03, 3.26828658723569993e-03,
2.83022014470915797e-03, 2.45087088680224316e-03, 2.12236869570126715e-03, 1.83789788427912387e-03,
1.59154943091895346e-03, 1.37822502603982855e-03, 1.19349370211248860e-03, 1.03352296618434065e-03,
8.94994016088910125e-04, 7.75032887553740577e-04, 6.71150830052272594e-04, 5.81192674418762454e-04,
5.03292121044870353e-04, 4.35833021053073336e-04, 3.77415847174197716e-04, 3.26828658723569971e-04,
2.83022014470915775e-04, 2.45087088680224327e-04, 2.12236869570126726e-04, 1.83789788427912376e-04,
1.59154943091895335e-04, 1.37822502603982850e-04, 1.19349370211248865e-04, 1.03352296618434062e-04,
8.94994016088910179e-05, 7.75032887553740523e-05, 6.71150830052272540e-05, 5.81192674418762481e-05,
5.03292121044870380e-05, 4.35833021053073309e-05, 3.77415847174197689e-05, 3.26828658723569984e-05,
2.83022014470915789e-05, 2.45087088680224307e-05, 2.12236869570126719e-05, 1.83789788427912390e-05 };

DI unsigned pk2(float lo, float hi) { f32x2 v = {lo, hi}; bf16x2_t b = __builtin_convertvector(v, bf16x2_t); return __builtin_bit_cast(unsigned, b); }
DI float bflo(unsigned w) { return __uint_as_float(w << 16); }
DI float bfhi(unsigned w) { return __uint_as_float(w & 0xffff0000u); }
DI void unpack8(const u32x4 w, float* f) { f[0] = bflo(w.x); f[1] = bfhi(w.x); f[2] = bflo(w.y); f[3] = bfhi(w.y); f[4] = bflo(w.z); f[5] = bfhi(w.z); f[6] = bflo(w.w); f[7] = bfhi(w.w); }
DI u32x4 pack8(const f32x4 a, const f32x4 b) { u32x4 w; w.x = pk2(a[0], a[1]); w.y = pk2(a[2], a[3]); w.z = pk2(b[0], b[1]); w.w = pk2(b[2], b[3]); return w; }
DI float wave_sum(float v) {
#pragma unroll
    for (int o = 1; o < 64; o <<= 1) v += __shfl_xor(v, o);
    return v;
}
DI float sigmoidf_(float x) { return __builtin_amdgcn_rcpf(1.0f + __builtin_amdgcn_exp2f(x * -1.4426950408889634f)); }
#define LDS_WAIT() asm volatile("s_waitcnt lgkmcnt(0)" ::: "memory")
#define FENCE() do { asm volatile("" ::: "memory"); __builtin_amdgcn_sched_barrier(0); } while (0)
#define TIE(var, dep) asm volatile("" : "+v"(var) : "v"(dep))
#define RAW_BAR() do { asm volatile("s_waitcnt lgkmcnt(0)" ::: "memory"); __builtin_amdgcn_s_barrier(); asm volatile("" ::: "memory"); } while (0)

#ifndef PG8_USE_SP2
#define PG8_USE_SP2 1
#endif
namespace pg8 {
constexpr int BM = 256, BK = 64, HALF = 128, HTB = HALF * BK * 2, STAGE_BYTES = 8 * HTB, NXCD = 8, WGM = 8;
__host__ __device__ __forceinline__ int lds_byte(int r, int c) { const int st = (r >> 4) * 2 + (c >> 5), rr = r & 15, cc = c & 31, ob = rr * 64 + cc * 2; return st * 1024 + (ob ^ (((ob >> 9) & 1) << 5)); }
__host__ __device__ __forceinline__ void stage_rc(int b, int& R, int& C) { const int st = b / 1024, sb = b % 1024, swz = sb ^ (((sb >> 9) & 1) << 5); R = (st >> 1) * 16 + swz / 64; C = (st & 1) * 32 + (swz % 64) / 2; }
__host__ __device__ __forceinline__ int perm32(int rho) { const int n = rho >> 4, i = rho & 15; return 8 * (i >> 2) + 4 * n + (i & 3); }

struct Unit { int pm, pn, ka, kb, aux; };
struct Gemm { const bf16_t* A; const bf16_t* Bt; int lda, ldb, K; };

template <int mode> struct Sched {
    int nM, nN, nwg, G, c;
    __device__ void init(int M, int N, int G_, int c_) { nM = M / BM; nN = N / BM; nwg = nM * nN; G = G_; c = c_; }
    __device__ bool next(int i, Unit& u) const {
        const int ii = (mode == 1) ? (i >> 1) : i;
        const long L = (long)ii * G + c; if (L >= nwg) return false;
        int wgid = (int)L; { const int q = nwg / NXCD, r = nwg % NXCD, xcd = wgid % NXCD, off = wgid / NXCD; wgid = (xcd < r ? xcd * (q + 1) : r * (q + 1) + (xcd - r) * q) + off; }
        const int nig = WGM * nN, gid = wgid / nig, fm = gid * WGM, gsz = (nM - fm) < WGM ? (nM - fm) : WGM;
        u.pm = fm + ((wgid % nig) % gsz); u.pn = (wgid % nig) / gsz;
        u.aux = (mode == 1) ? (i & 1) : 0; u.ka = (mode == 1) ? 1024 * (i & 1) : ((mode == 2) ? 256 * u.pn : 0); u.kb = (mode == 1) ? 1024 * (i & 1) : 0;
        return true;
    }
};

template <class Epi, class SchedT>
DI void gemm_phase(LAS unsigned char* lds, const Gemm g, const SchedT& S, const Epi& E) {
    int tid_ = threadIdx.x; asm volatile("" : "+v"(tid_));
    const int tid = tid_, wid = __builtin_amdgcn_readfirstlane(tid >> 6), lane = tid & 63, wr = wid >> 2, wc = wid & 3, fr = lane & 15, fq = lane >> 4;
    const int nt = g.K / BK;
    unsigned voffA, voffB;
    { int R, C; stage_rc(tid * 16, R, C); const int Rb = (R & ~31) + perm32(R & 31);
      voffA = (unsigned)(R * g.lda + C) * 2u; voffB = (unsigned)(Rb * g.ldb + C) * 2u; }
    const size_t dvoffA = (size_t)64 * g.lda * 2, dvoffB = (size_t)64 * g.ldb * 2;
    const size_t kstep = (size_t)(BK * 2);
    const size_t hstepA = (size_t)HALF * g.lda * 2, hstepB = (size_t)HALF * g.ldb * 2;
    const size_t tstepA = 2 * hstepA, tstepB = 2 * hstepB;
    const unsigned ldsw = (unsigned)wid * 1024u;
    const int aoff = lds_byte(wr * 64 + fr, fq * 8), boff = lds_byte(wc * 32 + fr, fq * 8);
#define PG8_SA(b, h) (((b) * 2 + (h)) * HTB)
#define PG8_SB(b, h) ((4 + (b) * 2 + (h)) * HTB)
#define PG8_STAGE(bufoff, gbase, voff) do { _Pragma("unroll") for (int _i = 0; _i < 2; ++_i) \
        __builtin_amdgcn_global_load_lds((const unsigned*)((const char*)(gbase) + (size_t)_i * d##voff + (voff)), (LAS unsigned*)(lds + (bufoff) + ldsw + _i * 8192), 16, 0, 0); } while (0)
#define PG8_LDA(dst, b, h) do { _Pragma("unroll") for (int m = 0; m < 4; ++m) _Pragma("unroll") for (int k = 0; k < 2; ++k) dst[m][k] = *(const LAS bf16x8*)(lds + PG8_SA(b, h) + aoff + m * 2048 + k * 1024); } while (0)
#define PG8_LDB(dst, b, h) do { _Pragma("unroll") for (int n = 0; n < 2; ++n) _Pragma("unroll") for (int k = 0; k < 2; ++k) dst[n][k] = *(const LAS bf16x8*)(lds + PG8_SB(b, h) + boff + n * 2048 + k * 1024); } while (0)
#define PG8_MMA(ai, bj, At, Bt) do { __builtin_amdgcn_s_setprio(1); _Pragma("unroll") for (int m = 0; m < 4; ++m) _Pragma("unroll") for (int n = 0; n < 2; ++n) _Pragma("unroll") for (int k = 0; k < 2; ++k) \
        acc[ai][bj][m][n] = __builtin_amdgcn_mfma_f32_16x16x32_bf16(Bt[n][k], At[m][k], acc[ai][bj][m][n], 0, 0, 0); __builtin_amdgcn_s_setprio(0); } while (0)
#define PG8_WAIT_V(n) asm volatile("s_waitcnt vmcnt(" #n ")" ::: "memory")
#define PG8_WAIT_L(n) asm volatile("s_waitcnt lgkmcnt(" #n ")" ::: "memory")
#define PG8_BAR __builtin_amdgcn_s_barrier()
#define PG8_SCHED __builtin_amdgcn_sched_barrier(0)
    Unit cur, nxt; int ui = 0;
    if (!S.next(0, cur)) return;
    f32x4 acc[2][2][4][2];
#pragma unroll
    for (int a = 0; a < 2; ++a)
#pragma unroll
        for (int b = 0; b < 2; ++b)
#pragma unroll
            for (int m = 0; m < 4; ++m)
#pragma unroll
                for (int n = 0; n < 2; ++n) acc[a][b][m][n] = (f32x4){0.f, 0.f, 0.f, 0.f};
    bf16x8 At[4][2], B0[2][2], B1[2][2];
    const char* cA = (const char*)g.A + (size_t)cur.pm * tstepA + (size_t)cur.ka * 2; const char* cB = (const char*)g.Bt + (size_t)cur.pn * tstepB + (size_t)cur.kb * 2;
#if PG8_USE_SP2
    PG8_STAGE(PG8_SB(0, 0), cB, voffB); PG8_STAGE(PG8_SB(0, 1), cB + hstepB, voffB); PG8_STAGE(PG8_SA(0, 0), cA, voffA); PG8_STAGE(PG8_SA(0, 1), cA + hstepA, voffA);
    if (wr == 1) PG8_BAR;
    PG8_WAIT_V(2); PG8_BAR;
#else
    PG8_STAGE(PG8_SB(0, 0), cB, voffB); PG8_STAGE(PG8_SA(0, 0), cA, voffA); PG8_STAGE(PG8_SB(0, 1), cB + hstepB, voffB); PG8_STAGE(PG8_SA(0, 1), cA + hstepA, voffA);
    if (wr == 1) PG8_BAR;
    PG8_WAIT_V(4); PG8_BAR;
#endif
    PG8_STAGE(PG8_SB(1, 0), cB + kstep, voffB); PG8_STAGE(PG8_SA(1, 0), cA + kstep, voffA); PG8_STAGE(PG8_SB(1, 1), cB + hstepB + kstep, voffB);
    PG8_WAIT_V(6); PG8_BAR;
    for (;;) {
        const bool has_next = S.next(ui + 1, nxt);
        const char* nA = has_next ? (const char*)g.A + (size_t)nxt.pm * tstepA + (size_t)nxt.ka * 2 : cA; const char* nB = has_next ? (const char*)g.Bt + (size_t)nxt.pn * tstepB + (size_t)nxt.kb * 2 : cB;
        for (int t = 0; t < nt; t += 2) {
            const bool last = (t == nt - 2);
            const char* a1 = cA + (size_t)(t + 1) * kstep;
            const char* a2 = last ? nA : cA + (size_t)(t + 2) * kstep; const char* b2 = last ? nB : cB + (size_t)(t + 2) * kstep;
            const char* a3 = a2 + kstep; const char* b3 = b2 + kstep;
#if PG8_USE_SP2
            PG8_LDB(B0, 0, 0); PG8_LDB(B1, 0, 1); PG8_SCHED; PG8_LDA(At, 0, 0); PG8_STAGE(PG8_SA(1, 1), a1 + hstepA, voffA);
            PG8_WAIT_V(8); PG8_WAIT_L(0); PG8_BAR; PG8_MMA(0, 0, At, B0); PG8_MMA(0, 1, At, B1); PG8_BAR; PG8_SCHED;
            PG8_LDA(At, 0, 1); PG8_STAGE(PG8_SB(0, 0), b2, voffB); PG8_STAGE(PG8_SB(0, 1), b2 + hstepB, voffB); PG8_STAGE(PG8_SA(0, 0), a2, voffA);
            PG8_WAIT_V(8); PG8_WAIT_L(0); PG8_BAR; PG8_MMA(1, 0, At, B0); PG8_MMA(1, 1, At, B1); PG8_BAR; PG8_SCHED;
            PG8_LDB(B0, 1, 0); PG8_LDB(B1, 1, 1); PG8_SCHED; PG8_LDA(At, 1, 0); PG8_STAGE(PG8_SA(0, 1), a2 + hstepA, voffA);
            PG8_WAIT_V(8); PG8_WAIT_L(0); PG8_BAR; PG8_MMA(0, 0, At, B0); PG8_MMA(0, 1, At, B1); PG8_BAR; PG8_SCHED;
            PG8_LDA(At, 1, 1); PG8_STAGE(PG8_SB(1, 0), b3, voffB); PG8_STAGE(PG8_SB(1, 1), b3 + hstepB, voffB); PG8_STAGE(PG8_SA(1, 0), a3, voffA);
            PG8_WAIT_V(8); PG8_WAIT_L(0); PG8_BAR; PG8_MMA(1, 0, At, B0); PG8_MMA(1, 1, At, B1); PG8_BAR; PG8_SCHED;
#else
            PG8_LDB(B0, 0, 0); PG8_SCHED; PG8_LDA(At, 0, 0); PG8_STAGE(PG8_SA(1, 1), a1 + hstepA, voffA);
            PG8_WAIT_L(8); PG8_BAR; PG8_WAIT_L(0); PG8_MMA(0, 0, At, B0); PG8_BAR; PG8_SCHED;
            PG8_LDB(B1, 0, 1); PG8_STAGE(PG8_SB(0, 0), b2, voffB);
            PG8_BAR; PG8_WAIT_L(0); PG8_MMA(0, 1, At, B1); PG8_BAR;
            PG8_LDA(At, 0, 1); PG8_STAGE(PG8_SA(0, 0), a2, voffA);
            PG8_BAR; PG8_WAIT_L(0); PG8_MMA(1, 0, At, B0); PG8_BAR; PG8_SCHED;
            PG8_STAGE(PG8_SB(0, 1), b2 + hstepB, voffB);
            PG8_WAIT_V(6); PG8_BAR; PG8_MMA(1, 1, At, B1); PG8_BAR;
            PG8_LDB(B0, 1, 0); PG8_SCHED; PG8_LDA(At, 1, 0); PG8_STAGE(PG8_SA(0, 1), a2 + hstepA, voffA);
            PG8_WAIT_L(8); PG8_BAR; PG8_WAIT_L(0); PG8_MMA(0, 0, At, B0); PG8_BAR; PG8_SCHED;
            PG8_LDB(B1, 1, 1); PG8_STAGE(PG8_SB(1, 0), b3, voffB);
            PG8_BAR; PG8_WAIT_L(0); PG8_MMA(0, 1, At, B1); PG8_BAR;
            PG8_LDA(At, 1, 1); PG8_STAGE(PG8_SA(1, 0), a3, voffA);
            PG8_BAR; PG8_WAIT_L(0); PG8_MMA(1, 0, At, B0); PG8_BAR; PG8_SCHED;
            PG8_STAGE(PG8_SB(1, 1), b3 + hstepB, voffB);
            PG8_WAIT_V(6); PG8_BAR; PG8_MMA(1, 1, At, B1); PG8_BAR;
#endif
        }
        if (wr == 0) PG8_BAR;
        { int l2 = threadIdx.x; asm volatile("" : "+v"(l2)); l2 &= 63;
          E(acc, cur, wr, wc, l2 & 15, l2 >> 4, lds + XL_OFF); }
        if (!has_next) break;
        if (!(Epi::CHAIN && cur.aux == 0)) {
#pragma unroll
            for (int a = 0; a < 2; ++a)
#pragma unroll
                for (int b = 0; b < 2; ++b)
#pragma unroll
                    for (int m = 0; m < 4; ++m)
#pragma unroll
                        for (int n = 0; n < 2; ++n) acc[a][b][m][n] = (f32x4){0.f, 0.f, 0.f, 0.f};
        }
        cur = nxt; cA = nA; cB = nB; ++ui;
        if (wr == 1) PG8_BAR;
    }
    PG8_WAIT_V(0);
    PG8_BAR;
}

template <class Epi, class SchedT>
DI void gemm_phase_drain(LAS unsigned char* lds, const Gemm g, const SchedT& S, const Epi& E) {
    int tid_ = threadIdx.x; asm volatile("" : "+v"(tid_));
    const int tid = tid_, wid = __builtin_amdgcn_readfirstlane(tid >> 6), lane = tid & 63, wr = wid >> 2, wc = wid & 3, fr = lane & 15, fq = lane >> 4;
    const int nt = g.K / BK;
    unsigned voffA, voffB;
    { int R, C; stage_rc(tid * 16, R, C); const int Rb = (R & ~31) + perm32(R & 31);
      voffA = (unsigned)(R * g.lda + C) * 2u; voffB = (unsigned)(Rb * g.ldb + C) * 2u; }
    const size_t dvoffA = (size_t)64 * g.lda * 2, dvoffB = (size_t)64 * g.ldb * 2;
    const size_t kstep = (size_t)(BK * 2);
    const size_t hstepA = (size_t)HALF * g.lda * 2, hstepB = (size_t)HALF * g.ldb * 2;
    const size_t tstepA = 2 * hstepA, tstepB = 2 * hstepB;
    const unsigned ldsw = (unsigned)wid * 1024u;
    const int aoff = lds_byte(wr * 64 + fr, fq * 8), boff = lds_byte(wc * 32 + fr, fq * 8);
    bool primed = false; Unit cur, nxt;
    bool have = S.next(0, cur);
    for (int ui = 0; have; ++ui) {
        f32x4 acc[2][2][4][2];
#pragma unroll
        for (int a = 0; a < 2; ++a)
#pragma unroll
            for (int b = 0; b < 2; ++b)
#pragma unroll
                for (int m = 0; m < 4; ++m)
#pragma unroll
                    for (int n = 0; n < 2; ++n) acc[a][b][m][n] = (f32x4){0.f, 0.f, 0.f, 0.f};
        bf16x8 At[4][2], B0[2][2], B1[2][2];
        const char* cA = (const char*)g.A + (size_t)cur.pm * tstepA + (size_t)cur.ka * 2; const char* cB = (const char*)g.Bt + (size_t)cur.pn * tstepB + (size_t)cur.kb * 2;
        if (!primed) {
#if PG8_USE_SP2
        PG8_STAGE(PG8_SB(0, 0), cB, voffB); PG8_STAGE(PG8_SB(0, 1), cB + hstepB, voffB); PG8_STAGE(PG8_SA(0, 0), cA, voffA); PG8_STAGE(PG8_SA(0, 1), cA + hstepA, voffA);
        if (wr == 1) PG8_BAR;
        PG8_WAIT_V(2); PG8_BAR;
#else
        PG8_STAGE(PG8_SB(0, 0), cB, voffB); PG8_STAGE(PG8_SA(0, 0), cA, voffA); PG8_STAGE(PG8_SB(0, 1), cB + hstepB, voffB); PG8_STAGE(PG8_SA(0, 1), cA + hstepA, voffA);
        if (wr == 1) PG8_BAR;
        PG8_WAIT_V(4); PG8_BAR;
#endif
        PG8_STAGE(PG8_SB(1, 0), cB + kstep, voffB); PG8_STAGE(PG8_SA(1, 0), cA + kstep, voffA); PG8_STAGE(PG8_SB(1, 1), cB + hstepB + kstep, voffB);
        PG8_WAIT_V(6); PG8_BAR;
        }
        const bool has_next = S.next(ui + 1, nxt); const bool pf = has_next && !E.uses_lds(cur);
        const char* nA = pf ? (const char*)g.A + (size_t)nxt.pm * tstepA + (size_t)nxt.ka * 2 : cA; const char* nB = pf ? (const char*)g.Bt + (size_t)nxt.pn * tstepB + (size_t)nxt.kb * 2 : cB;
        for (int t = 0; t < nt; t += 2) {
            const bool last = (t == nt - 2);
            const char* a1 = cA + (size_t)(t + 1) * kstep;
            const char* a2 = last ? nA : cA + (size_t)(t + 2) * kstep; const char* b2 = last ? nB : cB + (size_t)(t + 2) * kstep;
            const char* a3 = a2 + kstep; const char* b3 = b2 + kstep;
#if PG8_USE_SP2
            PG8_LDB(B0, 0, 0); PG8_LDB(B1, 0, 1); PG8_SCHED; PG8_LDA(At, 0, 0); PG8_STAGE(PG8_SA(1, 1), a1 + hstepA, voffA);
            PG8_WAIT_V(8); PG8_WAIT_L(0); PG8_BAR; PG8_MMA(0, 0, At, B0); PG8_MMA(0, 1, At, B1); PG8_BAR; PG8_SCHED;
            PG8_LDA(At, 0, 1); PG8_STAGE(PG8_SB(0, 0), b2, voffB); PG8_STAGE(PG8_SB(0, 1), b2 + hstepB, voffB); PG8_STAGE(PG8_SA(0, 0), a2, voffA);
            PG8_WAIT_V(8); PG8_WAIT_L(0); PG8_BAR; PG8_MMA(1, 0, At, B0); PG8_MMA(1, 1, At, B1); PG8_BAR; PG8_SCHED;
            PG8_LDB(B0, 1, 0); PG8_LDB(B1, 1, 1); PG8_SCHED; PG8_LDA(At, 1, 0); PG8_STAGE(PG8_SA(0, 1), a2 + hstepA, voffA);
            PG8_WAIT_V(8); PG8_WAIT_L(0); PG8_BAR; PG8_MMA(0, 0, At, B0); PG8_MMA(0, 1, At, B1); PG8_BAR; PG8_SCHED;
            PG8_LDA(At, 1, 1); PG8_STAGE(PG8_SB(1, 0), b3, voffB); PG8_STAGE(PG8_SB(1, 1), b3 + hstepB, voffB); PG8_STAGE(PG8_SA(1, 0), a3, voffA);
            PG8_WAIT_V(8); PG8_WAIT_L(0); PG8_BAR; PG8_MMA(1, 0, At, B0); PG8_MMA(1, 1, At, B1); PG8_BAR; PG8_SCHED;
#else
            PG8_LDB(B0, 0, 0); PG8_SCHED; PG8_LDA(At, 0, 0); PG8_STAGE(PG8_SA(1, 1), a1 + hstepA, voffA);
            PG8_WAIT_L(8); PG8_BAR; PG8_WAIT_L(0); PG8_MMA(0, 0, At, B0); PG8_BAR; PG8_SCHED;
            PG8_LDB(B1, 0, 1); PG8_STAGE(PG8_SB(0, 0), b2, voffB);
            PG8_BAR; PG8_WAIT_L(0); PG8_MMA(0, 1, At, B1); PG8_BAR;
            PG8_LDA(At, 0, 1); PG8_STAGE(PG8_SA(0, 0), a2, voffA);
            PG8_BAR; PG8_WAIT_L(0); PG8_MMA(1, 0, At, B0); PG8_BAR; PG8_SCHED;
            PG8_STAGE(PG8_SB(0, 1), b2 + hstepB, voffB);
            PG8_WAIT_V(6); PG8_BAR; PG8_MMA(1, 1, At, B1); PG8_BAR;
            PG8_LDB(B0, 1, 0); PG8_SCHED; PG8_LDA(At, 1, 0); PG8_STAGE(PG8_SA(0, 1), a2 + hstepA, voffA);
            PG8_WAIT_L(8); PG8_BAR; PG8_WAIT_L(0); PG8_MMA(0, 0, At, B0); PG8_BAR; PG8_SCHED;
            PG8_LDB(B1, 1, 1); PG8_STAGE(PG8_SB(1, 0), b3, voffB);
            PG8_BAR; PG8_WAIT_L(0); PG8_MMA(0, 1, At, B1); PG8_BAR;
            PG8_LDA(At, 1, 1); PG8_STAGE(PG8_SA(1, 0), a3, voffA);
            PG8_BAR; PG8_WAIT_L(0); PG8_MMA(1, 0, At, B0); PG8_BAR; PG8_SCHED;
            PG8_STAGE(PG8_SB(1, 1), b3 + hstepB, voffB);
            PG8_WAIT_V(6); PG8_BAR; PG8_MMA(1, 1, At, B1); PG8_BAR;
#endif
        }
        if (wr == 0) PG8_BAR;
        if (pf) {
            { int t2 = threadIdx.x; asm volatile("" : "+v"(t2)); E.drain(acc, cur, wr, wc, t2 & 15, (t2 & 63) >> 4, lds, t2); }
            if (wr == 1) PG8_BAR;
            primed = true;
        } else {
            PG8_WAIT_V(0); PG8_WAIT_L(0); PG8_BAR;
            { int t2 = threadIdx.x; asm volatile("" : "+v"(t2)); E.drain(acc, cur, wr, wc, t2 & 15, (t2 & 63) >> 4, lds, t2); }
            PG8_WAIT_L(0); PG8_BAR;
            primed = false;
        }
        have = has_next; cur = nxt;
    }
#undef PG8_SA
#undef PG8_SB
#undef PG8_STAGE
#undef PG8_LDA
#undef PG8_LDB
#undef PG8_MMA
#undef PG8_WAIT_V
#undef PG8_WAIT_L
#undef PG8_BAR
#undef PG8_SCHED
}
}
using pg8::Unit;
typedef f32x4 AccT[2][2][4][2];

constexpr int PT = 260;
struct Epi1 {
    static constexpr bool CHAIN = false;
    DI bool uses_lds(const Unit& u) const { return u.pn < 8; }
    bf16_t *q, *k, *v, *ub, *gates; float* kmean; const float *qg, *kg, *bgate;
    DI void drain(AccT& acc, const Unit& u, int wr, int wc, int fr, int fq, LAS unsigned char* lds, int tid) const {
        const int pn = u.pn; const int rowb = u.pm * 256 + wr * 64 + fr;
        bf16_t *pq = q, *pk = k, *pv = v, *pu = ub, *pg = gates; const float *pqg = qg, *pkg = kg;
        asm volatile("" : "+s"(pq), "+s"(pk), "+s"(pv), "+s"(pu), "+s"(pg), "+s"(pqg), "+s"(pkg));
        if (pn >= 16) {
            const int c0 = (pn - 16) * 128 + wc * 32 + fq * 8;
            f32x4 ba[2], bb[2];
#pragma unroll
            for (int n = 0; n < 2; ++n) { ba[n] = *(const f32x4*)(bgate + c0 + 4 * n); bb[n] = *(const f32x4*)(bgate + 2048 + c0 + 4 * n); }
#pragma unroll
            for (int ai = 0; ai < 2; ++ai)
#pragma unroll
                for (int m = 0; m < 4; ++m) { bf16_t* rowp = pg + (size_t)(rowb + ai * 128 + m * 16) * 4096 + c0;
                    f32x4 rr[2], gg[2];
#pragma unroll
                    for (int n = 0; n < 2; ++n)
#pragma unroll
                        for (int i = 0; i < 4; ++i) { const float ea = __builtin_amdgcn_exp2f((acc[ai][0][m][n][i] + ba[n][i]) * -1.4426950408889634f), eb = __builtin_amdgcn_exp2f((acc[ai][1][m][n][i] + bb[n][i]) * -1.4426950408889634f);
                            gg[n][i] = __builtin_amdgcn_rcpf(1.0f + eb); rr[n][i] = (1.0f + eb) * __builtin_amdgcn_rcpf(1.0f + ea); }
                    *(u32x4*)rowp = pack8(rr[0], rr[1]); *(u32x4*)(rowp + 2048) = pack8(gg[0], gg[1]); }
            return;
        }
        if (pn >= 8) {
            bf16_t* base; int ldc, col0; const bool sig = false;
            if (pn < 12) { base = pv; ldc = 1024; col0 = (pn - 8) * 256; } else { base = pu; ldc = 1024; col0 = (pn - 12) * 256; }
            col0 += wc * 32 + fq * 8;
            f32x4 bv[2][2];
#pragma unroll
            for (int bj = 0; bj < 2; ++bj)
#pragma unroll
                for (int n = 0; n < 2; ++n) bv[bj][n] = sig ? *(const f32x4*)(bgate + col0 + bj * 128 + 4 * n) : (f32x4){0.f, 0.f, 0.f, 0.f};
#pragma unroll
            for (int ai = 0; ai < 2; ++ai)
#pragma unroll
                for (int m = 0; m < 4; ++m) { bf16_t* rowp = base + (size_t)(rowb + ai * 128 + m * 16) * ldc + col0;
#pragma unroll
                    for (int bj = 0; bj < 2; ++bj) { f32x4 v0 = acc[ai][bj][m][0] + bv[bj][0], v1 = acc[ai][bj][m][1] + bv[bj][1];
                        if (sig) {
#pragma unroll
                            for (int i = 0; i < 4; ++i) { v0[i] = sigmoidf_(v0[i]); v1[i] = sigmoidf_(v1[i]); } }
                        *(u32x4*)(rowp + bj * 128) = pack8(v0, v1); } }
            return;
        }
        const bool isq = pn < 4; const int hp = (pn & 3) * 2;
        const float* g = isq ? pqg : pkg; bf16_t* dst = isq ? pq : pk;
        const float qs = isq ? 0.08838834764831845f * 1.4426950408889634f : 1.0f;
        LAS float* T = (LAS float*)lds;
        const int r = tid >> 2, part = tid & 3, bj2 = part >> 1, sub = part & 1;
        float ksum = 0.f;
#pragma unroll
        for (int ai = 0; ai < 2; ++ai) {
#pragma unroll
            for (int m = 0; m < 4; ++m)
#pragma unroll
                for (int bj = 0; bj < 2; ++bj)
#pragma unroll
                    for (int n = 0; n < 2; ++n) *(LAS f32x4*)(T + (64 * wr + 16 * m + fr) * PT + 128 * bj + 32 * wc + 8 * fq + 4 * n) = acc[ai][bj][m][n];
            RAW_BAR();
            LAS float* rowp = T + r * PT + 128 * bj2 + 32 * sub;
            float ss = 0.f;
#pragma unroll
            for (int j = 0; j < 8; ++j) { const f32x4 a = *(const LAS f32x4*)(rowp + 4 * j), b = *(const LAS f32x4*)(rowp + 64 + 4 * j);
                ss += (a[0] * a[0] + a[1] * a[1]) + (a[2] * a[2] + a[3] * a[3]) + (b[0] * b[0] + b[1] * b[1]) + (b[2] * b[2] + b[3] * b[3]); }
            ss += __shfl_xor(ss, 1);
            const float rr = __builtin_amdgcn_rsqf(ss * (1.0f / 128.0f) + EPS) * qs;
            const int row = u.pm * 256 + ai * 128 + r;
            bf16_t* op = dst + (size_t)row * 1024 + (hp + bj2) * 128 + 32 * sub;
#pragma unroll 1
            for (int j = 0; j < 8; j += 2) {
                f32x4 o1[2], o2[2];
#pragma unroll
                for (int jj = 0; jj < 2; ++jj) {
                    const int d = 32 * sub + 4 * (j + jj);
                    const f32x4 x1 = *(const LAS f32x4*)(rowp + 4 * (j + jj)), x2 = *(const LAS f32x4*)(rowp + 64 + 4 * (j + jj));
                    const f32x4 g0 = *(const f32x4*)(g + d), g1 = *(const f32x4*)(g + 64 + d);
                    f32x4 cs, sn;
#pragma unroll
                    for (int i = 0; i < 4; ++i) { double t = (double)row * ROPE_C[d + i]; t -= __builtin_floor(t); const float tf = (float)t; cs[i] = __builtin_amdgcn_cosf(tf); sn[i] = __builtin_amdgcn_sinf(tf); }
                    const f32x4 a = x1 * rr * g0, b = x2 * rr * g1;
                    o1[jj] = a * cs - b * sn; o2[jj] = b * cs + a * sn;
                    if (!isq) { *(LAS f32x4*)(rowp + 4 * (j + jj)) = o1[jj]; *(LAS f32x4*)(rowp + 64 + 4 * (j + jj)) = o2[jj]; }
                }
                *(u32x4*)(op + 4 * j) = pack8(o1[0], o1[1]); *(u32x4*)(op + 64 + 4 * j) = pack8(o2[0], o2[1]);
            }
            if (!isq) { RAW_BAR(); if (tid < 256) {
#pragma unroll 8
                for (int rr2 = 0; rr2 < 128; ++rr2) ksum += T[rr2 * PT + tid]; } }
            RAW_BAR();
        }
        if (!isq && tid < 256) kmean[((size_t)(hp + (tid >> 7)) * 64 + u.pm) * 128 + (tid & 127)] = ksum * (1.0f / 256.0f);
    }
};

struct Epi3 {
    static constexpr bool CHAIN = false;
    bf16_t* am; const float* ls;
    DI void drain(AccT& acc, const Unit& u, int wr, int wc, int fr, int fq, LAS unsigned char* l, int) const { (*this)(acc, u, wr, wc, fr, fq, l); }
    DI void operator()(AccT& acc, const Unit& u, int wr, int wc, int fr, int fq, LAS unsigned char*) const {
        const int col0 = u.pn * 256 + wc * 32 + fq * 8; const int rowb = u.pm * 256 + wr * 64 + fr;
        f32x4 sv[2][2];
#pragma unroll
        for (int bj = 0; bj < 2; ++bj)
#pragma unroll
            for (int n = 0; n < 2; ++n) sv[bj][n] = *(const f32x4*)(ls + col0 + bj * 128 + 4 * n);
#pragma unroll
        for (int ai = 0; ai < 2; ++ai)
#pragma unroll
            for (int m = 0; m < 4; ++m) { bf16_t* rowp = am + (size_t)(rowb + ai * 128 + m * 16) * 2048 + 1024 + col0;
#pragma unroll
                for (int bj = 0; bj < 2; ++bj) *(u32x4*)(rowp + bj * 128) = pack8(acc[ai][bj][m][0] * sv[bj][0], acc[ai][bj][m][1] * sv[bj][1]); }
    }
};

struct Epi5 {
    static constexpr bool CHAIN = true;
    const bf16_t* gates; bf16_t* merged;
    DI void operator()(AccT& acc, const Unit& u, int wr, int wc, int fr, int fq, LAS unsigned char*) const {
        const int col0 = u.pn * 256 + wc * 32 + fq * 8; const int rowb = u.pm * 256 + wr * 64 + fr;
        if (u.aux == 0) {
#pragma unroll
            for (int ai = 0; ai < 2; ++ai) {
                u32x4 gw[4][2];
#pragma unroll
                for (int m = 0; m < 4; ++m)
#pragma unroll
                    for (int bj = 0; bj < 2; ++bj) gw[m][bj] = *(const u32x4*)(gates + (size_t)(rowb + ai * 128 + m * 16) * 4096 + col0 + bj * 128);
#pragma unroll
                for (int m = 0; m < 4; ++m)
#pragma unroll
                    for (int bj = 0; bj < 2; ++bj) { float gr[8]; unpack8(gw[m][bj], gr);
#pragma unroll
                        for (int i = 0; i < 4; ++i) { acc[ai][bj][m][0][i] *= gr[i]; acc[ai][bj][m][1][i] *= gr[4 + i]; } }
                FENCE();
            }
        } else {
#pragma unroll
            for (int ai = 0; ai < 2; ++ai) {
                u32x4 gw[4][2];
#pragma unroll
                for (int m = 0; m < 4; ++m)
#pragma unroll
                    for (int bj = 0; bj < 2; ++bj) gw[m][bj] = *(const u32x4*)(gates + (size_t)(rowb + ai * 128 + m * 16) * 4096 + 2048 + col0 + bj * 128);
#pragma unroll
                for (int m = 0; m < 4; ++m)
#pragma unroll
                    for (int bj = 0; bj < 2; ++bj) { float gp[8]; unpack8(gw[m][bj], gp); f32x4 v0, v1;
#pragma unroll
                        for (int i = 0; i < 4; ++i) { v0[i] = acc[ai][bj][m][0][i] * gp[i]; v1[i] = acc[ai][bj][m][1][i] * gp[4 + i]; }
                        *(u32x4*)(merged + (size_t)(rowb + ai * 128 + m * 16) * 2048 + col0 + bj * 128) = pack8(v0, v1); }
                FENCE();
            }
        }
    }
};

struct Epi6 {
    static constexpr bool CHAIN = false;
    const float* x; float* out; bf16_t* xg; const float* modf; const float* nfg; float* rowss;
    DI void operator()(AccT& acc, const Unit& u, int wr, int wc, int fr, int fq, LAS unsigned char*) const {
        const int col0 = u.pn * 256 + wc * 32 + fq * 8; const int rowb = u.pm * 256 + wr * 64 + fr;
        f32x4 g1v[2][2], gmv[2][2];
#pragma unroll
        for (int bj = 0; bj < 2; ++bj)
#pragma unroll
            for (int n = 0; n < 2; ++n) { const int c = col0 + bj * 128 + 4 * n; g1v[bj][n] = *(const f32x4*)(modf + 2 * 2048 + c);
                gmv[bj][n] = *(const f32x4*)(nfg + c) * (*(const f32x4*)(modf + 4 * 2048 + c) + 1.0f); }
#pragma unroll
        for (int ag = 0; ag < 4; ++ag) { const int ai = ag >> 1, m0 = (ag & 1) * 2;
            f32x4 xr[4][2][2];
#pragma unroll
            for (int m = m0; m < m0 + 2; ++m)
#pragma unroll
                for (int bj = 0; bj < 2; ++bj) { const size_t off = (size_t)(rowb + ai * 128 + m * 16) * 2048 + col0 + bj * 128;
                    xr[m][bj][0] = *(const f32x4*)(x + off); xr[m][bj][1] = *(const f32x4*)(x + off + 4); }
            FENCE();
#pragma unroll
            for (int m = m0; m < m0 + 2; ++m) { const size_t row = (size_t)(rowb + ai * 128 + m * 16); float ss = 0.f;
#pragma unroll
                for (int bj = 0; bj < 2; ++bj) { const size_t off = row * 2048 + col0 + bj * 128;
                    const f32x4 y0 = xr[m][bj][0] + g1v[bj][0] * acc[ai][bj][m][0], y1 = xr[m][bj][1] + g1v[bj][1] * acc[ai][bj][m][1];
                    *(f32x4*)(out + off) = y0; *(f32x4*)(out + off + 4) = y1;
                    *(u32x4*)(xg + off) = pack8(y0 * gmv[bj][0], y1 * gmv[bj][1]);
                    ss += (y0[0] * y0[0] + y0[1] * y0[1]) + (y0[2] * y0[2] + y0[3] * y0[3]) + (y1[0] * y1[0] + y1[1] * y1[1]) + (y1[2] * y1[2] + y1[3] * y1[3]); }
                ss += __shfl_xor(ss, 16); ss += __shfl_xor(ss, 32);
                if (fq == 0) rowss[row * 32 + u.pn * 4 + wc] = ss; }
            FENCE();
        }
    }
};

struct Epi7 {
    static constexpr bool CHAIN = false;
    DI bool uses_lds(const Unit&) const { return true; }
    const float* rsb; const float* biasup; const float* cw; const float* cb; bf16_t* act; float* edge;
    DI void drain(AccT& acc, const Unit& u, int wr, int wc, int fr, int fq, LAS unsigned char* lds, int tid) const {
        LAS float* T = (LAS float*)lds;
        const int cgi = tid & 15, rg = tid >> 4;
        const int lcb = u.pn * 128;
        const int cg8 = (tid >> 1) & 15, h4 = tid & 1, rgi = tid >> 5;
        const int cc = 8 * cg8 + 4 * h4, lca = lcb + cc, lcbb = DFF + lcb + cc;
        const f32x4 wa0 = *(const f32x4*)(cw + lca), wa1 = *(const f32x4*)(cw + NUP + lca), wa2 = *(const f32x4*)(cw + 2 * NUP + lca), ca0 = *(const f32x4*)(cb + lca);
        const f32x4 wb0 = *(const f32x4*)(cw + lcbb), wb1 = *(const f32x4*)(cw + NUP + lcbb), wb2 = *(const f32x4*)(cw + 2 * NUP + lcbb), cb0 = *(const f32x4*)(cb + lcbb);
        f32x4 biv[2][2]; float rsv[2][4];
#pragma unroll
        for (int bj = 0; bj < 2; ++bj)
#pragma unroll
            for (int n = 0; n < 2; ++n) biv[bj][n] = *(const f32x4*)(biasup + u.pn * 256 + 128 * bj + 32 * wc + 8 * fq + 4 * n);
#pragma unroll
        for (int ai = 0; ai < 2; ++ai)
#pragma unroll
            for (int m = 0; m < 4; ++m) rsv[ai][m] = rsb[u.pm * 256 + ai * 128 + 64 * wr + 16 * m + fr];
#pragma unroll
        for (int ai = 0; ai < 2; ++ai) {
            {
#pragma unroll
                for (int bj = 0; bj < 2; ++bj)
#pragma unroll
                    for (int n = 0; n < 2; ++n) {
#pragma unroll
                        for (int m = 0; m < 4; ++m) *(LAS f32x4*)(T + (2 + 64 * wr + 16 * m + fr) * PT + 128 * bj + 32 * wc + 8 * fq + 4 * n) = acc[ai][bj][m][n] * rsv[ai][m] + biv[bj][n]; }
            }
            RAW_BAR();
            {
#pragma unroll 1
                for (int ch = 0; ch < 2; ++ch) {
                    const int r0 = 8 * rgi + 4 * ch;
                    f32x4 xa[6], xb[6];
#pragma unroll
                    for (int kx = 0; kx < 6; ++kx) { xa[kx] = *(const LAS f32x4*)(T + (r0 + kx) * PT + cc); xb[kx] = *(const LAS f32x4*)(T + (r0 + kx) * PT + 128 + cc); }
                    u32x2 pw[4];
#pragma unroll
                    for (int kx = 0; kx < 4; ++kx) { const f32x4 av = ca0 + wa0 * xa[kx] + wa1 * xa[kx + 1] + wa2 * xa[kx + 2], bv = cb0 + wb0 * xb[kx] + wb1 * xb[kx + 1] + wb2 * xb[kx + 2];
                        float rv[4];
#pragma unroll
                        for (int i = 0; i < 4; ++i) rv[i] = av[i] * sigmoidf_(av[i]) * bv[i];
                        pw[kx].x = pk2(rv[0], rv[1]); pw[kx].y = pk2(rv[2], rv[3]); }
                    const u32x2 s0 = h4 ? pw[0] : pw[2], s1 = h4 ? pw[1] : pw[3];
                    u32x2 g0, g1; g0.x = __shfl_xor(s0.x, 1); g0.y = __shfl_xor(s0.y, 1); g1.x = __shfl_xor(s1.x, 1); g1.y = __shfl_xor(s1.y, 1);
                    const u32x2 m0 = h4 ? pw[2] : pw[0], m1 = h4 ? pw[3] : pw[1];
                    const u32x4 o0 = h4 ? (u32x4){g0.x, g0.y, m0.x, m0.y} : (u32x4){m0.x, m0.y, g0.x, g0.y};
                    const u32x4 o1 = h4 ? (u32x4){g1.x, g1.y, m1.x, m1.y} : (u32x4){m1.x, m1.y, g1.x, g1.y};
                    if (!(ai == 0 && rgi == 0 && ch == 0 && h4 == 0)) {
                        const size_t row = (size_t)(u.pm * 256 + ai * 128 + r0 + 2 * h4);
                        *(u32x4*)(act + row * DFF + lcb + 8 * cg8) = o0; *(u32x4*)(act + (row + 1) * DFF + lcb + 8 * cg8) = o1; }
                }
            }
            if (tid < 128) { const int sel = tid >> 6, col4 = (tid & 63) * 4; const int lc = (col4 < 128) ? (lcb + col4) : (DFF + lcb + col4 - 128);
                const f32x4 ev = *(const LAS f32x4*)(T + ((ai == 0 ? 2 : 128) + sel) * PT + col4);
                *(f32x4*)(edge + ((size_t)(u.pm * 4 + 2 * ai + sel)) * NUP + lc) = ev; }
            RAW_BAR();
            if (ai == 0) { if (tid < 128) { const int sel = tid >> 6, col4 = (tid & 63) * 4; *(LAS f32x4*)(T + sel * PT + col4) = *(const LAS f32x4*)(T + (128 + sel) * PT + col4); }
                RAW_BAR(); }
        }
    }
};

struct Epi9 {
    static constexpr bool CHAIN = false;
    float* out; const float* modf;
    DI void operator()(AccT& acc, const Unit& u, int wr, int wc, int fr, int fq, LAS unsigned char*) const {
        const int col0 = u.pn * 256 + wc * 32 + fq * 8; const int rowb = u.pm * 256 + wr * 64 + fr;
        f32x4 g2v[2][2];
#pragma unroll
        for (int bj = 0; bj < 2; ++bj)
#pragma unroll
            for (int n = 0; n < 2; ++n) g2v[bj][n] = *(const f32x4*)(modf + 5 * 2048 + col0 + bj * 128 + 4 * n);
#pragma unroll
        for (int ag = 0; ag < 4; ++ag) { const int ai = ag >> 1, m0 = (ag & 1) * 2;
            f32x4 xr[4][2][2];
#pragma unroll
            for (int m = m0; m < m0 + 2; ++m)
#pragma unroll
                for (int bj = 0; bj < 2; ++bj) { const size_t off = (size_t)(rowb + ai * 128 + m * 16) * 2048 + col0 + bj * 128;
                    xr[m][bj][0] = *(const f32x4*)(out + off); xr[m][bj][1] = *(const f32x4*)(out + off + 4); }
            FENCE();
#pragma unroll
            for (int m = m0; m < m0 + 2; ++m)
#pragma unroll
                for (int bj = 0; bj < 2; ++bj) { const size_t off = (size_t)(rowb + ai * 128 + m * 16) * 2048 + col0 + bj * 128;
                    *(f32x4*)(out + off) = xr[m][bj][0] + g2v[bj][0] * acc[ai][bj][m][0]; *(f32x4*)(out + off + 4) = xr[m][bj][1] + g2v[bj][1] * acc[ai][bj][m][1]; }
            FENCE();
        }
    }
};

DI int dest_row(int mode, int n) {
    if (mode == 1) { if (n >= 2048) return n; const int d = n & 127; return (n & ~127) + 32 * ((d >> 4) & 3) + 8 * ((d >> 2) & 3) + 4 * (d >> 6) + (d & 3); }
    if (mode == 2) { const int bj = n >= DFF ? 1 : 0, cc = n - bj * DFF; return 256 * (cc >> 7) + 128 * bj + (cc & 127); }
    if (mode == 3) { const int bj = n >= 2048 ? 1 : 0, cc = n - bj * 2048; return 256 * (cc >> 7) + 128 * bj + (cc & 127); }
    return n;
}
DI void transpose_item(const float* W, int N, bf16_t* WT, int ldd, int koff, int row_off, int mode, LAS float* scr, int item, int lane) {
    const int nblk = N / 64, kb = item / nblk, nb = item % nblk, k0 = 64 * kb, n0 = 64 * nb;
    const int kr = lane >> 4, n4 = (lane & 15) * 4;
    f32x4 v[16];
#pragma unroll
    for (int i = 0; i < 16; ++i) v[i] = __builtin_nontemporal_load((const f32x4*)(W + (size_t)(k0 + 4 * i + kr) * N + n0 + n4));
#pragma unroll
    for (int i = 0; i < 16; ++i) { LAS float* d = scr + (4 * i + kr) * 65 + n4; d[0] = v[i][0]; d[1] = v[i][1]; d[2] = v[i][2]; d[3] = v[i][3]; }
    LDS_WAIT(); asm volatile("" ::: "memory");
    const int c = lane & 7;
#pragma unroll
    for (int j = 0; j < 8; ++j) { const int n = (lane >> 3) + 8 * j; const LAS float* sp = scr + (8 * c) * 65 + n;
        u32x4 o; o.x = pk2(sp[0 * 65], sp[1 * 65]); o.y = pk2(sp[2 * 65], sp[3 * 65]); o.z = pk2(sp[4 * 65], sp[5 * 65]); o.w = pk2(sp[6 * 65], sp[7 * 65]);
        *(u32x4*)(WT + (size_t)(row_off + dest_row(mode, n0 + n)) * ldd + koff + k0 + 8 * c) = o; }
    LDS_WAIT(); asm volatile("" ::: "memory");
}

DI s16x4 vtr(const LAS unsigned char* p) { typedef short v4i16_t __attribute__((ext_vector_type(4))); return __builtin_bit_cast(s16x4, __builtin_amdgcn_ds_read_tr16_b64_v4i16((LAS v4i16_t*)p)); }
constexpr int KV_PITCH = 272;
constexpr int LDS_KS = 0, LDS_VS = 256 * KV_PITCH, LDS_TAB = 2 * 256 * KV_PITCH;


#define XB_TMO      128
#define XB_XCNT(j)  (256  + 64 * (j))
#define XB_XSUB(j)  (1280 + 64 * (j))
#define XB_XGEN(j)  (2304 + 64 * (j))
#define XB_TOP      3328
#define XB_TOPGEN   3392
#define XCD_BAR_WORDS 3456
#define XB_SPIN_CAP (1u << 18)
DI unsigned xb_ld(unsigned* p)              { return __hip_atomic_load(p, __ATOMIC_RELAXED, __HIP_MEMORY_SCOPE_AGENT); }
DI unsigned xb_add(unsigned* p, unsigned v) { return __hip_atomic_fetch_add(p, v, __ATOMIC_RELAXED, __HIP_MEMORY_SCOPE_AGENT); }
DI unsigned xb_xcc_id() { return (unsigned)__builtin_amdgcn_s_getreg((3 << 11) | 20) & 0xFu; }
#define XB_SPIN(cond, bar) do { unsigned _sp = 0; while (cond) { __builtin_amdgcn_s_sleep(1); \
    if ((++_sp & 255u) == 0u) { if (xb_ld(&(bar)[XB_TMO])) break; if (_sp > XB_SPIN_CAP) { atomicAdd(&(bar)[XB_TMO], 1u); break; } } } } while (0)
struct XcdBarrier { unsigned* bar; unsigned x; volatile LAS unsigned* st; };
DI XcdBarrier xcd_barrier_post(unsigned* bar, volatile LAS unsigned* st) {
    XcdBarrier b; b.bar = bar; b.x = xb_xcc_id(); b.st = st;
    if (threadIdx.x == 0) (void)xb_add(&bar[XB_XCNT(b.x)], 1u);
    return b;
}
DI void xcd_barrier_complete(unsigned* bar, unsigned x, unsigned& nloc, unsigned& nx) {
    const unsigned G = gridDim.x * gridDim.y * gridDim.z;
    unsigned sum, cnt, mine, sp = 0u;
    for (;;) {
        sum = 0u; cnt = 0u; mine = 0u;
#pragma unroll
        for (unsigned j = 0; j < 16; ++j) { const unsigned c = xb_ld(&bar[XB_XCNT(j)]); sum += c; cnt += (c > 0u) ? 1u : 0u; mine = (j == x) ? c : mine; }
        if (sum == G) break;
        __builtin_amdgcn_s_sleep(1);
        if ((++sp & 255u) == 0u) { if (xb_ld(&bar[XB_TMO])) break; if (sp > XB_SPIN_CAP) { atomicAdd(&bar[XB_TMO], 1u); break; } }
    }
    nloc = mine > 0u ? mine : 1u; nx = cnt > 0u ? cnt : 1u;
}
DI void xcd_barrier(const XcdBarrier& b) {
    asm volatile("s_waitcnt vmcnt(0)" ::: "memory");
    __syncthreads();
    if (threadIdx.x == 0) {
        unsigned* bar = b.bar;
        __builtin_amdgcn_s_waitcnt(0);
        unsigned nloc = b.st[0], nx = b.st[1];
        if (nloc == 0u) { xcd_barrier_complete(bar, b.x, nloc, nx); b.st[0] = nloc; b.st[1] = nx; }
        const unsigned old = xb_add(&bar[XB_XSUB(b.x)], 1u);
        const unsigned gen = old / nloc;
        if (old + 1u == (gen + 1u) * nloc) {
            __builtin_amdgcn_fence(__ATOMIC_RELEASE, "agent");
            asm volatile("s_waitcnt vmcnt(0)" ::: "memory");
            const unsigned og = xb_add(&bar[XB_TOP], 1u);
            const unsigned tg = og / nx;
            if (og + 1u == (tg + 1u) * nx) xb_add(&bar[XB_TOPGEN], 1u);
            else XB_SPIN(xb_ld(&bar[XB_TOPGEN]) == tg, bar);
            __builtin_amdgcn_fence(__ATOMIC_ACQUIRE, "agent");
            xb_add(&bar[XB_XGEN(b.x)], 1u);
            asm volatile("s_waitcnt vmcnt(0)" ::: "memory");
        } else {
            XB_SPIN(xb_ld(&bar[XB_XGEN(b.x)]) == gen, bar);
            __builtin_amdgcn_fence(__ATOMIC_ACQUIRE, "agent");
            asm volatile("s_waitcnt vmcnt(0)" ::: "memory");
        }
    }
    __syncthreads();
}

#ifndef PHMASK
#define PHMASK 0xFFFF
#endif
struct Params {
    const float* in[20]; float* out; unsigned char* ws;
};

__global__ void __launch_bounds__(NTHR, 2) fwd_megakernel(Params p) {
    extern __shared__ __attribute__((aligned(16))) unsigned char lds_raw[];
    LAS unsigned char* lds = (LAS unsigned char*)lds_raw;
    cg::grid_group grid = cg::this_grid();
    int tid = threadIdx.x, lane = tid & 63; const int wave = __builtin_amdgcn_readfirstlane(tid >> 6);
#define RELOAD_IDS() do { tid = threadIdx.x; asm volatile("" : "+v"(tid)); lane = tid & 63; } while (0)
    const int G = gridDim.x, bx = blockIdx.x;
    const int vcu = (G % 8 == 0) ? (bx % 8) * (G / 8) + bx / 8 : bx;
    const int gw = vcu * NWAVES + wave, NGW = G * NWAVES;
    unsigned char* ws = p.ws;
    volatile LAS unsigned* xst = (volatile LAS unsigned*)(lds + LDS_BYTES - 16);
    if (threadIdx.x < 4) xst[threadIdx.x] = 0u;
    __syncthreads();
    XcdBarrier xbar; xbar.bar = (unsigned*)(ws + WS_BAR); xbar.x = 0; xbar.st = xst;
    if (blockIdx.x == 0) {
        for (int i = threadIdx.x; i < 512; i += NTHR) ((unsigned*)(ws + WS_CNT))[i] = 0u;
        for (int i = threadIdx.x; i < XCD_BAR_WORDS; i += NTHR) ((unsigned*)(ws + WS_BAR))[i] = 0u;
    }
#define xin (p.in[0])
#define cvec (p.in[1])
#define w_ada (p.in[2])
#define b_ada (p.in[3])
#define nmg (p.in[4])
#define w_in (p.in[5])
#define qng (p.in[6])
#define kng (p.in[7])
#define w_pgrp (p.in[8])
#define pscale (p.in[9])
#define w_abr (p.in[10])
#define w_pbr (p.in[11])
#define w_gate (p.in[12])
#define b_gate (p.in[13])
#define w_o (p.in[14])
#define nfg (p.in[15])
#define w_up (p.in[16])
#define conv_w (p.in[17])
#define conv_b (p.in[18])
#define w_down (p.in[19])
#define outp (p.out)
#define cnt ((unsigned*)(ws + WS_CNT))
#define kmean ((float*)(ws + WS_KMEAN))
#define modp ((float*)(ws + WS_MODP))
#define modf ((float*)(ws + WS_MODF))
#define biasup ((float*)(ws + WS_BIASUP))
#define rowss ((float*)(ws + WS_ROWSS))
#define lsum ((float*)(ws + WS_LSUM))
#define qlist ((unsigned*)(ws + WS_LIST))
#define W1t ((bf16_t*)(ws + WS_W1))
#define Wyt ((bf16_t*)(ws + WS_WY))
#define Wot ((bf16_t*)(ws + WS_WO))
#define Wgt ((bf16_t*)(ws + WS_WG))
#define Wdt ((bf16_t*)(ws + WS_WD))
#define Wut ((bf16_t*)(ws + WS_WU))
#define hbuf ((bf16_t*)(ws + WS_HB))
#define qb ((bf16_t*)(ws + WS_Q))
#define kb ((bf16_t*)(ws + WS_K))
#define vb ((bf16_t*)(ws + WS_V))
#define ub ((bf16_t*)(ws + WS_U))
#define gates ((bf16_t*)(ws + WS_GATES))
#define dbuf ((bf16_t*)(ws + WS_DB))
#define am ((bf16_t*)(ws + WS_AM))
#define merged ((bf16_t*)(ws + WS_MERGED))
#define xg ((bf16_t*)(ws + WS_XG))
#define act ((bf16_t*)(ws + WS_ACT))
#define edge ((float*)(ws + WS_EDGE))
#define slots ((bf16_t*)p.out)
#define rsb ((float*)(ws + WS_LSUM))
#if PHMASK & 1
    {
        LAS float* scr = (LAS float*)(lds + wave * 16640);
        constexpr int I_IN = 32 * 64, I_GT = 32 * 64, I_AB = 16 * 32, I_PB = 16 * 32, I_O = 32 * 32, I_UP = 32 * 176, I_DN = 88 * 32, I_G = 4 * 4;
        constexpr int NIT = I_IN + I_GT + I_AB + I_PB + I_O + I_UP + I_DN + 4 * I_G;
        for (int it = gw; it < NIT; it += NGW) {
            int r = it;
            if (r < I_UP) { transpose_item(w_up, NUP, Wut, 2048, 0, 0, 2, scr, r, lane); continue; } r -= I_UP;
            if (r < I_DN) { transpose_item(w_down, 2048, Wdt, DFF, 0, 0, 0, scr, r, lane); continue; } r -= I_DN;
            if (r < I_IN) { transpose_item(w_in, 4096, W1t, 2048, 0, 0, 0, scr, r, lane); continue; } r -= I_IN;
            if (r < I_GT) { transpose_item(w_gate, 4096, W1t, 2048, 0, 4096, 3, scr, r, lane); continue; } r -= I_GT;
            if (r < I_AB) { transpose_item(w_abr, 2048, Wyt, 2048, 0, 0, 0, scr, r, lane); continue; } r -= I_AB;
            if (r < I_PB) { transpose_item(w_pbr, 2048, Wyt, 2048, 1024, 0, 0, scr, r, lane); continue; } r -= I_PB;
            if (r < I_O) { transpose_item(w_o, 2048, Wot, 2048, 0, 0, 0, scr, r, lane); continue; } r -= I_O;
            { const int gI = r / I_G; transpose_item(w_pgrp + (size_t)gI * 65536, 256, Wgt, 1024, 0, gI * 256, 0, scr, r % I_G, lane); }
        }
        for (int it = gw; it < 768; it += NGW) {
            const int kc = it / 48, cgi = it % 48; const int col = cgi * 256 + lane * 4;
            f32x4 a = (f32x4){0.f, 0.f, 0.f, 0.f};
#pragma unroll 8
            for (int kk = 0; kk < 128; ++kk) { const int kx = kc * 128 + kk; const float cv = cvec[kx]; const float sv = cv * sigmoidf_(cv);
                a += __builtin_nontemporal_load((const f32x4*)(w_ada + (size_t)kx * 12288 + col)) * sv; }
            *(f32x4*)(modp + (size_t)kc * 12288 + col) = a;
        }
    }
    grid.sync();
    xbar = xcd_barrier_post((unsigned*)(ws + WS_BAR), xst);
    RELOAD_IDS();

#endif
#if PHMASK & 2
    {
        LAS float* sh1 = (LAS float*)lds; LAS float* gm1 = sh1 + 2048;
        for (int e = tid; e < 4096; e += NTHR) { float s = b_ada[e];
#pragma unroll
            for (int kc = 0; kc < 16; ++kc) s += modp[(size_t)kc * 12288 + e];
            if (e < 2048) sh1[e] = s; else gm1[e - 2048] = nmg[e - 2048] * (1.0f + s); }
        if (tid < 48) { const int e = bx * 48 + tid; if (e < 12288 && bx < 256) { float s = b_ada[e];
#pragma unroll
            for (int kc = 0; kc < 16; ++kc) s += modp[(size_t)kc * 12288 + e];
            modf[e] = s; } }
        if (G < 256 && bx == 0) { for (int e = G * 48 + tid; e < 12288; e += NTHR) { float s = b_ada[e]; for (int kc = 0; kc < 16; ++kc) s += modp[(size_t)kc * 12288 + e]; modf[e] = s; } }
        __syncthreads();
        for (int m = gw; m < S; m += 2 * NGW) {
            const int m2 = (m + NGW < S) ? m + NGW : m;
            const f32x4* xr0 = (const f32x4*)(xin + (size_t)m * DM) + lane; const f32x4* xr1 = (const f32x4*)(xin + (size_t)m2 * DM) + lane;
            f32x4 v0[8], v1[8]; float s0 = 0.f, s1 = 0.f;
#pragma unroll
            for (int j = 0; j < 8; ++j) { v0[j] = xr0[64 * j]; v1[j] = xr1[64 * j]; }
#pragma unroll
            for (int j = 0; j < 8; ++j) { s0 += (v0[j][0] * v0[j][0] + v0[j][1] * v0[j][1]) + (v0[j][2] * v0[j][2] + v0[j][3] * v0[j][3]);
                s1 += (v1[j][0] * v1[j][0] + v1[j][1] * v1[j][1]) + (v1[j][2] * v1[j][2] + v1[j][3] * v1[j][3]); }
            const float r0 = __builtin_amdgcn_rsqf(wave_sum(s0) * (1.0f / DM) + EPS), r1 = __builtin_amdgcn_rsqf(wave_sum(s1) * (1.0f / DM) + EPS);
            u32x2* o0 = (u32x2*)(hbuf + (size_t)m * DM) + lane; u32x2* o1 = (u32x2*)(hbuf + (size_t)m2 * DM) + lane;
#pragma unroll
            for (int j = 0; j < 8; ++j) { const int c = 4 * lane + 256 * j; const f32x4 gmv = *(const LAS f32x4*)(gm1 + c), shv = *(const LAS f32x4*)(sh1 + c);
                const f32x4 h0 = v0[j] * r0 * gmv + shv, h1 = v1[j] * r1 * gmv + shv;
                u32x2 w0, w1; w0.x = pk2(h0[0], h0[1]); w0.y = pk2(h0[2], h0[3]); w1.x = pk2(h1[0], h1[1]); w1.y = pk2(h1[2], h1[3]); o0[64 * j] = w0; o1[64 * j] = w1; }
        }
    }
    xcd_barrier(xbar);
    RELOAD_IDS();

#endif
#if PHMASK & 4
    {
        pg8::Gemm g{hbuf, W1t, 2048, 2048, 2048}; pg8::Sched<0> Sc; Sc.init(S, N1, G, bx);
        Epi1 E{qb, kb, vb, ub, gates, kmean, qng, kng, b_gate};
        pg8::gemm_phase_drain<Epi1>(lds, g, Sc, E);
    }
    xcd_barrier(xbar);
    RELOAD_IDS();

#endif
#if PHMASK & 8
    {
        LAS unsigned char* kmb = lds;
        LAS unsigned* hist = (LAS unsigned*)(lds + 32768); LAS unsigned* basep = hist + 64;
        for (int base = bx * 8; base < 2048; base += G * 8) {
            const int h = base >> 8;
            __syncthreads();
            { const int jr = tid >> 3, c0 = (tid & 7) * 16; const f32x4* src = (const f32x4*)(kmean + (size_t)h * 8192 + jr * 128 + c0);
              const f32x4 k0 = src[0], k1 = src[1], k2 = src[2], k3 = src[3];
              *(LAS u32x4*)(kmb + jr * KV_PITCH + c0 * 2) = pack8(k0, k1); *(LAS u32x4*)(kmb + jr * KV_PITCH + c0 * 2 + 16) = pack8(k2, k3); }
            if (tid < 64) hist[tid] = 0u;
            __syncthreads();
            const int item = base + wave, qgi = item & 255, own = qgi >> 2, ns = own < 3 ? own : 3;
            const int r32 = lane & 31, hh = lane >> 5;
            int selj[2][3]; unsigned selp[2][3];
#pragma unroll
            for (int sub = 0; sub < 2; ++sub) {
                const int qi = qgi * 64 + sub * 32 + r32;
                const bf16_t* qp = qb + (size_t)qi * 1024 + h * 128 + 8 * hh;
                f32x16 ac[2];
#pragma unroll
                for (int jt = 0; jt < 2; ++jt)
#pragma unroll
                    for (int i = 0; i < 16; ++i) ac[jt][i] = 0.f;
#pragma unroll
                for (int ks = 0; ks < 8; ++ks) { const bf16x8 qf = *(const bf16x8*)(qp + 16 * ks);
#pragma unroll
                    for (int jt = 0; jt < 2; ++jt) { const bf16x8 kf = *(const LAS bf16x8*)(kmb + (32 * jt + r32) * KV_PITCH + 32 * ks + 16 * hh);
                        ac[jt] = __builtin_amdgcn_mfma_f32_32x32x16_bf16(kf, qf, ac[jt], 0, 0, 0); } }
                float b0 = -3.0e38f, b1 = -3.0e38f, b2 = -3.0e38f; int i0 = 255, i1 = 255, i2 = 255;
#pragma unroll
                for (int jt = 0; jt < 2; ++jt)
#pragma unroll
                    for (int i = 0; i < 16; ++i) { const int j = 32 * jt + (i & 3) + 8 * (i >> 2) + 4 * hh; const float vj = (j < own) ? ac[jt][i] : -3.0e38f;
                        if (vj > b0) { b2 = b1; i2 = i1; b1 = b0; i1 = i0; b0 = vj; i0 = j; }
                        else if (vj > b1) { b2 = b1; i2 = i1; b1 = vj; i1 = j; }
                        else if (vj > b2) { b2 = vj; i2 = j; } }
                const float p0 = __shfl_xor(b0, 32), p1 = __shfl_xor(b1, 32), p2 = __shfl_xor(b2, 32);
                const int q0 = __shfl_xor(i0, 32), q1 = __shfl_xor(i1, 32), q2 = __shfl_xor(i2, 32);
#pragma unroll
                for (int t = 0; t < 3; ++t) { const float vj = t == 0 ? p0 : (t == 1 ? p1 : p2); const int j = t == 0 ? q0 : (t == 1 ? q1 : q2);
                    if (vj > b0 || (vj == b0 && j < i0)) { b2 = b1; i2 = i1; b1 = b0; i1 = i0; b0 = vj; i0 = j; }
                    else if (vj > b1 || (vj == b1 && j < i1)) { b2 = b1; i2 = i1; b1 = vj; i1 = j; }
                    else if (vj > b2 || (vj == b2 && j < i2)) { b2 = vj; i2 = j; } }
                selj[sub][0] = i0; selj[sub][1] = i1; selj[sub][2] = i2;
#pragma unroll
                for (int t = 0; t < 3; ++t) selp[sub][t] = (hh == 0 && t < ns) ? __hip_atomic_fetch_add((unsigned*)(hist + selj[sub][t]), 1u, __ATOMIC_RELAXED, __HIP_MEMORY_SCOPE_WORKGROUP) : 0u;
            }
            __syncthreads();
            if (tid < 64) { const unsigned c = hist[tid]; basep[tid] = c ? atomicAdd(cnt + h * 64 + tid, c) : 0u; }
            __syncthreads();
            if (hh == 0) {
#pragma unroll
                for (int sub = 0; sub < 2; ++sub)
#pragma unroll
                    for (int t = 0; t < 3; ++t) if (t < ns) { const int j = selj[sub][t]; const unsigned qi = (unsigned)(qgi * 64 + sub * 32 + r32);
                        qlist[(size_t)(h * 64 + j) * 16384 + basep[j] + selp[sub][t]] = qi * 4u + (unsigned)t; }
            }
        }
        for (int idx = vcu * NTHR + tid; idx < 2048 * 128; idx += G * NTHR) {
            const int cgi = idx & 127, rc = idx >> 7, w = 2 << (cgi >> 5), t0 = rc * 8;
            const bf16_t* __restrict__ up = ub + cgi * 8; bf16_t* __restrict__ dp = dbuf + cgi * 8;
            float sum[8];
#pragma unroll
            for (int i = 0; i < 8; ++i) sum[i] = 0.f;
            for (int i = 1; i <= w; ++i) { const int t = t0 - i; if (t >= 0) { float f[8]; unpack8(*(const u32x4*)(up + (size_t)t * 1024), f);
#pragma unroll
                for (int e = 0; e < 8; ++e) sum[e] += f[e]; } }
#pragma unroll
            for (int t = t0; t < t0 + 8; ++t) {
                float f[8]; unpack8(*(const u32x4*)(up + (size_t)t * 1024), f);
#pragma unroll
                for (int e = 0; e < 8; ++e) sum[e] += f[e];
                if (t - w >= 0) { float o[8]; unpack8(*(const u32x4*)(up + (size_t)(t - w) * 1024), o);
#pragma unroll
                    for (int e = 0; e < 8; ++e) sum[e] -= o[e]; }
                const float inv = 1.0f / (float)((t + 1) < w ? (t + 1) : w);
                u32x4 o4; o4.x = pk2(sum[0] * inv - f[0], sum[1] * inv - f[1]); o4.y = pk2(sum[2] * inv - f[2], sum[3] * inv - f[3]);
                o4.z = pk2(sum[4] * inv - f[4], sum[5] * inv - f[5]); o4.w = pk2(sum[6] * inv - f[6], sum[7] * inv - f[7]);
                *(u32x4*)(dp + (size_t)t * 1024) = o4;
            }
        }
        for (int rho = gw; rho < NUP; rho += NGW) {
            float s = 0.f;
#pragma unroll
            for (int j = 0; j < 4; ++j) { const int k0 = j * 512 + lane * 8; float f[8]; unpack8(*(const u32x4*)(Wut + (size_t)rho * 2048 + k0), f);
                const f32x4 s0 = *(const f32x4*)(modf + 3 * 2048 + k0), s1 = *(const f32x4*)(modf + 3 * 2048 + k0 + 4);
                s += (f[0] * s0[0] + f[1] * s0[1]) + (f[2] * s0[2] + f[3] * s0[3]) + (f[4] * s1[0] + f[5] * s1[1]) + (f[6] * s1[2] + f[7] * s1[3]); }
            s = wave_sum(s);
            if (lane == 0) biasup[rho] = s;
        }
    }
    xcd_barrier(xbar);
    RELOAD_IDS();

#endif
#if PHMASK & 16
    {
        RELOAD_IDS();
        __syncthreads();
        LAS int* pre = (LAS int*)(lds + LDS_TAB); LAS int* tmp = pre + 520;
        { const int n = 1 + (int)((cnt[tid] + 255u) >> 8); tmp[tid] = n; __syncthreads();
          for (int o = 1; o < 512; o <<= 1) { const int v = tmp[tid] + (tid >= o ? tmp[tid - o] : 0); __syncthreads(); tmp[tid] = v; __syncthreads(); }
          pre[tid + 1] = tmp[tid]; if (tid == 0) pre[0] = 0; __syncthreads(); }
        const int total = pre[512];
        int lane_ = lane; asm volatile("" : "+v"(lane_));
        const int r32 = lane_ & 31, hh = lane_ >> 5, i16 = lane_ & 15, qq = i16 >> 2, pp = i16 & 3, blk = (lane_ >> 4) & 1;
#define ATT_DECODE(UN, HJ, LI) do { int lo_ = 0, hi_ = 511; while (lo_ < hi_) { const int mid_ = (lo_ + hi_ + 1) >> 1; if (pre[mid_] <= (UN)) lo_ = mid_; else hi_ = mid_ - 1; } HJ = lo_; LI = (UN) - pre[lo_]; } while (0)
#define ATT_KVLOAD(HJ) do { const int h_ = (HJ) >> 6, j_ = (HJ) & 63; const bf16_t* kg = kb + (size_t)(j_ * 256) * 1024 + h_ * 128; const bf16_t* vg = vb + (size_t)(j_ * 256) * 1024 + h_ * 128; \
        _Pragma("unroll") for (int i = 0; i < 8; ++i) { const int idx = tid + NTHR * i, row = idx >> 4, c16 = idx & 15; \
            kreg[i] = *(const u32x4*)(kg + (size_t)row * 1024 + c16 * 8); vreg[i] = *(const u32x4*)(vg + (size_t)row * 1024 + c16 * 8); } } while (0)
#define ATT_ENT(HJ, LI, ENT, NL) do { NL = ((LI) == 0) ? 256 : (int)cnt[HJ] - ((LI) - 1) * 256; const int e_ = wave * 32 + r32; \
        if ((LI) == 0) ENT = (unsigned)(((HJ) & 63) * 256 + e_) * 4u + 3u; else ENT = qlist[(size_t)(HJ) * 16384 + (size_t)((LI) - 1) * 256 + (e_ < NL ? e_ : 0)]; } while (0)
        u32x4 kreg[8], vreg[8];
        int hj = 0, li = 0, nlist = 0; unsigned ent = 0u;
        if (bx < total) { ATT_DECODE(bx, hj, li); ATT_KVLOAD(hj); ATT_ENT(hj, li, ent, nlist); }
        for (int un = bx; un < total; un += G) {
            const int h = hj >> 6, j = hj & 63;
            const bool ownu = (li == 0);
            const int e = wave * 32 + r32;
            const bool valid = e < nlist;
            const int qi = (int)(ent >> 2), slot = (int)(ent & 3u);
            const bf16_t* qp = qb + (size_t)qi * 1024 + h * 128 + 8 * hh;
            bf16x8 qf[8];
#pragma unroll
            for (int ks = 0; ks < 8; ++ks) qf[ks] = *(const bf16x8*)(qp + 16 * ks);
            __syncthreads();
#pragma unroll
            for (int i = 0; i < 8; ++i) { const int idx = tid + NTHR * i, row = idx >> 4, c16 = idx & 15;
                *(LAS u32x4*)(lds + LDS_KS + row * KV_PITCH + c16 * 16) = kreg[i]; *(LAS u32x4*)(lds + LDS_VS + row * KV_PITCH + c16 * 16) = vreg[i]; }
            __syncthreads();
            int hj2, li2, nlist2; unsigned ent2;
            { const int unn = (un + G < total) ? un + G : un; ATT_DECODE(unn, hj2, li2); ATT_KVLOAD(hj2); ATT_ENT(hj2, li2, ent2, nlist2); }
            if (wave * 32 < nlist) {
                const int nq = ownu ? ((wave * 32 + 31) >> 6) + 1 : 4;
                f32x16 o[4];
#pragma unroll
                for (int dt = 0; dt < 4; ++dt)
#pragma unroll
                    for (int i = 0; i < 16; ++i) o[dt][i] = 0.f;
                float lacc = 0.f;
                const int qloc = e;
#pragma unroll 1
                for (int hf = 0; hf < nq; ++hf) {
                    f32x16 sa[2];
#pragma unroll
                    for (int i = 0; i < 16; ++i) { sa[0][i] = 0.f; sa[1][i] = 0.f; }
                    {
                        const LAS unsigned char* kp0 = lds + LDS_KS + (64 * hf + r32) * KV_PITCH + 16 * hh;
                        const LAS unsigned char* kp1 = kp0 + 32 * KV_PITCH;
                        bf16x8 a0 = *(const LAS bf16x8*)kp0, a1 = *(const LAS bf16x8*)kp1;
#pragma unroll
                        for (int ks = 0; ks < 8; ++ks) {
                            bf16x8 n0 = a0, n1 = a1;
                            if (ks < 7) { n0 = *(const LAS bf16x8*)(kp0 + 32 * (ks + 1)); n1 = *(const LAS bf16x8*)(kp1 + 32 * (ks + 1)); }
                            sa[0] = __builtin_amdgcn_mfma_f32_32x32x16_bf16(a0, qf[ks], sa[0], 0, 0, 0);
                            sa[1] = __builtin_amdgcn_mfma_f32_32x32x16_bf16(a1, qf[ks], sa[1], 0, 0, 0);
                            a0 = n0; a1 = n1;
                        }
                    }
                    if (ownu) {
#pragma unroll
                        for (int kt = 0; kt < 2; ++kt)
#pragma unroll
                            for (int i = 0; i < 16; ++i) { const int key = 64 * hf + 32 * kt + (i & 3) + 8 * (i >> 2) + 4 * hh;
                                float pv = __builtin_amdgcn_exp2f(sa[kt][i]); if (key > qloc) pv = 0.f; sa[kt][i] = pv; lacc += pv; }
                    } else {
#pragma unroll
                        for (int kt = 0; kt < 2; ++kt)
#pragma unroll
                            for (int i = 0; i < 16; ++i) { const float pv = __builtin_amdgcn_exp2f(sa[kt][i]); sa[kt][i] = pv; lacc += pv; }
                    }
                    bf16x8 pb[4];
#pragma unroll
                    for (int st = 0; st < 4; ++st) { const int kt = st >> 1, s2 = st & 1;
                        u32x4 pw; pw.x = pk2(sa[kt][8 * s2 + 0], sa[kt][8 * s2 + 1]); pw.y = pk2(sa[kt][8 * s2 + 2], sa[kt][8 * s2 + 3]);
                        pw.z = pk2(sa[kt][8 * s2 + 4], sa[kt][8 * s2 + 5]); pw.w = pk2(sa[kt][8 * s2 + 6], sa[kt][8 * s2 + 7]);
                        pb[st] = __builtin_bit_cast(bf16x8, pw); }
                    const LAS unsigned char* vp = lds + LDS_VS + (64 * hf + 4 * hh + qq) * KV_PITCH + 32 * blk + 8 * pp;
                    s16x4 cl[4], ch[4];
#pragma unroll
                    for (int dt = 0; dt < 4; ++dt) { cl[dt] = vtr(vp + 64 * dt); ch[dt] = vtr(vp + 8 * KV_PITCH + 64 * dt); }
#pragma unroll
                    for (int st = 0; st < 4; ++st) {
                        s16x4 nl[4], nh[4];
#pragma unroll
                        for (int dt = 0; dt < 4; ++dt) { nl[dt] = cl[dt]; nh[dt] = ch[dt]; }
                        if (st < 3) { const LAS unsigned char* vn = vp + 16 * (st + 1) * KV_PITCH;
#pragma unroll
                            for (int dt = 0; dt < 4; ++dt) { nl[dt] = vtr(vn + 64 * dt); nh[dt] = vtr(vn + 8 * KV_PITCH + 64 * dt); } }
#pragma unroll
                        for (int dt = 0; dt < 4; ++dt) { const bf16x8 vf = __builtin_shufflevector(cl[dt], ch[dt], 0, 1, 2, 3, 4, 5, 6, 7);
                            o[dt] = __builtin_amdgcn_mfma_f32_32x32x16_bf16(vf, pb[st], o[dt], 0, 0, 0); }
#pragma unroll
                        for (int dt = 0; dt < 4; ++dt) { cl[dt] = nl[dt]; ch[dt] = nh[dt]; }
                    }
                }
                lacc += __shfl_xor(lacc, 32);
                u32x4 ow[8];
#pragma unroll
                for (int dt = 0; dt < 4; ++dt)
#pragma unroll
                    for (int gp2 = 0; gp2 < 2; ++gp2) { const int g0 = 2 * gp2, g1 = g0 + 1;
                        unsigned ax = pk2(o[dt][4 * g0], o[dt][4 * g0 + 1]), ay = pk2(o[dt][4 * g0 + 2], o[dt][4 * g0 + 3]);
                        unsigned bxw = pk2(o[dt][4 * g1], o[dt][4 * g1 + 1]), by = pk2(o[dt][4 * g1 + 2], o[dt][4 * g1 + 3]);
                        { const auto rsw = __builtin_amdgcn_permlane32_swap(ax, bxw, false, false); ax = rsw[0]; bxw = rsw[1]; }
                        { const auto rsw = __builtin_amdgcn_permlane32_swap(ay, by, false, false); ay = rsw[0]; by = rsw[1]; }
                        ow[dt * 2 + gp2] = (u32x4){ax, ay, bxw, by}; }
                if (valid) {
                    bf16_t* op = slots + ((size_t)qi * 4 + slot) * 1024 + h * 128 + 8 * hh;
#pragma unroll
                    for (int dt = 0; dt < 4; ++dt)
#pragma unroll
                        for (int gp2 = 0; gp2 < 2; ++gp2) *(u32x4*)(op + 32 * dt + 16 * gp2) = ow[dt * 2 + gp2];
                    if (hh == 0) lsum[((size_t)qi * 4 + slot) * 8 + h] = lacc;
                }
            }
            hj = hj2; li = li2; ent = ent2; nlist = nlist2;
        }
        RELOAD_IDS();
        for (int base = vcu * 8; base < 2048; base += G * 8) {
            const int gI = base >> 9;
            __syncthreads();
#pragma unroll
            for (int i = 0; i < 16; ++i) { const int idx = tid + NTHR * i, row = idx >> 5, c16 = idx & 31;
                *(LAS u32x4*)(lds + row * 528 + c16 * 16) = *(const u32x4*)(Wgt + (size_t)(gI * 256 + row) * 1024 + c16 * 8); }
            __syncthreads();
            const int item = base + wave, s0 = (item & 511) * 32, r = lane & 31, hh = lane >> 5;
            bf16x8 af[16];
            const bf16_t* ap = dbuf + (size_t)(s0 + r) * 1024 + gI * 256 + 8 * hh;
#pragma unroll
            for (int ks = 0; ks < 16; ++ks) af[ks] = *(const bf16x8*)(ap + 16 * ks);
#pragma unroll 1
            for (int nt = 0; nt < 8; nt += 2) {
                f32x16 ac[2];
#pragma unroll
                for (int i = 0; i < 16; ++i) { ac[0][i] = 0.f; ac[1][i] = 0.f; }
                const LAS unsigned char* bp = lds + (nt * 32 + r) * 528 + 16 * hh;
#pragma unroll
                for (int ks = 0; ks < 16; ++ks) { const bf16x8 b0 = *(const LAS bf16x8*)(bp + 32 * ks), b1 = *(const LAS bf16x8*)(bp + 32 * 528 + 32 * ks);
                    ac[0] = __builtin_amdgcn_mfma_f32_32x32x16_bf16(b0, af[ks], ac[0], 0, 0, 0); ac[1] = __builtin_amdgcn_mfma_f32_32x32x16_bf16(b1, af[ks], ac[1], 0, 0, 0); }
                f32x4 lsv[2][4];
#pragma unroll
                for (int t2 = 0; t2 < 2; ++t2)
#pragma unroll
                    for (int q4 = 0; q4 < 4; ++q4) lsv[t2][q4] = *(const f32x4*)(pscale + gI * 256 + (nt + t2) * 32 + 8 * q4 + 4 * hh);
#pragma unroll
                for (int t2 = 0; t2 < 2; ++t2) {
                    bf16_t* op = am + (size_t)(s0 + r) * 2048 + 1024 + gI * 256 + (nt + t2) * 32 + 4 * hh;
#pragma unroll
                    for (int q4 = 0; q4 < 4; ++q4) { const f32x4 lv = lsv[t2][q4];
                        u32x2 w; w.x = pk2(ac[t2][4 * q4] * lv[0], ac[t2][4 * q4 + 1] * lv[1]); w.y = pk2(ac[t2][4 * q4 + 2] * lv[2], ac[t2][4 * q4 + 3] * lv[3]); *(u32x2*)(op + 8 * q4) = w; }
                }
            }
        }
    }
    xcd_barrier(xbar);
    RELOAD_IDS();

#endif
#if PHMASK & 32
    {
    }
    RELOAD_IDS();
#pragma unroll 2
    for (int idx = vcu * NTHR + tid; idx < S * 128; idx += G * NTHR) {
        const int qi = idx >> 7, c8 = idx & 127, h = c8 >> 4, own = qi >> 8, ns = own < 3 ? own : 3;
        float a[8]; float l = 0.f;
#pragma unroll
        for (int i = 0; i < 8; ++i) a[i] = 0.f;
#pragma unroll
        for (int s = 0; s < 4; ++s) if (s == 3 || s < ns) { float f[8]; unpack8(*(const u32x4*)(slots + ((size_t)qi * 4 + s) * 1024 + c8 * 8), f);
#pragma unroll
            for (int i = 0; i < 8; ++i) a[i] += f[i];
            l += lsum[((size_t)qi * 4 + s) * 8 + h]; }
        const float inv = 1.0f / l;
        u32x4 w; w.x = pk2(a[0] * inv, a[1] * inv); w.y = pk2(a[2] * inv, a[3] * inv); w.z = pk2(a[4] * inv, a[5] * inv); w.w = pk2(a[6] * inv, a[7] * inv);
        *(u32x4*)(am + (size_t)qi * 2048 + c8 * 8) = w;
    }
    xcd_barrier(xbar);
    RELOAD_IDS();

#endif
#if PHMASK & 64
    { pg8::Gemm g{am, Wyt, 2048, 2048, 1024}; pg8::Sched<1> Sc; Sc.init(S, 2048, G, bx); Epi5 E{gates, merged}; pg8::gemm_phase<Epi5>(lds, g, Sc, E); }
    xcd_barrier(xbar);
    RELOAD_IDS();

#endif
#if PHMASK & 128
    { pg8::Gemm g{merged, Wot, 2048, 2048, 2048}; pg8::Sched<0> Sc; Sc.init(S, 2048, G, bx); Epi6 E{xin, outp, xg, modf, nfg, rowss}; pg8::gemm_phase<Epi6>(lds, g, Sc, E); }
    xcd_barrier(xbar);
    RELOAD_IDS();

#endif
#if PHMASK & 256
    for (int row = vcu * NTHR + tid; row < S; row += G * NTHR) { const f32x4* pr = (const f32x4*)(rowss + (size_t)row * 32); f32x4 sm = pr[0];
#pragma unroll
        for (int j = 1; j < 8; ++j) sm += pr[j];
        rsb[row] = __builtin_amdgcn_rsqf(((sm[0] + sm[1]) + (sm[2] + sm[3])) * (1.0f / 2048.0f) + EPS); }
    xcd_barrier(xbar);
    RELOAD_IDS();
    { pg8::Gemm g{xg, Wut, 2048, 2048, 2048}; pg8::Sched<0> Sc; Sc.init(S, NUP, G, bx); Epi7 E{rsb, biasup, conv_w, conv_b, act, edge}; pg8::gemm_phase_drain<Epi7>(lds, g, Sc, E); }
    xcd_barrier(xbar);
    RELOAD_IDS();

#endif
#if PHMASK & 512
    {
        pg8::Sched<0> Sf; Sf.init(S, 2048, G, bx);
        int lastpm = -1;
        for (int ui = 0;; ++ui) {
            Unit uf; if (!Sf.next(ui, uf)) break;
            const int tl = uf.pm; if (tl == lastpm) continue; lastpm = tl;
            for (int idx = tid; idx < DFF / 4; idx += NTHR) {
                const int c = idx * 4;
                f32x4 r0[2], r1[2];
#pragma unroll
                for (int bj = 0; bj < 2; ++bj) {
                    const int lc = bj * DFF + c;
                    const f32x4 z = (f32x4){0.f, 0.f, 0.f, 0.f};
                    const f32x4 pm2 = tl > 0 ? *(const f32x4*)(edge + ((size_t)((tl - 1) * 4 + 2)) * NUP + lc) : z;
                    const f32x4 pm1 = tl > 0 ? *(const f32x4*)(edge + ((size_t)((tl - 1) * 4 + 3)) * NUP + lc) : z;
                    const f32x4 e0 = *(const f32x4*)(edge + ((size_t)(tl * 4 + 0)) * NUP + lc), e1 = *(const f32x4*)(edge + ((size_t)(tl * 4 + 1)) * NUP + lc);
                    const f32x4 w0 = *(const f32x4*)(conv_w + lc), w1 = *(const f32x4*)(conv_w + NUP + lc), w2 = *(const f32x4*)(conv_w + 2 * NUP + lc), cbv = *(const f32x4*)(conv_b + lc);
                    r0[bj] = cbv + w0 * pm2 + w1 * pm1 + w2 * e0;
                    r1[bj] = cbv + w0 * pm1 + w1 * e0 + w2 * e1;
                }
                u32x2 o0, o1; float t0[4], t1[4];
#pragma unroll
                for (int i = 0; i < 4; ++i) { t0[i] = r0[0][i] * sigmoidf_(r0[0][i]) * r0[1][i]; t1[i] = r1[0][i] * sigmoidf_(r1[0][i]) * r1[1][i]; }
                o0.x = pk2(t0[0], t0[1]); o0.y = pk2(t0[2], t0[3]); o1.x = pk2(t1[0], t1[1]); o1.y = pk2(t1[2], t1[3]);
                *(u32x2*)(act + (size_t)(tl * 256) * DFF + c) = o0; *(u32x2*)(act + (size_t)(tl * 256 + 1) * DFF + c) = o1;
            }
        }
        asm volatile("s_waitcnt vmcnt(0)" ::: "memory");
        __syncthreads();
        RELOAD_IDS();
    }
    { pg8::Gemm g{act, Wdt, DFF, DFF, DFF}; pg8::Sched<0> Sc; Sc.init(S, 2048, G, bx); Epi9 E{outp, modf}; pg8::gemm_phase<Epi9>(lds, g, Sc, E); }
#endif
}

extern "C" void kernel_launch(void* const* d_in, const int* in_sizes, int n_in, void* d_out, int out_size, void* d_ws, size_t ws_size, hipStream_t stream) {
    static int grid_blocks = 0;
    if (grid_blocks == 0) {
        if (n_in != 20 || out_size != S * DM || ws_size < WS_END) { fprintf(stderr, "kernel_launch: unexpected shapes (n_in %d out %d ws %zu)\n", n_in, out_size, ws_size); grid_blocks = -1; return; }
        int dev = 0, cus = 0, per_cu = 0;
        hipGetDevice(&dev);
        hipDeviceGetAttribute(&cus, hipDeviceAttributeMultiprocessorCount, dev);
        hipFuncSetAttribute((const void*)fwd_megakernel, hipFuncAttributeMaxDynamicSharedMemorySize, LDS_BYTES);
        hipOccupancyMaxActiveBlocksPerMultiprocessor(&per_cu, (const void*)fwd_megakernel, NTHR, LDS_BYTES);
        if (per_cu < 1) { fprintf(stderr, "kernel_launch: occupancy query reports %d blocks per CU\n", per_cu); grid_blocks = -1; return; }
        if (per_cu > 1) per_cu = 1;
        grid_blocks = cus * per_cu;
        if (grid_blocks > 256) grid_blocks = 256;
    }
    if (grid_blocks < 0) return;
    Params p{};
    for (int i = 0; i < 20; ++i) p.in[i] = (const float*)d_in[i];
    p.out = (float*)d_out; p.ws = (unsigned char*)d_ws;
    void* args[] = {&p};
    hipError_t e = hipLaunchCooperativeKernel((const void*)fwd_megakernel, dim3(grid_blocks), dim3(NTHR), args, LDS_BYTES, stream);
    if (e != hipSuccess) fprintf(stderr, "cooperative launch failed: %s (grid %d)\n", hipGetErrorString(e), grid_blocks);
}
```

```cpp
#include <hip/hip_runtime.h>
#include <hip/hip_cooperative_groups.h>
#include <cstdio>
#include <cstdint>
namespace cg = cooperative_groups;

#define LAS __attribute__((address_space(3)))
#define DI __device__ __forceinline__
typedef unsigned short bf16_t;
typedef short bf16x8 __attribute__((ext_vector_type(8)));
typedef short s16x4 __attribute__((ext_vector_type(4)));
typedef float f32x2 __attribute__((ext_vector_type(2)));
typedef float f32x4 __attribute__((ext_vector_type(4)));
typedef float f32x16 __attribute__((ext_vector_type(16)));
typedef unsigned u32x2 __attribute__((ext_vector_type(2)));
typedef unsigned u32x4 __attribute__((ext_vector_type(4)));
typedef __bf16 bf16x2_t __attribute__((ext_vector_type(2)));

constexpr int S = 16384, DM = 2048, NH = 8, HD = 128, AW = 1024, PW = 1024, DFF = 5632, NUP = 2 * DFF, N1 = 8192;
constexpr float EPS = 1e-6f;
constexpr int NWAVES = 8, NTHR = 512;
constexpr int LDS_BYTES = 147456;
constexpr int XL_OFF = 131072;

constexpr size_t MiB = 1u << 20;
constexpr size_t WS_ZERO = 0, ZERO_BYTES = 1 * MiB;
constexpr size_t WS_CNT = 0, WS_KMEAN = 65536, WS_BAR = 524288;
constexpr size_t WS_MODP = 1 * MiB;
constexpr size_t WS_MODF = 2 * MiB;
constexpr size_t WS_BIASUP = 2 * MiB + 65536;
constexpr size_t WS_ROWSS = 3 * MiB;
constexpr size_t WS_LSUM = 5 * MiB;
constexpr size_t WS_LIST = 8 * MiB;
constexpr size_t WS_W1 = 40 * MiB;
constexpr size_t WS_WY = 72 * MiB;
constexpr size_t WS_WO = 80 * MiB;
constexpr size_t WS_WG = 88 * MiB;
constexpr size_t WS_WD = 90 * MiB;
constexpr size_t WS_WU = 112 * MiB;
constexpr size_t WS_HB = 156 * MiB;
constexpr size_t WS_Q = 220 * MiB, WS_K = 252 * MiB, WS_V = 284 * MiB, WS_U = 316 * MiB;
constexpr size_t WS_GATES = 348 * MiB;
constexpr size_t WS_DB = 476 * MiB;
constexpr size_t WS_AM = WS_HB;
constexpr size_t WS_MERGED = 284 * MiB;
constexpr size_t WS_XG = WS_HB;
constexpr size_t WS_ACT = 220 * MiB;
constexpr size_t WS_EDGE = 400 * MiB;
constexpr size_t WS_END = 508 * MiB;

__constant__ double ROPE_C[64] = {
1.59154943091895346e-01, 1.37822502603982849e-01, 1.19349370211248862e-01, 1.03352296618434064e-01,
8.94994016088910133e-02, 7.75032887553740585e-02, 6.71150830052272551e-02, 5.81192674418762462e-02,
5.03292121044870353e-02, 4.35833021053073297e-02, 3.77415847174197711e-02, 3.26828658723569976e-02,
2.83022014470915797e-02, 2.45087088680224316e-02, 2.12236869570126724e-02, 1.83789788427912383e-02,
1.59154943091895346e-02, 1.37822502603982859e-02, 1.19349370211248869e-02, 1.03352296618434061e-02,
8.94994016088910168e-03, 7.75032887553740620e-03, 6.71150830052272551e-03, 5.81192674418762497e-03,
5.03292121044870353e-03, 4.35833021053073314e-03, 3.77415847174197694e-03, 3.26828658723569993e-03,
2.83022014470915797e-03, 2.45087088680224316e-03, 2.12236869570126715e-03, 1.83789788427912387e-03,
1.59154943091895346e-03, 1.37822502603982855e-03, 1.19349370211248860e-03, 1.03352296618434065e-03,
8.94994016088910125e-04, 7.75032887553740577e-04, 6.71150830052272594e-04, 5.81192674418762454e-04,
5.03292121044870353e-04, 4.35833021053073336e-04, 3.77415847174197716e-04, 3.26828658723569971e-04,
2.83022014470915775e-04, 2.45087088680224327e-04, 2.12236869570126726e-04, 1.83789788427912376e-04,
1.59154943091895335e-04, 1.37822502603982850e-04, 1.19349370211248865e-04, 1.03352296618434062e-04,
8.94994016088910179e-05, 7.75032887553740523e-05, 6.71150830052272540e-05, 5.81192674418762481e-05,
5.03292121044870380e-05, 4.35833021053073309e-05, 3.77415847174197689e-05, 3.26828658723569984e-05,
2.83022014470915789e-05, 2.45087088680224307e-05, 2.12236869570126719e-05, 1.83789788427912390e-05 };

DI unsigned pk2(float lo, float hi) { f32x2 v = {lo, hi}; bf16x2_t b = __builtin_convertvector(v, bf16x2_t); return __builtin_bit_cast(unsigned, b); }
DI float bflo(unsigned w) { return __uint_as_float(w << 16); }
DI float bfhi(unsigned w) { return __uint_as_float(w & 0xffff0000u); }
DI void unpack8(const u32x4 w, float* f) { f[0] = bflo(w.x); f[1] = bfhi(w.x); f[2] = bflo(w.y); f[3] = bfhi(w.y); f[4] = bflo(w.z); f[5] = bfhi(w.z); f[6] = bflo(w.w); f[7] = bfhi(w.w); }
DI u32x4 pack8(const f32x4 a, const f32x4 b) { u32x4 w; w.x = pk2(a[0], a[1]); w.y = pk2(a[2], a[3]); w.z = pk2(b[0], b[1]); w.w = pk2(b[2], b[3]); return w; }
DI float wave_sum(float v) {
#pragma unroll
    for (int o = 1; o < 64; o <<= 1) v += __shfl_xor(v, o);
    return v;
}
DI float sigmoidf_(float x) { return __builtin_amdgcn_rcpf(1.0f + __builtin_amdgcn_exp2f(x * -1.4426950408889634f)); }
#define LDS_WAIT() asm volatile("s_waitcnt lgkmcnt(0)" ::: "memory")
#define FENCE() do { asm volatile("" ::: "memory"); __builtin_amdgcn_sched_barrier(0); } while (0)
#define TIE(var, dep) asm volatile("" : "+v"(var) : "v"(dep))
#define RAW_BAR() do { asm volatile("s_waitcnt lgkmcnt(0)" ::: "memory"); __builtin_amdgcn_s_barrier(); asm volatile("" ::: "memory"); } while (0)

#ifndef PG8_USE_SP2
#define PG8_USE_SP2 1
#endif
namespace pg8 {
constexpr int BM = 256, BK = 64, HALF = 128, HTB = HALF * BK * 2, STAGE_BYTES = 8 * HTB, NXCD = 8, WGM = 8;
__host__ __device__ __forceinline__ int lds_byte(int r, int c) { const int st = (r >> 4) * 2 + (c >> 5), rr = r & 15, cc = c & 31, ob = rr * 64 + cc * 2; return st * 1024 + (ob ^ (((ob >> 9) & 1) << 5)); }
__host__ __device__ __forceinline__ void stage_rc(int b, int& R, int& C) { const int st = b / 1024, sb = b % 1024, swz = sb ^ (((sb >> 9) & 1) << 5); R = (st >> 1) * 16 + swz / 64; C = (st & 1) * 32 + (swz % 64) / 2; }
__host__ __device__ __forceinline__ int perm32(int rho) { const int n = rho >> 4, i = rho & 15; return 8 * (i >> 2) + 4 * n + (i & 3); }

struct Unit { int pm, pn, ka, kb, aux; };
struct Gemm { const bf16_t* A; const bf16_t* Bt; int lda, ldb, K; };

template <int mode> struct Sched {
    int nM, nN, nwg, G, c;
    __device__ void init(int M, int N, int G_, int c_) { nM = M / BM; nN = N / BM; nwg = nM * nN; G = G_; c = c_; }
    __device__ bool next(int i, Unit& u) const {
        const int ii = (mode == 1) ? (i >> 1) : i;
        const long L = (long)ii * G + c; if (L >= nwg) return false;
        int wgid = (int)L; { const int q = nwg / NXCD, r = nwg % NXCD, xcd = wgid % NXCD, off = wgid / NXCD; wgid = (xcd < r ? xcd * (q + 1) : r * (q + 1) + (xcd - r) * q) + off; }
        const int nig = WGM * nN, gid = wgid / nig, fm = gid * WGM, gsz = (nM - fm) < WGM ? (nM - fm) : WGM;
        u.pm = fm + ((wgid % nig) % gsz); u.pn = (wgid % nig) / gsz;
        u.aux = (mode == 1) ? (i & 1) : 0; u.ka = (mode == 1) ? 1024 * (i & 1) : ((mode == 2) ? 256 * u.pn : 0); u.kb = (mode == 1) ? 1024 * (i & 1) : 0;
        return true;
    }
};

template <class Epi, class SchedT>
DI void gemm_phase(LAS unsigned char* lds, const Gemm g, const SchedT& S, const Epi& E) {
    int tid_ = threadIdx.x; asm volatile("" : "+v"(tid_));
    const int tid = tid_, wid = __builtin_amdgcn_readfirstlane(tid >> 6), lane = tid & 63, wr = wid >> 2, wc = wid & 3, fr = lane & 15, fq = lane >> 4;
    const int nt = g.K / BK;
    unsigned voffA, voffB;
    { int R, C; stage_rc(tid * 16, R, C); const int Rb = (R & ~31) + perm32(R & 31);
      voffA = (unsigned)(R * g.lda + C) * 2u; voffB = (unsigned)(Rb * g.ldb + C) * 2u; }
    const size_t dvoffA = (size_t)64 * g.lda * 2, dvoffB = (size_t)64 * g.ldb * 2;
    const size_t kstep = (size_t)(BK * 2);
    const size_t hstepA = (size_t)HALF * g.lda * 2, hstepB = (size_t)HALF * g.ldb * 2;
    const size_t tstepA = 2 * hstepA, tstepB = 2 * hstepB;
    const unsigned ldsw = (unsigned)wid * 1024u;
    const int aoff = lds_byte(wr * 64 + fr, fq * 8), boff = lds_byte(wc * 32 + fr, fq * 8);
#define PG8_SA(b, h) (((b) * 2 + (h)) * HTB)
#define PG8_SB(b, h) ((4 + (b) * 2 + (h)) * HTB)
#define PG8_STAGE(bufoff, gbase, voff) do { _Pragma("unroll") for (int _i = 0; _i < 2; ++_i) \
        __builtin_amdgcn_global_load_lds((const unsigned*)((const char*)(gbase) + (size_t)_i * d##voff + (voff)), (LAS unsigned*)(lds + (bufoff) + ldsw + _i * 8192), 16, 0, 0); } while (0)
#define PG8_LDA(dst, b, h) do { _Pragma("unroll") for (int m = 0; m < 4; ++m) _Pragma("unroll") for (int k = 0; k < 2; ++k) dst[m][k] = *(const LAS bf16x8*)(lds + PG8_SA(b, h) + aoff + m * 2048 + k * 1024); } while (0)
#define PG8_LDB(dst, b, h) do { _Pragma("unroll") for (int n = 0; n < 2; ++n) _Pragma("unroll") for (int k = 0; k < 2; ++k) dst[n][k] = *(const LAS bf16x8*)(lds + PG8_SB(b, h) + boff + n * 2048 + k * 1024); } while (0)
#define PG8_MMA(ai, bj, At, Bt) do { __builtin_amdgcn_s_setprio(1); _Pragma("unroll") for (int m = 0; m < 4; ++m) _Pragma("unroll") for (int n = 0; n < 2; ++n) _Pragma("unroll") for (int k = 0; k < 2; ++k) \
        acc[ai][bj][m][n] = __builtin_amdgcn_mfma_f32_16x16x32_bf16(Bt[n][k], At[m][k], acc[ai][bj][m][n], 0, 0, 0); __builtin_amdgcn_s_setprio(0); } while (0)
#define PG8_WAIT_V(n) asm volatile("s_waitcnt vmcnt(" #n ")" ::: "memory")
#define PG8_WAIT_L(n) asm volatile("s_waitcnt lgkmcnt(" #n ")" ::: "memory")
#define PG8_BAR __builtin_amdgcn_s_barrier()
#define PG8_SCHED __builtin_amdgcn_sched_barrier(0)
    Unit cur, nxt; int ui = 0;
    if (!S.next(0, cur)) return;
    f32x4 acc[2][2][4][2];
#pragma unroll
    for (int a = 0; a < 2; ++a)
#pragma unroll
        for (int b = 0; b < 2; ++b)
#pragma unroll
            for (int m = 0; m < 4; ++m)
#pragma unroll
                for (int n = 0; n < 2; ++n) acc[a][b][m][n] = (f32x4){0.f, 0.f, 0.f, 0.f};
    bf16x8 At[4][2], B0[2][2], B1[2][2];
    const char* cA = (const char*)g.A + (size_t)cur.pm * tstepA + (size_t)cur.ka * 2; const char* cB = (const char*)g.Bt + (size_t)cur.pn * tstepB + (size_t)cur.kb * 2;
#if PG8_USE_SP2
    PG8_STAGE(PG8_SB(0, 0), cB, voffB); PG8_STAGE(PG8_SB(0, 1), cB + hstepB, voffB); PG8_STAGE(PG8_SA(0, 0), cA, voffA); PG8_STAGE(PG8_SA(0, 1), cA + hstepA, voffA);
    if (wr == 1) PG8_BAR;
    PG8_WAIT_V(2); PG8_BAR;
#else
    PG8_STAGE(PG8_SB(0, 0), cB, voffB); PG8_STAGE(PG8_SA(0, 0), cA, voffA); PG8_STAGE(PG8_SB(0, 1), cB + hstepB, voffB); PG8_STAGE(PG8_SA(0, 1), cA + hstepA, voffA);
    if (wr == 1) PG8_BAR;
    PG8_WAIT_V(4); PG8_BAR;
#endif
    PG8_STAGE(PG8_SB(1, 0), cB + kstep, voffB); PG8_STAGE(PG8_SA(1, 0), cA + kstep, voffA); PG8_STAGE(PG8_SB(1, 1), cB + hstepB + kstep, voffB);
    PG8_WAIT_V(6); PG8_BAR;
    for (;;) {
        const bool has_next = S.next(ui + 1, nxt);
        const char* nA = has_next ? (const char*)g.A + (size_t)nxt.pm * tstepA + (size_t)nxt.ka * 2 : cA; const char* nB = has_next ? (const char*)g.Bt + (size_t)nxt.pn * tstepB + (size_t)nxt.kb * 2 : cB;
        for (int t = 0; t < nt; t += 2) {
            const bool last = (t == nt - 2);
            const char* a1 = cA + (size_t)(t + 1) * kstep;
            const char* a2 = last ? nA : cA + (size_t)(t + 2) * kstep; const char* b2 = last ? nB : cB + (size_t)(t + 2) * kstep;
            const char* a3 = a2 + kstep; const char* b3 = b2 + kstep;
#if PG8_USE_SP2
            PG8_LDB(B0, 0, 0); PG8_LDB(B1, 0, 1); PG8_SCHED; PG8_LDA(At, 0, 0); PG8_STAGE(PG8_SA(1, 1), a1 + hstepA, voffA);
            PG8_WAIT_V(8); PG8_WAIT_L(0); PG8_BAR; PG8_MMA(0, 0, At, B0); PG8_MMA(0, 1, At, B1); PG8_BAR; PG8_SCHED;
            PG8_LDA(At, 0, 1); PG8_STAGE(PG8_SB(0, 0), b2, voffB); PG8_STAGE(PG8_SB(0, 1), b2 + hstepB, voffB); PG8_STAGE(PG8_SA(0, 0), a2, voffA);
            PG8_WAIT_V(8); PG8_WAIT_L(0); PG8_BAR; PG8_MMA(1, 0, At, B0); PG8_MMA(1, 1, At, B1); PG8_BAR; PG8_SCHED;
            PG8_LDB(B0, 1, 0); PG8_LDB(B1, 1, 1); PG8_SCHED; PG8_LDA(At, 1, 0); PG8_STAGE(PG8_SA(0, 1), a2 + hstepA, voffA);
            PG8_WAIT_V(8); PG8_WAIT_L(0); PG8_BAR; PG8_MMA(0, 0, At, B0); PG8_MMA(0, 1, At, B1); PG8_BAR; PG8_SCHED;
            PG8_LDA(At, 1, 1); PG8_STAGE(PG8_SB(1, 0), b3, voffB); PG8_STAGE(PG8_SB(1, 1), b3 + hstepB, voffB); PG8_STAGE(PG8_SA(1, 0), a3, voffA);
            PG8_WAIT_V(8); PG8_WAIT_L(0); PG8_BAR; PG8_MMA(1, 0, At, B0); PG8_MMA(1, 1, At, B1); PG8_BAR; PG8_SCHED;
#else
            PG8_LDB(B0, 0, 0); PG8_SCHED; PG8_LDA(At, 0, 0); PG8_STAGE(PG8_SA(1, 1), a1 + hstepA, voffA);
            PG8_WAIT_L(8); PG8_BAR; PG8_WAIT_L(0); PG8_MMA(0, 0, At, B0); PG8_BAR; PG8_SCHED;
            PG8_LDB(B1, 0, 1); PG8_STAGE(PG8_SB(0, 0), b2, voffB);
            PG8_BAR; PG8_WAIT_L(0); PG8_MMA(0, 1, At, B1); PG8_BAR;
            PG8_LDA(At, 0, 1); PG8_STAGE(PG8_SA(0, 0), a2, voffA);
            PG8_BAR; PG8_WAIT_L(0); PG8_MMA(1, 0, At, B0); PG8_BAR; PG8_SCHED;
            PG8_STAGE(PG8_SB(0, 1), b2 + hstepB, voffB);
            PG8_WAIT_V(6); PG8_BAR; PG8_MMA(1, 1, At, B1); PG8_BAR;
            PG8_LDB(B0, 1, 0); PG8_SCHED; PG8_LDA(At, 1, 0); PG8_STAGE(PG8_SA(0, 1), a2 + hstepA, voffA);
            PG8_WAIT_L(8); PG8_BAR; PG8_WAIT_L(0); PG8_MMA(0, 0, At, B0); PG8_BAR; PG8_SCHED;
            PG8_LDB(B1, 1, 1); PG8_STAGE(PG8_SB(1, 0), b3, voffB);
            PG8_BAR; PG8_WAIT_L(0); PG8_MMA(0, 1, At, B1); PG8_BAR;
            PG8_LDA(At, 1, 1); PG8_STAGE(PG8_SA(1, 0), a3, voffA);
            PG8_BAR; PG8_WAIT_L(0); PG8_MMA(1, 0, At, B0); PG8_BAR; PG8_SCHED;
            PG8_STAGE(PG8_SB(1, 1), b3 + hstepB, voffB);
            PG8_WAIT_V(6); PG8_BAR; PG8_MMA(1, 1, At, B1); PG8_BAR;
#endif
        }
        if (wr == 0) PG8_BAR;
        { int l2 = threadIdx.x; asm volatile("" : "+v"(l2)); l2 &= 63;
          E(acc, cur, wr, wc, l2 & 15, l2 >> 4, lds + XL_OFF); }
        if (!has_next) break;
        if (!(Epi::CHAIN && cur.aux == 0)) {
#pragma unroll
            for (int a = 0; a < 2; ++a)
#pragma unroll
                for (int b = 0; b < 2; ++b)
#pragma unroll
                    for (int m = 0; m < 4; ++m)
#pragma unroll
                        for (int n = 0; n < 2; ++n) acc[a][b][m][n] = (f32x4){0.f, 0.f, 0.f, 0.f};
        }
        cur = nxt; cA = nA; cB = nB; ++ui;
        if (wr == 1) PG8_BAR;
    }
    PG8_WAIT_V(0);
    PG8_BAR;
}

template <class Epi, class SchedT>
DI void gemm_phase_drain(LAS unsigned char* lds, const Gemm g, const SchedT& S, const Epi& E) {
    int tid_ = threadIdx.x; asm volatile("" : "+v"(tid_));
    const int tid = tid_, wid = __builtin_amdgcn_readfirstlane(tid >> 6), lane = tid & 63, wr = wid >> 2, wc = wid & 3, fr = lane & 15, fq = lane >> 4;
    const int nt = g.K / BK;
    unsigned voffA, voffB;
    { int R, C; stage_rc(tid * 16, R, C); const int Rb = (R & ~31) + perm32(R & 31);
      voffA = (unsigned)(R * g.lda + C) * 2u; voffB = (unsigned)(Rb * g.ldb + C) * 2u; }
    const size_t dvoffA = (size_t)64 * g.lda * 2, dvoffB = (size_t)64 * g.ldb * 2;
    const size_t kstep = (size_t)(BK * 2);
    const size_t hstepA = (size_t)HALF * g.lda * 2, hstepB = (size_t)HALF * g.ldb * 2;
    const size_t tstepA = 2 * hstepA, tstepB = 2 * hstepB;
    const unsigned ldsw = (unsigned)wid * 1024u;
    const int aoff = lds_byte(wr * 64 + fr, fq * 8), boff = lds_byte(wc * 32 + fr, fq * 8);
    bool primed = false; Unit cur, nxt;
    bool have = S.next(0, cur);
    for (int ui = 0; have; ++ui) {
        f32x4 acc[2][2][4][2];
#pragma unroll
        for (int a = 0; a < 2; ++a)
#pragma unroll
            for (int b = 0; b < 2; ++b)
#pragma unroll
                for (int m = 0; m < 4; ++m)
#pragma unroll
                    for (int n = 0; n < 2; ++n) acc[a][b][m][n] = (f32x4){0.f, 0.f, 0.f, 0.f};
        bf16x8 At[4][2], B0[2][2], B1[2][2];
        const char* cA = (const char*)g.A + (size_t)cur.pm * tstepA + (size_t)cur.ka * 2; const char* cB = (const char*)g.Bt + (size_t)cur.pn * tstepB + (size_t)cur.kb * 2;
        if (!primed) {
#if PG8_USE_SP2
        PG8_STAGE(PG8_SB(0, 0), cB, voffB); PG8_STAGE(PG8_SB(0, 1), cB + hstepB, voffB); PG8_STAGE(PG8_SA(0, 0), cA, voffA); PG8_STAGE(PG8_SA(0, 1), cA + hstepA, voffA);
        if (wr == 1) PG8_BAR;
        PG8_WAIT_V(2); PG8_BAR;
#else
        PG8_STAGE(PG8_SB(0, 0), cB, voffB); PG8_STAGE(PG8_SA(0, 0), cA, voffA); PG8_STAGE(PG8_SB(0, 1), cB + hstepB, voffB); PG8_STAGE(PG8_SA(0, 1), cA + hstepA, voffA);
        if (wr == 1) PG8_BAR;
        PG8_WAIT_V(4); PG8_BAR;
#endif
        PG8_STAGE(PG8_SB(1, 0), cB + kstep, voffB); PG8_STAGE(PG8_SA(1, 0), cA + kstep, voffA); PG8_STAGE(PG8_SB(1, 1), cB + hstepB + kstep, voffB);
        PG8_WAIT_V(6); PG8_BAR;
        }
        const bool has_next = S.next(ui + 1, nxt); const bool pf = has_next && !E.uses_lds(cur);
        const char* nA = pf ? (const char*)g.A + (size_t)nxt.pm * tstepA + (size_t)nxt.ka * 2 : cA; const char* nB = pf ? (const char*)g.Bt + (size_t)nxt.pn * tstepB + (size_t)nxt.kb * 2 : cB;
        for (int t = 0; t < nt; t += 2) {
            const bool last = (t == nt - 2);
            const char* a1 = cA + (size_t)(t + 1) * kstep;
            const char* a2 = last ? nA : cA + (size_t)(t + 2) * kstep; const char* b2 = last ? nB : cB + (size_t)(t + 2) * kstep;
            const char* a3 = a2 + kstep; const char* b3 = b2 + kstep;
#if PG8_USE_SP2
            PG8_LDB(B0, 0, 0); PG8_LDB(B1, 0, 1); PG8_SCHED; PG8_LDA(At, 0, 0); PG8_STAGE(PG8_SA(1, 1), a1 + hstepA, voffA);
            PG8_WAIT_V(8); PG8_WAIT_L(0); PG8_BAR; PG8_MMA(0, 0, At, B0); PG8_MMA(0, 1, At, B1); PG8_BAR; PG8_SCHED;
            PG8_LDA(At, 0, 1); PG8_STAGE(PG8_SB(0, 0), b2, voffB); PG8_STAGE(PG8_SB(0, 1), b2 + hstepB, voffB); PG8_STAGE(PG8_SA(0, 0), a2, voffA);
            PG8_WAIT_V(8); PG8_WAIT_L(0); PG8_BAR; PG8_MMA(1, 0, At, B0); PG8_MMA(1, 1, At, B1); PG8_BAR; PG8_SCHED;
            PG8_LDB(B0, 1, 0); PG8_LDB(B1, 1, 1); PG8_SCHED; PG8_LDA(At, 1, 0); PG8_STAGE(PG8_SA(0, 1), a2 + hstepA, voffA);
            PG8_WAIT_V(8); PG8_WAIT_L(0); PG8_BAR; PG8_MMA(0, 0, At, B0); PG8_MMA(0, 1, At, B1); PG8_BAR; PG8_SCHED;
            PG8_LDA(At, 1, 1); PG8_STAGE(PG8_SB(1, 0), b3, voffB); PG8_STAGE(PG8_SB(1, 1), b3 + hstepB, voffB); PG8_STAGE(PG8_SA(1, 0), a3, voffA);
            PG8_WAIT_V(8); PG8_WAIT_L(0); PG8_BAR; PG8_MMA(1, 0, At, B0); PG8_MMA(1, 1, At, B1); PG8_BAR; PG8_SCHED;
#else
            PG8_LDB(B0, 0, 0); PG8_SCHED; PG8_LDA(At, 0, 0); PG8_STAGE(PG8_SA(1, 1), a1 + hstepA, voffA);
            PG8_WAIT_L(8); PG8_BAR; PG8_WAIT_L(0); PG8_MMA(0, 0, At, B0); PG8_BAR; PG8_SCHED;
            PG8_LDB(B1, 0, 1); PG8_STAGE(PG8_SB(0, 0), b2, voffB);
            PG8_BAR; PG8_WAIT_L(0); PG8_MMA(0, 1, At, B1); PG8_BAR;
            PG8_LDA(At, 0, 1); PG8_STAGE(PG8_SA(0, 0), a2, voffA);
            PG8_BAR; PG8_WAIT_L(0); PG8_MMA(1, 0, At, B0); PG8_BAR; PG8_SCHED;
            PG8_STAGE(PG8_SB(0, 1), b2 + hstepB, voffB);
            PG8_WAIT_V(6); PG8_BAR; PG8_MMA(1, 1, At, B1); PG8_BAR;
            PG8_LDB(B0, 1, 0); PG8_SCHED; PG8_LDA(At, 1, 0); PG8_STAGE(PG8_SA(0, 1), a2 + hstepA, voffA);
            PG8_WAIT_L(8); PG8_BAR; PG8_WAIT_L(0); PG8_MMA(0, 0, At, B0); PG8_BAR; PG8_SCHED;
            PG8_LDB(B1, 1, 1); PG8_STAGE(PG8_SB(1, 0), b3, voffB);
            PG8_BAR; PG8_WAIT_L(0); PG8_MMA(0, 1, At, B1); PG8_BAR;
            PG8_LDA(At, 1, 1); PG8_STAGE(PG8_SA(1, 0), a3, voffA);
            PG8_BAR; PG8_WAIT_L(0); PG8_MMA(1, 0, At, B0); PG8_BAR; PG8_SCHED;
            PG8_STAGE(PG8_SB(1, 1), b3 + hstepB, voffB);
            PG8_WAIT_V(6); PG8_BAR; PG8_MMA(1, 1, At, B1); PG8_BAR;
#endif
        }
        if (wr == 0) PG8_BAR;
        if (pf) {
            { int t2 = threadIdx.x; asm volatile("" : "+v"(t2)); E.drain(acc, cur, wr, wc, t2 & 15, (t2 & 63) >> 4, lds, t2); }
            if (wr == 1) PG8_BAR;
            primed = true;
        } else {
            PG8_WAIT_V(0); PG8_WAIT_L(0); PG8_BAR;
            { int t2 = threadIdx.x; asm volatile("" : "+v"(t2)); E.drain(acc, cur, wr, wc, t2 & 15, (t2 & 63) >> 4, lds, t2); }
            PG8_WAIT_L(0); PG8_BAR;
            primed = false;
        }
        have = has_next; cur = nxt;
    }
#undef PG8_SA
#undef PG8_SB
#undef PG8_STAGE
#undef PG8_LDA
#undef PG8_LDB
#undef PG8_MMA
#undef PG8_WAIT_V
#undef PG8_WAIT_L
#undef PG8_BAR
#undef PG8_SCHED
}
}
using pg8::Unit;
typedef f32x4 AccT[2][2][4][2];

constexpr int PT = 260;
struct Epi1 {
    static constexpr bool CHAIN = false;
    DI bool uses_lds(const Unit& u) const { return u.pn < 8; }
    bf16_t *q, *k, *v, *ub, *gates; float* kmean; const float *qg, *kg, *bgate;
    DI void drain(AccT& acc, const Unit& u, int wr, int wc, int fr, int fq, LAS unsigned char* lds, int tid) const {
        const int pn = u.pn; const int rowb = u.pm * 256 + wr * 64 + fr;
        bf16_t *pq = q, *pk = k, *pv = v, *pu = ub, *pg = gates; const float *pqg = qg, *pkg = kg;
        asm volatile("" : "+s"(pq), "+s"(pk), "+s"(pv), "+s"(pu), "+s"(pg), "+s"(pqg), "+s"(pkg));
        if (pn >= 16) {
            const int c0 = (pn - 16) * 128 + wc * 32 + fq * 8;
            f32x4 ba[2], bb[2];
#pragma unroll
            for (int n = 0; n < 2; ++n) { ba[n] = *(const f32x4*)(bgate + c0 + 4 * n); bb[n] = *(const f32x4*)(bgate + 2048 + c0 + 4 * n); }
#pragma unroll
            for (int ai = 0; ai < 2; ++ai)
#pragma unroll
                for (int m = 0; m < 4; ++m) { bf16_t* rowp = pg + (size_t)(rowb + ai * 128 + m * 16) * 4096 + c0;
                    f32x4 rr[2], gg[2];
#pragma unroll
                    for (int n = 0; n < 2; ++n)
#pragma unroll
                        for (int i = 0; i < 4; ++i) { const float ea = __builtin_amdgcn_exp2f((acc[ai][0][m][n][i] + ba[n][i]) * -1.4426950408889634f), eb = __builtin_amdgcn_exp2f((acc[ai][1][m][n][i] + bb[n][i]) * -1.4426950408889634f);
                            gg[n][i] = __builtin_amdgcn_rcpf(1.0f + eb); rr[n][i] = (1.0f + eb) * __builtin_amdgcn_rcpf(1.0f + ea); }
                    *(u32x4*)rowp = pack8(rr[0], rr[1]); *(u32x4*)(rowp + 2048) = pack8(gg[0], gg[1]); }
            return;
        }
        if (pn >= 8) {
            bf16_t* base; int ldc, col0; const bool sig = false;
            if (pn < 12) { base = pv; ldc = 1024; col0 = (pn - 8) * 256; } else { base = pu; ldc = 1024; col0 = (pn - 12) * 256; }
            col0 += wc * 32 + fq * 8;
            f32x4 bv[2][2];
#pragma unroll
            for (int bj = 0; bj < 2; ++bj)
#pragma unroll
                for (int n = 0; n < 2; ++n) bv[bj][n] = sig ? *(const f32x4*)(bgate + col0 + bj * 128 + 4 * n) : (f32x4){0.f, 0.f, 0.f, 0.f};
#pragma unroll
            for (int ai = 0; ai < 2; ++ai)
#pragma unroll
                for (int m = 0; m < 4; ++m) { bf16_t* rowp = base + (size_t)(rowb + ai * 128 + m * 16) * ldc + col0;
#pragma unroll
                    for (int bj = 0; bj < 2; ++bj) { f32x4 v0 = acc[ai][bj][m][0] + bv[bj][0], v1 = acc[ai][bj][m][1] + bv[bj][1];
                        if (sig) {
#pragma unroll
                            for (int i = 0; i < 4; ++i) { v0[i] = sigmoidf_(v0[i]); v1[i] = sigmoidf_(v1[i]); } }
                        *(u32x4*)(rowp + bj * 128) = pack8(v0, v1); } }
            return;
        }
        const bool isq = pn < 4; const int hp = (pn & 3) * 2;
        const LAS float* g = (const LAS float*)(lds + 133120) + (isq ? 0 : 128); const LAS double* ropec = (const LAS double*)(lds + 134144); bf16_t* dst = isq ? pq : pk;
        const float qs = isq ? 0.08838834764831845f * 1.4426950408889634f : 1.0f;
        LAS float* T = (LAS float*)lds;
        const int r = tid >> 2, part = tid & 3, bj2 = part >> 1, sub = part & 1;
        float ksum = 0.f;
#pragma unroll
        for (int ai = 0; ai < 2; ++ai) {
#pragma unroll
            for (int m = 0; m < 4; ++m)
#pragma unroll
                for (int bj = 0; bj < 2; ++bj)
#pragma unroll
                    for (int n = 0; n < 2; ++n) *(LAS f32x4*)(T + (64 * wr + 16 * m + fr) * PT + 128 * bj + 32 * wc + 8 * fq + 4 * n) = acc[ai][bj][m][n];
            RAW_BAR();
            LAS float* rowp = T + r * PT + 128 * bj2 + 32 * sub;
            float ss = 0.f;
#pragma unroll
            for (int j = 0; j < 8; ++j) { const f32x4 a = *(const LAS f32x4*)(rowp + 4 * j), b = *(const LAS f32x4*)(rowp + 64 + 4 * j);
                ss += (a[0] * a[0] + a[1] * a[1]) + (a[2] * a[2] + a[3] * a[3]) + (b[0] * b[0] + b[1] * b[1]) + (b[2] * b[2] + b[3] * b[3]); }
            ss += __shfl_xor(ss, 1);
            const float rr = __builtin_amdgcn_rsqf(ss * (1.0f / 128.0f) + EPS) * qs;
            const int row = u.pm * 256 + ai * 128 + r;
            bf16_t* op = dst + (size_t)row * 1024 + (hp + bj2) * 128 + 32 * sub;
#pragma unroll 1
            for (int j = 0; j < 8; j += 2) {
                f32x4 o1[2], o2[2];
#pragma unroll
                for (int jj = 0; jj < 2; ++jj) {
                    const int d = 32 * sub + 4 * (j + jj);
                    const f32x4 x1 = *(const LAS f32x4*)(rowp + 4 * (j + jj)), x2 = *(const LAS f32x4*)(rowp + 64 + 4 * (j + jj));
                    const f32x4 g0 = *(const LAS f32x4*)(g + d), g1 = *(const LAS f32x4*)(g + 64 + d);
                    f32x4 cs, sn;
#pragma unroll
                    for (int i = 0; i < 4; ++i) { double t = (double)row * ropec[d + i]; t -= __builtin_floor(t); const float tf = (float)t; cs[i] = __builtin_amdgcn_cosf(tf); sn[i] = __builtin_amdgcn_sinf(tf); }
                    const f32x4 a = x1 * rr * g0, b = x2 * rr * g1;
                    o1[jj] = a * cs - b * sn; o2[jj] = b * cs + a * sn;
                    if (!isq) { *(LAS f32x4*)(rowp + 4 * (j + jj)) = o1[jj]; *(LAS f32x4*)(rowp + 64 + 4 * (j + jj)) = o2[jj]; }
                }
                *(u32x4*)(op + 4 * j) = pack8(o1[0], o1[1]); *(u32x4*)(op + 64 + 4 * j) = pack8(o2[0], o2[1]);
            }
            if (!isq) { RAW_BAR(); if (tid < 256) {
#pragma unroll 8
                for (int rr2 = 0; rr2 < 128; ++rr2) ksum += T[rr2 * PT + tid]; } }
            RAW_BAR();
        }
        if (!isq && tid < 256) kmean[((size_t)(hp + (tid >> 7)) * 64 + u.pm) * 128 + (tid & 127)] = ksum * (1.0f / 256.0f);
    }
};

struct Epi3 {
    static constexpr bool CHAIN = false;
    bf16_t* am; const float* ls;
    DI void drain(AccT& acc, const Unit& u, int wr, int wc, int fr, int fq, LAS unsigned char* l, int) const { (*this)(acc, u, wr, wc, fr, fq, l); }
    DI void operator()(AccT& acc, const Unit& u, int wr, int wc, int fr, int fq, LAS unsigned char*) const {
        const int col0 = u.pn * 256 + wc * 32 + fq * 8; const int rowb = u.pm * 256 + wr * 64 + fr;
        f32x4 sv[2][2];
#pragma unroll
        for (int bj = 0; bj < 2; ++bj)
#pragma unroll
            for (int n = 0; n < 2; ++n) sv[bj][n] = *(const f32x4*)(ls + col0 + bj * 128 + 4 * n);
#pragma unroll
        for (int ai = 0; ai < 2; ++ai)
#pragma unroll
            for (int m = 0; m < 4; ++m) { bf16_t* rowp = am + (size_t)(rowb + ai * 128 + m * 16) * 2048 + 1024 + col0;
#pragma unroll
                for (int bj = 0; bj < 2; ++bj) *(u32x4*)(rowp + bj * 128) = pack8(acc[ai][bj][m][0] * sv[bj][0], acc[ai][bj][m][1] * sv[bj][1]); }
    }
};

struct Epi5 {
    static constexpr bool CHAIN = true;
    const bf16_t* gates; bf16_t* merged;
    DI void operator()(AccT& acc, const Unit& u, int wr, int wc, int fr, int fq, LAS unsigned char*) const {
        const int col0 = u.pn * 256 + wc * 32 + fq * 8; const int rowb = u.pm * 256 + wr * 64 + fr;
        if (u.aux == 0) {
#pragma unroll
            for (int ai = 0; ai < 2; ++ai) {
                u32x4 gw[4][2];
#pragma unroll
                for (int m = 0; m < 4; ++m)
#pragma unroll
                    for (int bj = 0; bj < 2; ++bj) gw[m][bj] = *(const u32x4*)(gates + (size_t)(rowb + ai * 128 + m * 16) * 4096 + col0 + bj * 128);
#pragma unroll
                for (int m = 0; m < 4; ++m)
#pragma unroll
                    for (int bj = 0; bj < 2; ++bj) { float gr[8]; unpack8(gw[m][bj], gr);
#pragma unroll
                        for (int i = 0; i < 4; ++i) { acc[ai][bj][m][0][i] *= gr[i]; acc[ai][bj][m][1][i] *= gr[4 + i]; } }
                FENCE();
            }
        } else {
#pragma unroll
            for (int ai = 0; ai < 2; ++ai) {
                u32x4 gw[4][2];
#pragma unroll
                for (int m = 0; m < 4; ++m)
#pragma unroll
                    for (int bj = 0; bj < 2; ++bj) gw[m][bj] = *(const u32x4*)(gates + (size_t)(rowb + ai * 128 + m * 16) * 4096 + 2048 + col0 + bj * 128);
#pragma unroll
                for (int m = 0; m < 4; ++m)
#pragma unroll
                    for (int bj = 0; bj < 2; ++bj) { float gp[8]; unpack8(gw[m][bj], gp); f32x4 v0, v1;
#pragma unroll
                        for (int i = 0; i < 4; ++i) { v0[i] = acc[ai][bj][m][0][i] * gp[i]; v1[i] = acc[ai][bj][m][1][i] * gp[4 + i]; }
                        *(u32x4*)(merged + (size_t)(rowb + ai * 128 + m * 16) * 2048 + col0 + bj * 128) = pack8(v0, v1); }
                FENCE();
            }
        }
    }
};

struct Epi6 {
    static constexpr bool CHAIN = false;
    const float* x; float* out; bf16_t* xg; const float* modf; const float* nfg; float* rowss;
    DI void operator()(AccT& acc, const Unit& u, int wr, int wc, int fr, int fq, LAS unsigned char*) const {
        const int col0 = u.pn * 256 + wc * 32 + fq * 8; const int rowb = u.pm * 256 + wr * 64 + fr;
        f32x4 g1v[2][2], gmv[2][2];
#pragma unroll
        for (int bj = 0; bj < 2; ++bj)
#pragma unroll
            for (int n = 0; n < 2; ++n) { const int c = col0 + bj * 128 + 4 * n; g1v[bj][n] = *(const f32x4*)(modf + 2 * 2048 + c);
                gmv[bj][n] = *(const f32x4*)(nfg + c) * (*(const f32x4*)(modf + 4 * 2048 + c) + 1.0f); }
#pragma unroll
        for (int ag = 0; ag < 4; ++ag) { const int ai = ag >> 1, m0 = (ag & 1) * 2;
            f32x4 xr[4][2][2];
#pragma unroll
            for (int m = m0; m < m0 + 2; ++m)
#pragma unroll
                for (int bj = 0; bj < 2; ++bj) { const size_t off = (size_t)(rowb + ai * 128 + m * 16) * 2048 + col0 + bj * 128;
                    xr[m][bj][0] = *(const f32x4*)(x + off); xr[m][bj][1] = *(const f32x4*)(x + off + 4); }
            FENCE();
#pragma unroll
            for (int m = m0; m < m0 + 2; ++m) { const size_t row = (size_t)(rowb + ai * 128 + m * 16); float ss = 0.f;
#pragma unroll
                for (int bj = 0; bj < 2; ++bj) { const size_t off = row * 2048 + col0 + bj * 128;
                    const f32x4 y0 = xr[m][bj][0] + g1v[bj][0] * acc[ai][bj][m][0], y1 = xr[m][bj][1] + g1v[bj][1] * acc[ai][bj][m][1];
                    *(f32x4*)(out + off) = y0; *(f32x4*)(out + off + 4) = y1;
                    *(u32x4*)(xg + off) = pack8(y0 * gmv[bj][0], y1 * gmv[bj][1]);
                    ss += (y0[0] * y0[0] + y0[1] * y0[1]) + (y0[2] * y0[2] + y0[3] * y0[3]) + (y1[0] * y1[0] + y1[1] * y1[1]) + (y1[2] * y1[2] + y1[3] * y1[3]); }
                ss += __shfl_xor(ss, 16); ss += __shfl_xor(ss, 32);
                if (fq == 0) rowss[row * 32 + u.pn * 4 + wc] = ss; }
            FENCE();
        }
    }
};

struct Epi7 {
    static constexpr bool CHAIN = false;
    DI bool uses_lds(const Unit&) const { return true; }
    const float* rsb; const float* biasup; const float* cw; const float* cb; bf16_t* act; float* edge;
    DI void drain(AccT& acc, const Unit& u, int wr, int wc, int fr, int fq, LAS unsigned char* lds, int tid) const {
        LAS float* T = (LAS float*)lds;
        const int cgi = tid & 15, rg = tid >> 4;
        const int lcb = u.pn * 128;
        const int cg8 = (tid >> 1) & 15, h4 = tid & 1, rgi = tid >> 5;
        const int cc = 8 * cg8 + 4 * h4, lca = lcb + cc, lcbb = DFF + lcb + cc;
        const f32x4 wa0 = *(const f32x4*)(cw + lca), wa1 = *(const f32x4*)(cw + NUP + lca), wa2 = *(const f32x4*)(cw + 2 * NUP + lca), ca0 = *(const f32x4*)(cb + lca);
        const f32x4 wb0 = *(const f32x4*)(cw + lcbb), wb1 = *(const f32x4*)(cw + NUP + lcbb), wb2 = *(const f32x4*)(cw + 2 * NUP + lcbb), cb0 = *(const f32x4*)(cb + lcbb);
        f32x4 biv[2][2]; float rsv[2][4];
#pragma unroll
        for (int bj = 0; bj < 2; ++bj)
#pragma unroll
            for (int n = 0; n < 2; ++n) biv[bj][n] = *(const f32x4*)(biasup + u.pn * 256 + 128 * bj + 32 * wc + 8 * fq + 4 * n);
#pragma unroll
        for (int ai = 0; ai < 2; ++ai)
#pragma unroll
            for (int m = 0; m < 4; ++m) rsv[ai][m] = rsb[u.pm * 256 + ai * 128 + 64 * wr + 16 * m + fr];
#pragma unroll
        for (int ai = 0; ai < 2; ++ai) {
            {
#pragma unroll
                for (int bj = 0; bj < 2; ++bj)
#pragma unroll
                    for (int n = 0; n < 2; ++n) {
#pragma unroll
                        for (int m = 0; m < 4; ++m) *(LAS f32x4*)(T + (2 + 64 * wr + 16 * m + fr) * PT + 128 * bj + 32 * wc + 8 * fq + 4 * n) = acc[ai][bj][m][n] * rsv[ai][m] + biv[bj][n]; }
            }
            RAW_BAR();
            {
#pragma unroll 1
                for (int ch = 0; ch < 2; ++ch) {
                    const int r0 = 8 * rgi + 4 * ch;
                    f32x4 xa[6], xb[6];
#pragma unroll
                    for (int kx = 0; kx < 6; ++kx) { xa[kx] = *(const LAS f32x4*)(T + (r0 + kx) * PT + cc); xb[kx] = *(const LAS f32x4*)(T + (r0 + kx) * PT + 128 + cc); }
                    u32x2 pw[4];
#pragma unroll
                    for (int kx = 0; kx < 4; ++kx) { const f32x4 av = ca0 + wa0 * xa[kx] + wa1 * xa[kx + 1] + wa2 * xa[kx + 2], bv = cb0 + wb0 * xb[kx] + wb1 * xb[kx + 1] + wb2 * xb[kx + 2];
                        float rv[4];
#pragma unroll
                        for (int i = 0; i < 4; ++i) rv[i] = av[i] * sigmoidf_(av[i]) * bv[i];
                        pw[kx].x = pk2(rv[0], rv[1]); pw[kx].y = pk2(rv[2], rv[3]); }
                    const u32x2 s0 = h4 ? pw[0] : pw[2], s1 = h4 ? pw[1] : pw[3];
                    u32x2 g0, g1; g0.x = __shfl_xor(s0.x, 1); g0.y = __shfl_xor(s0.y, 1); g1.x = __shfl_xor(s1.x, 1); g1.y = __shfl_xor(s1.y, 1);
                    const u32x2 m0 = h4 ? pw[2] : pw[0], m1 = h4 ? pw[3] : pw[1];
                    const u32x4 o0 = h4 ? (u32x4){g0.x, g0.y, m0.x, m0.y} : (u32x4){m0.x, m0.y, g0.x, g0.y};
                    const u32x4 o1 = h4 ? (u32x4){g1.x, g1.y, m1.x, m1.y} : (u32x4){m1.x, m1.y, g1.x, g1.y};
                    if (!(ai == 0 && rgi == 0 && ch == 0 && h4 == 0)) {
                        const size_t row = (size_t)(u.pm * 256 + ai * 128 + r0 + 2 * h4);
                        *(u32x4*)(act + row * DFF + lcb + 8 * cg8) = o0; *(u32x4*)(act + (row + 1) * DFF + lcb + 8 * cg8) = o1; }
                }
            }
            if (tid < 128) { const int sel = tid >> 6, col4 = (tid & 63) * 4; const int lc = (col4 < 128) ? (lcb + col4) : (DFF + lcb + col4 - 128);
                const f32x4 ev = *(const LAS f32x4*)(T + ((ai == 0 ? 2 : 128) + sel) * PT + col4);
                *(f32x4*)(edge + ((size_t)(u.pm * 4 + 2 * ai + sel)) * NUP + lc) = ev; }
            RAW_BAR();
            if (ai == 0) { if (tid < 128) { const int sel = tid >> 6, col4 = (tid & 63) * 4; *(LAS f32x4*)(T + sel * PT + col4) = *(const LAS f32x4*)(T + (128 + sel) * PT + col4); }
                RAW_BAR(); }
        }
    }
};

struct Epi9 {
    static constexpr bool CHAIN = false;
    float* out; const float* modf;
    DI void operator()(AccT& acc, const Unit& u, int wr, int wc, int fr, int fq, LAS unsigned char*) const {
        const int col0 = u.pn * 256 + wc * 32 + fq * 8; const int rowb = u.pm * 256 + wr * 64 + fr;
        f32x4 g2v[2][2];
#pragma unroll
        for (int bj = 0; bj < 2; ++bj)
#pragma unroll
            for (int n = 0; n < 2; ++n) g2v[bj][n] = *(const f32x4*)(modf + 5 * 2048 + col0 + bj * 128 + 4 * n);
#pragma unroll
        for (int ag = 0; ag < 4; ++ag) { const int ai = ag >> 1, m0 = (ag & 1) * 2;
            f32x4 xr[4][2][2];
#pragma unroll
            for (int m = m0; m < m0 + 2; ++m)
#pragma unroll
                for (int bj = 0; bj < 2; ++bj) { const size_t off = (size_t)(rowb + ai * 128 + m * 16) * 2048 + col0 + bj * 128;
                    xr[m][bj][0] = *(const f32x4*)(out + off); xr[m][bj][1] = *(const f32x4*)(out + off + 4); }
            FENCE();
#pragma unroll
            for (int m = m0; m < m0 + 2; ++m)
#pragma unroll
                for (int bj = 0; bj < 2; ++bj) { const size_t off = (size_t)(rowb + ai * 128 + m * 16) * 2048 + col0 + bj * 128;
                    *(f32x4*)(out + off) = xr[m][bj][0] + g2v[bj][0] * acc[ai][bj][m][0]; *(f32x4*)(out + off + 4) = xr[m][bj][1] + g2v[bj][1] * acc[ai][bj][m][1]; }
            FENCE();
        }
    }
};

DI int dest_row(int mode, int n) {
    if (mode == 1) { if (n >= 2048) return n; const int d = n & 127; return (n & ~127) + 32 * ((d >> 4) & 3) + 8 * ((d >> 2) & 3) + 4 * (d >> 6) + (d & 3); }
    if (mode == 2) { const int bj = n >= DFF ? 1 : 0, cc = n - bj * DFF; return 256 * (cc >> 7) + 128 * bj + (cc & 127); }
    if (mode == 3) { const int bj = n >= 2048 ? 1 : 0, cc = n - bj * 2048; return 256 * (cc >> 7) + 128 * bj + (cc & 127); }
    return n;
}
DI void transpose_item(const float* W, int N, bf16_t* WT, int ldd, int koff, int row_off, int mode, LAS float* scr, int item, int lane) {
    const int nblk = N / 64, kb = item / nblk, nb = item % nblk, k0 = 64 * kb, n0 = 64 * nb;
    const int kr = lane >> 4, n4 = (lane & 15) * 4;
    f32x4 v[16];
#pragma unroll
    for (int i = 0; i < 16; ++i) v[i] = __builtin_nontemporal_load((const f32x4*)(W + (size_t)(k0 + 4 * i + kr) * N + n0 + n4));
#pragma unroll
    for (int i = 0; i < 16; ++i) { LAS float* d = scr + (4 * i + kr) * 65 + n4; d[0] = v[i][0]; d[1] = v[i][1]; d[2] = v[i][2]; d[3] = v[i][3]; }
    LDS_WAIT(); asm volatile("" ::: "memory");
    const int c = lane & 7;
#pragma unroll
    for (int j = 0; j < 8; ++j) { const int n = (lane >> 3) + 8 * j; const LAS float* sp = scr + (8 * c) * 65 + n;
        u32x4 o; o.x = pk2(sp[0 * 65], sp[1 * 65]); o.y = pk2(sp[2 * 65], sp[3 * 65]); o.z = pk2(sp[4 * 65], sp[5 * 65]); o.w = pk2(sp[6 * 65], sp[7 * 65]);
        *(u32x4*)(WT + (size_t)(row_off + dest_row(mode, n0 + n)) * ldd + koff + k0 + 8 * c) = o; }
    LDS_WAIT(); asm volatile("" ::: "memory");
}

DI s16x4 vtr(const LAS unsigned char* p) { typedef short v4i16_t __attribute__((ext_vector_type(4))); return __builtin_bit_cast(s16x4, __builtin_amdgcn_ds_read_tr16_b64_v4i16((LAS v4i16_t*)p)); }
constexpr int KV_PITCH = 272;
constexpr int LDS_KS = 0, LDS_VS = 256 * KV_PITCH, LDS_TAB = 2 * 256 * KV_PITCH;


#define XB_TMO      128
#define XB_XCNT(j)  (256  + 64 * (j))
#define XB_XSUB(j)  (1280 + 64 * (j))
#define XB_XGEN(j)  (2304 + 64 * (j))
#define XB_TOP      3328
#define XB_TOPGEN   3392
#define XCD_BAR_WORDS 3456
#define XB_SPIN_CAP (1u << 18)
DI unsigned xb_ld(unsigned* p)              { return __hip_atomic_load(p, __ATOMIC_RELAXED, __HIP_MEMORY_SCOPE_AGENT); }
DI unsigned xb_add(unsigned* p, unsigned v) { return __hip_atomic_fetch_add(p, v, __ATOMIC_RELAXED, __HIP_MEMORY_SCOPE_AGENT); }
DI unsigned xb_xcc_id() { return (unsigned)__builtin_amdgcn_s_getreg((3 << 11) | 20) & 0xFu; }
#define XB_SPIN(cond, bar) do { unsigned _sp = 0; while (cond) { __builtin_amdgcn_s_sleep(1); \
    if ((++_sp & 255u) == 0u) { if (xb_ld(&(bar)[XB_TMO])) break; if (_sp > XB_SPIN_CAP) { atomicAdd(&(bar)[XB_TMO], 1u); break; } } } } while (0)
struct XcdBarrier { unsigned* bar; unsigned x; volatile LAS unsigned* st; };
DI XcdBarrier xcd_barrier_post(unsigned* bar, volatile LAS unsigned* st) {
    XcdBarrier b; b.bar = bar; b.x = xb_xcc_id(); b.st = st;
    if (threadIdx.x == 0) (void)xb_add(&bar[XB_XCNT(b.x)], 1u);
    return b;
}
DI void xcd_barrier_complete(unsigned* bar, unsigned x, unsigned& nloc, unsigned& nx) {
    const unsigned G = gridDim.x * gridDim.y * gridDim.z;
    unsigned sum, cnt, mine, sp = 0u;
    for (;;) {
        sum = 0u; cnt = 0u; mine = 0u;
#pragma unroll
        for (unsigned j = 0; j < 16; ++j) { const unsigned c = xb_ld(&bar[XB_XCNT(j)]); sum += c; cnt += (c > 0u) ? 1u : 0u; mine = (j == x) ? c : mine; }
        if (sum == G) break;
        __builtin_amdgcn_s_sleep(1);
        if ((++sp & 255u) == 0u) { if (xb_ld(&bar[XB_TMO])) break; if (sp > XB_SPIN_CAP) { atomicAdd(&bar[XB_TMO], 1u); break; } }
    }
    nloc = mine > 0u ? mine : 1u; nx = cnt > 0u ? cnt : 1u;
}
DI void xcd_barrier(const XcdBarrier& b) {
    asm volatile("s_waitcnt vmcnt(0)" ::: "memory");
    __syncthreads();
    if (threadIdx.x == 0) {
        unsigned* bar = b.bar;
        __builtin_amdgcn_s_waitcnt(0);
        unsigned nloc = b.st[0], nx = b.st[1];
        if (nloc == 0u) { xcd_barrier_complete(bar, b.x, nloc, nx); b.st[0] = nloc; b.st[1] = nx; }
        const unsigned old = xb_add(&bar[XB_XSUB(b.x)], 1u);
        const unsigned gen = old / nloc;
        if (old + 1u == (gen + 1u) * nloc) {
            __builtin_amdgcn_fence(__ATOMIC_RELEASE, "agent");
            asm volatile("s_waitcnt vmcnt(0)" ::: "memory");
            const unsigned og = xb_add(&bar[XB_TOP], 1u);
            const unsigned tg = og / nx;
            if (og + 1u == (tg + 1u) * nx) xb_add(&bar[XB_TOPGEN], 1u);
            else XB_SPIN(xb_ld(&bar[XB_TOPGEN]) == tg, bar);
            __builtin_amdgcn_fence(__ATOMIC_ACQUIRE, "agent");
            xb_add(&bar[XB_XGEN(b.x)], 1u);
            asm volatile("s_waitcnt vmcnt(0)" ::: "memory");
        } else {
            XB_SPIN(xb_ld(&bar[XB_XGEN(b.x)]) == gen, bar);
            __builtin_amdgcn_fence(__ATOMIC_ACQUIRE, "agent");
            asm volatile("s_waitcnt vmcnt(0)" ::: "memory");
        }
    }
    __syncthreads();
}

#ifndef PHMASK
#define PHMASK 0xFFFF
#endif
struct Params {
    const float* in[20]; float* out; unsigned char* ws;
};

__global__ void __launch_bounds__(NTHR, 2) fwd_megakernel(Params p) {
    extern __shared__ __attribute__((aligned(16))) unsigned char lds_raw[];
    LAS unsigned char* lds = (LAS unsigned char*)lds_raw;
    cg::grid_group grid = cg::this_grid();
    int tid = threadIdx.x, lane = tid & 63; const int wave = __builtin_amdgcn_readfirstlane(tid >> 6);
#define RELOAD_IDS() do { tid = threadIdx.x; asm volatile("" : "+v"(tid)); lane = tid & 63; } while (0)
    const int G = gridDim.x, bx = blockIdx.x;
    const int vcu = (G % 8 == 0) ? (bx % 8) * (G / 8) + bx / 8 : bx;
    const int gw = vcu * NWAVES + wave, NGW = G * NWAVES;
    unsigned char* ws = p.ws;
    volatile LAS unsigned* xst = (volatile LAS unsigned*)(lds + LDS_BYTES - 16);
    if (threadIdx.x < 4) xst[threadIdx.x] = 0u;
    __syncthreads();
    XcdBarrier xbar; xbar.bar = (unsigned*)(ws + WS_BAR); xbar.x = 0; xbar.st = xst;
    if (blockIdx.x == 0) {
        for (int i = threadIdx.x; i < 512; i += NTHR) ((unsigned*)(ws + WS_CNT))[i] = 0u;
        for (int i = threadIdx.x; i < XCD_BAR_WORDS; i += NTHR) ((unsigned*)(ws + WS_BAR))[i] = 0u;
    }
#define xin (p.in[0])
#define cvec (p.in[1])
#define w_ada (p.in[2])
#define b_ada (p.in[3])
#define nmg (p.in[4])
#define w_in (p.in[5])
#define qng (p.in[6])
#define kng (p.in[7])
#define w_pgrp (p.in[8])
#define pscale (p.in[9])
#define w_abr (p.in[10])
#define w_pbr (p.in[11])
#define w_gate (p.in[12])
#define b_gate (p.in[13])
#define w_o (p.in[14])
#define nfg (p.in[15])
#define w_up (p.in[16])
#define conv_w (p.in[17])
#define conv_b (p.in[18])
#define w_down (p.in[19])
#define outp (p.out)
#define cnt ((unsigned*)(ws + WS_CNT))
#define kmean ((float*)(ws + WS_KMEAN))
#define modp ((float*)(ws + WS_MODP))
#define modf ((float*)(ws + WS_MODF))
#define biasup ((float*)(ws + WS_BIASUP))
#define rowss ((float*)(ws + WS_ROWSS))
#define lsum ((float*)(ws + WS_LSUM))
#define qlist ((unsigned*)(ws + WS_LIST))
#define W1t ((bf16_t*)(ws + WS_W1))
#define Wyt ((bf16_t*)(ws + WS_WY))
#define Wot ((bf16_t*)(ws + WS_WO))
#define Wgt ((bf16_t*)(ws + WS_WG))
#define Wdt ((bf16_t*)(ws + WS_WD))
#define Wut ((bf16_t*)(ws + WS_WU))
#define hbuf ((bf16_t*)(ws + WS_HB))
#define qb ((bf16_t*)(ws + WS_Q))
#define kb ((bf16_t*)(ws + WS_K))
#define vb ((bf16_t*)(ws + WS_V))
#define ub ((bf16_t*)(ws + WS_U))
#define gates ((bf16_t*)(ws + WS_GATES))
#define dbuf ((bf16_t*)(ws + WS_DB))
#define am ((bf16_t*)(ws + WS_AM))
#define merged ((bf16_t*)(ws + WS_MERGED))
#define xg ((bf16_t*)(ws + WS_XG))
#define act ((bf16_t*)(ws + WS_ACT))
#define edge ((float*)(ws + WS_EDGE))
#define slots ((bf16_t*)p.out)
#define rsb ((float*)(ws + WS_LSUM))
#if PHMASK & 1
    {
        LAS float* scr = (LAS float*)(lds + wave * 16640);
        constexpr int I_IN = 32 * 64, I_GT = 32 * 64, I_AB = 16 * 32, I_PB = 16 * 32, I_O = 32 * 32, I_UP = 32 * 176, I_DN = 88 * 32, I_G = 4 * 4;
        constexpr int NIT = I_IN + I_GT + I_AB + I_PB + I_O + I_UP + I_DN + 4 * I_G;
        for (int it = gw; it < NIT; it += NGW) {
            int r = it;
            if (r < I_UP) { transpose_item(w_up, NUP, Wut, 2048, 0, 0, 2, scr, r, lane); continue; } r -= I_UP;
            if (r < I_DN) { transpose_item(w_down, 2048, Wdt, DFF, 0, 0, 0, scr, r, lane); continue; } r -= I_DN;
            if (r < I_IN) { transpose_item(w_in, 4096, W1t, 2048, 0, 0, 0, scr, r, lane); continue; } r -= I_IN;
            if (r < I_GT) { transpose_item(w_gate, 4096, W1t, 2048, 0, 4096, 3, scr, r, lane); continue; } r -= I_GT;
            if (r < I_AB) { transpose_item(w_abr, 2048, Wyt, 2048, 0, 0, 0, scr, r, lane); continue; } r -= I_AB;
            if (r < I_PB) { transpose_item(w_pbr, 2048, Wyt, 2048, 1024, 0, 0, scr, r, lane); continue; } r -= I_PB;
            if (r < I_O) { transpose_item(w_o, 2048, Wot, 2048, 0, 0, 0, scr, r, lane); continue; } r -= I_O;
            { const int gI = r / I_G; transpose_item(w_pgrp + (size_t)gI * 65536, 256, Wgt, 1024, 0, gI * 256, 0, scr, r % I_G, lane); }
        }
        for (int it = gw; it < 768; it += NGW) {
            const int kc = it / 48, cgi = it % 48; const int col = cgi * 256 + lane * 4;
            f32x4 a = (f32x4){0.f, 0.f, 0.f, 0.f};
#pragma unroll 8
            for (int kk = 0; kk < 128; ++kk) { const int kx = kc * 128 + kk; const float cv = cvec[kx]; const float sv = cv * sigmoidf_(cv);
                a += __builtin_nontemporal_load((const f32x4*)(w_ada + (size_t)kx * 12288 + col)) * sv; }
            *(f32x4*)(modp + (size_t)kc * 12288 + col) = a;
        }
    }
    grid.sync();
    xbar = xcd_barrier_post((unsigned*)(ws + WS_BAR), xst);
    RELOAD_IDS();

#endif
#if PHMASK & 2
    {
        LAS float* sh1 = (LAS float*)lds; LAS float* gm1 = sh1 + 2048;
        for (int e = tid; e < 4096; e += NTHR) { float s = b_ada[e];
#pragma unroll
            for (int kc = 0; kc < 16; ++kc) s += modp[(size_t)kc * 12288 + e];
            if (e < 2048) sh1[e] = s; else gm1[e - 2048] = nmg[e - 2048] * (1.0f + s); }
        if (tid < 48) { const int e = bx * 48 + tid; if (e < 12288 && bx < 256) { float s = b_ada[e];
#pragma unroll
            for (int kc = 0; kc < 16; ++kc) s += modp[(size_t)kc * 12288 + e];
            modf[e] = s; } }
        if (G < 256 && bx == 0) { for (int e = G * 48 + tid; e < 12288; e += NTHR) { float s = b_ada[e]; for (int kc = 0; kc < 16; ++kc) s += modp[(size_t)kc * 12288 + e]; modf[e] = s; } }
        __syncthreads();
        for (int m = gw; m < S; m += 2 * NGW) {
            const int m2 = (m + NGW < S) ? m + NGW : m;
            const f32x4* xr0 = (const f32x4*)(xin + (size_t)m * DM) + lane; const f32x4* xr1 = (const f32x4*)(xin + (size_t)m2 * DM) + lane;
            f32x4 v0[8], v1[8]; float s0 = 0.f, s1 = 0.f;
#pragma unroll
            for (int j = 0; j < 8; ++j) { v0[j] = xr0[64 * j]; v1[j] = xr1[64 * j]; }
#pragma unroll
            for (int j = 0; j < 8; ++j) { s0 += (v0[j][0] * v0[j][0] + v0[j][1] * v0[j][1]) + (v0[j][2] * v0[j][2] + v0[j][3] * v0[j][3]);
                s1 += (v1[j][0] * v1[j][0] + v1[j][1] * v1[j][1]) + (v1[j][2] * v1[j][2] + v1[j][3] * v1[j][3]); }
            const float r0 = __builtin_amdgcn_rsqf(wave_sum(s0) * (1.0f / DM) + EPS), r1 = __builtin_amdgcn_rsqf(wave_sum(s1) * (1.0f / DM) + EPS);
            u32x2* o0 = (u32x2*)(hbuf + (size_t)m * DM) + lane; u32x2* o1 = (u32x2*)(hbuf + (size_t)m2 * DM) + lane;
#pragma unroll
            for (int j = 0; j < 8; ++j) { const int c = 4 * lane + 256 * j; const f32x4 gmv = *(const LAS f32x4*)(gm1 + c), shv = *(const LAS f32x4*)(sh1 + c);
                const f32x4 h0 = v0[j] * r0 * gmv + shv, h1 = v1[j] * r1 * gmv + shv;
                u32x2 w0, w1; w0.x = pk2(h0[0], h0[1]); w0.y = pk2(h0[2], h0[3]); w1.x = pk2(h1[0], h1[1]); w1.y = pk2(h1[2], h1[3]); o0[64 * j] = w0; o1[64 * j] = w1; }
        }
    }
    xcd_barrier(xbar);
    RELOAD_IDS();

#endif
#if PHMASK & 4
    {
        pg8::Gemm g{hbuf, W1t, 2048, 2048, 2048}; pg8::Sched<0> Sc; Sc.init(S, N1, G, bx);
        if (tid < 128) { ((LAS float*)(lds + 133120))[tid] = qng[tid]; ((LAS float*)(lds + 133120))[128 + tid] = kng[tid]; }
        if (tid < 64) ((LAS double*)(lds + 134144))[tid] = ROPE_C[tid];
        __syncthreads();
        Epi1 E{qb, kb, vb, ub, gates, kmean, qng, kng, b_gate};
        pg8::gemm_phase_drain<Epi1>(lds, g, Sc, E);
    }
    xcd_barrier(xbar);
    RELOAD_IDS();

#endif
#if PHMASK & 8
    {
        LAS unsigned char* kmb = lds;
        LAS unsigned* hist = (LAS unsigned*)(lds + 32768); LAS unsigned* basep = hist + 64;
        for (int base = bx * 8; base < 2048; base += G * 8) {
            const int h = base >> 8;
            __syncthreads();
            { const int jr = tid >> 3, c0 = (tid & 7) * 16; const f32x4* src = (const f32x4*)(kmean + (size_t)h * 8192 + jr * 128 + c0);
              const f32x4 k0 = src[0], k1 = src[1], k2 = src[2], k3 = src[3];
              *(LAS u32x4*)(kmb + jr * KV_PITCH + c0 * 2) = pack8(k0, k1); *(LAS u32x4*)(kmb + jr * KV_PITCH + c0 * 2 + 16) = pack8(k2, k3); }
            if (tid < 64) hist[tid] = 0u;
            __syncthreads();
            const int item = base + wave, qgi = item & 255, own = qgi >> 2, ns = own < 3 ? own : 3;
            const int r32 = lane & 31, hh = lane >> 5;
            int selj[2][3]; unsigned selp[2][3];
#pragma unroll
            for (int sub = 0; sub < 2; ++sub) {
                const int qi = qgi * 64 + sub * 32 + r32;
                const bf16_t* qp = qb + (size_t)qi * 1024 + h * 128 + 8 * hh;
                f32x16 ac[2];
#pragma unroll
                for (int jt = 0; jt < 2; ++jt)
#pragma unroll
                    for (int i = 0; i < 16; ++i) ac[jt][i] = 0.f;
#pragma unroll
                for (int ks = 0; ks < 8; ++ks) { const bf16x8 qf = *(const bf16x8*)(qp + 16 * ks);
#pragma unroll
                    for (int jt = 0; jt < 2; ++jt) { const bf16x8 kf = *(const LAS bf16x8*)(kmb + (32 * jt + r32) * KV_PITCH + 32 * ks + 16 * hh);
                        ac[jt] = __builtin_amdgcn_mfma_f32_32x32x16_bf16(kf, qf, ac[jt], 0, 0, 0); } }
                float b0 = -3.0e38f, b1 = -3.0e38f, b2 = -3.0e38f; int i0 = 255, i1 = 255, i2 = 255;
#pragma unroll
                for (int jt = 0; jt < 2; ++jt)
#pragma unroll
                    for (int i = 0; i < 16; ++i) { const int j = 32 * jt + (i & 3) + 8 * (i >> 2) + 4 * hh; const float vj = (j < own) ? ac[jt][i] : -3.0e38f;
                        if (vj > b0) { b2 = b1; i2 = i1; b1 = b0; i1 = i0; b0 = vj; i0 = j; }
                        else if (vj > b1) { b2 = b1; i2 = i1; b1 = vj; i1 = j; }
                        else if (vj > b2) { b2 = vj; i2 = j; } }
                const float p0 = __shfl_xor(b0, 32), p1 = __shfl_xor(b1, 32), p2 = __shfl_xor(b2, 32);
                const int q0 = __shfl_xor(i0, 32), q1 = __shfl_xor(i1, 32), q2 = __shfl_xor(i2, 32);
#pragma unroll
                for (int t = 0; t < 3; ++t) { const float vj = t == 0 ? p0 : (t == 1 ? p1 : p2); const int j = t == 0 ? q0 : (t == 1 ? q1 : q2);
                    if (vj > b0 || (vj == b0 && j < i0)) { b2 = b1; i2 = i1; b1 = b0; i1 = i0; b0 = vj; i0 = j; }
                    else if (vj > b1 || (vj == b1 && j < i1)) { b2 = b1; i2 = i1; b1 = vj; i1 = j; }
                    else if (vj > b2 || (vj == b2 && j < i2)) { b2 = vj; i2 = j; } }
                selj[sub][0] = i0; selj[sub][1] = i1; selj[sub][2] = i2;
#pragma unroll
                for (int t = 0; t < 3; ++t) selp[sub][t] = (hh == 0 && t < ns) ? __hip_atomic_fetch_add((unsigned*)(hist + selj[sub][t]), 1u, __ATOMIC_RELAXED, __HIP_MEMORY_SCOPE_WORKGROUP) : 0u;
            }
            __syncthreads();
            if (tid < 64) { const unsigned c = hist[tid]; basep[tid] = c ? atomicAdd(cnt + h * 64 + tid, c) : 0u; }
            __syncthreads();
            if (hh == 0) {
#pragma unroll
                for (int sub = 0; sub < 2; ++sub)
#pragma unroll
                    for (int t = 0; t < 3; ++t) if (t < ns) { const int j = selj[sub][t]; const unsigned qi = (unsigned)(qgi * 64 + sub * 32 + r32);
                        qlist[(size_t)(h * 64 + j) * 16384 + basep[j] + selp[sub][t]] = qi * 4u + (unsigned)t; }
            }
        }
        for (int idx = vcu * NTHR + tid; idx < 2048 * 128; idx += G * NTHR) {
            const int cgi = idx & 127, rc = idx >> 7, w = 2 << (cgi >> 5), t0 = rc * 8;
            const bf16_t* __restrict__ up = ub + cgi * 8; bf16_t* __restrict__ dp = dbuf + cgi * 8;
            float sum[8];
#pragma unroll
            for (int i = 0; i < 8; ++i) sum[i] = 0.f;
            for (int i = 1; i <= w; ++i) { const int t = t0 - i; if (t >= 0) { float f[8]; unpack8(*(const u32x4*)(up + (size_t)t * 1024), f);
#pragma unroll
                for (int e = 0; e < 8; ++e) sum[e] += f[e]; } }
#pragma unroll
            for (int t = t0; t < t0 + 8; ++t) {
                float f[8]; unpack8(*(const u32x4*)(up + (size_t)t * 1024), f);
#pragma unroll
                for (int e = 0; e < 8; ++e) sum[e] += f[e];
                if (t - w >= 0) { float o[8]; unpack8(*(const u32x4*)(up + (size_t)(t - w) * 1024), o);
#pragma unroll
                    for (int e = 0; e < 8; ++e) sum[e] -= o[e]; }
                const float inv = 1.0f / (float)((t + 1) < w ? (t + 1) : w);
                u32x4 o4; o4.x = pk2(sum[0] * inv - f[0], sum[1] * inv - f[1]); o4.y = pk2(sum[2] * inv - f[2], sum[3] * inv - f[3]);
                o4.z = pk2(sum[4] * inv - f[4], sum[5] * inv - f[5]); o4.w = pk2(sum[6] * inv - f[6], sum[7] * inv - f[7]);
                *(u32x4*)(dp + (size_t)t * 1024) = o4;
            }
        }
        for (int rho = gw; rho < NUP; rho += NGW) {
            float s = 0.f;
#pragma unroll
            for (int j = 0; j < 4; ++j) { const int k0 = j * 512 + lane * 8; float f[8]; unpack8(*(const u32x4*)(Wut + (size_t)rho * 2048 + k0), f);
                const f32x4 s0 = *(const f32x4*)(modf + 3 * 2048 + k0), s1 = *(const f32x4*)(modf + 3 * 2048 + k0 + 4);
                s += (f[0] * s0[0] + f[1] * s0[1]) + (f[2] * s0[2] + f[3] * s0[3]) + (f[4] * s1[0] + f[5] * s1[1]) + (f[6] * s1[2] + f[7] * s1[3]); }
            s = wave_sum(s);
            if (lane == 0) biasup[rho] = s;
        }
    }
    xcd_barrier(xbar);
    RELOAD_IDS();

#endif
#if PHMASK & 16
    {
        RELOAD_IDS();
        __syncthreads();
        LAS int* pre = (LAS int*)(lds + LDS_TAB); LAS int* tmp = pre + 520;
        { const int n = 1 + (int)((cnt[tid] + 255u) >> 8); tmp[tid] = n; __syncthreads();
          for (int o = 1; o < 512; o <<= 1) { const int v = tmp[tid] + (tid >= o ? tmp[tid - o] : 0); __syncthreads(); tmp[tid] = v; __syncthreads(); }
          pre[tid + 1] = tmp[tid]; if (tid == 0) pre[0] = 0; __syncthreads(); }
        const int total = pre[512];
        int lane_ = lane; asm volatile("" : "+v"(lane_));
        const int r32 = lane_ & 31, hh = lane_ >> 5, i16 = lane_ & 15, qq = i16 >> 2, pp = i16 & 3, blk = (lane_ >> 4) & 1;
#define ATT_DECODE(UN, HJ, LI) do { int lo_ = 0, hi_ = 511; while (lo_ < hi_) { const int mid_ = (lo_ + hi_ + 1) >> 1; if (pre[mid_] <= (UN)) lo_ = mid_; else hi_ = mid_ - 1; } HJ = lo_; LI = (UN) - pre[lo_]; } while (0)
#define ATT_KVLOAD(HJ) do { const int h_ = (HJ) >> 6, j_ = (HJ) & 63; const bf16_t* kg = kb + (size_t)(j_ * 256) * 1024 + h_ * 128; const bf16_t* vg = vb + (size_t)(j_ * 256) * 1024 + h_ * 128; \
        _Pragma("unroll") for (int i = 0; i < 8; ++i) { const int idx = tid + NTHR * i, row = idx >> 4, c16 = idx & 15; \
            kreg[i] = *(const u32x4*)(kg + (size_t)row * 1024 + c16 * 8); vreg[i] = *(const u32x4*)(vg + (size_t)row * 1024 + c16 * 8); } } while (0)
#define ATT_ENT(HJ, LI, ENT, NL) do { NL = ((LI) == 0) ? 256 : (int)cnt[HJ] - ((LI) - 1) * 256; const int e_ = wave * 32 + r32; \
        if ((LI) == 0) ENT = (unsigned)(((HJ) & 63) * 256 + e_) * 4u + 3u; else ENT = qlist[(size_t)(HJ) * 16384 + (size_t)((LI) - 1) * 256 + (e_ < NL ? e_ : 0)]; } while (0)
        u32x4 kreg[8], vreg[8];
        int hj = 0, li = 0, nlist = 0; unsigned ent = 0u;
        if (bx < total) { ATT_DECODE(bx, hj, li); ATT_KVLOAD(hj); ATT_ENT(hj, li, ent, nlist); }
        for (int un = bx; un < total; un += G) {
            const int h = hj >> 6, j = hj & 63;
            const bool ownu = (li == 0);
            const int e = wave * 32 + r32;
            const bool valid = e < nlist;
            const int qi = (int)(ent >> 2), slot = (int)(ent & 3u);
            const bf16_t* qp = qb + (size_t)qi * 1024 + h * 128 + 8 * hh;
            bf16x8 qf[8];
#pragma unroll
            for (int ks = 0; ks < 8; ++ks) qf[ks] = *(const bf16x8*)(qp + 16 * ks);
            __syncthreads();
#pragma unroll
            for (int i = 0; i < 8; ++i) { const int idx = tid + NTHR * i, row = idx >> 4, c16 = idx & 15;
                *(LAS u32x4*)(lds + LDS_KS + row * KV_PITCH + c16 * 16) = kreg[i]; *(LAS u32x4*)(lds + LDS_VS + row * KV_PITCH + c16 * 16) = vreg[i]; }
            __syncthreads();
            int hj2, li2, nlist2; unsigned ent2;
            { const int unn = (un + G < total) ? un + G : un; ATT_DECODE(unn, hj2, li2); ATT_KVLOAD(hj2); ATT_ENT(hj2, li2, ent2, nlist2); }
            if (wave * 32 < nlist) {
                const int nq = ownu ? ((wave * 32 + 31) >> 6) + 1 : 4;
                f32x16 o[4];
#pragma unroll
                for (int dt = 0; dt < 4; ++dt)
#pragma unroll
                    for (int i = 0; i < 16; ++i) o[dt][i] = 0.f;
                float lacc = 0.f;
                const int qloc = e;
#pragma unroll 1
                for (int hf = 0; hf < nq; ++hf) {
                    f32x16 sa[2];
#pragma unroll
                    for (int i = 0; i < 16; ++i) { sa[0][i] = 0.f; sa[1][i] = 0.f; }
                    {
                        const LAS unsigned char* kp0 = lds + LDS_KS + (64 * hf + r32) * KV_PITCH + 16 * hh;
                        const LAS unsigned char* kp1 = kp0 + 32 * KV_PITCH;
                        bf16x8 a0 = *(const LAS bf16x8*)kp0, a1 = *(const LAS bf16x8*)kp1;
#pragma unroll
                        for (int ks = 0; ks < 8; ++ks) {
                            bf16x8 n0 = a0, n1 = a1;
                            if (ks < 7) { n0 = *(const LAS bf16x8*)(kp0 + 32 * (ks + 1)); n1 = *(const LAS bf16x8*)(kp1 + 32 * (ks + 1)); }
                            sa[0] = __builtin_amdgcn_mfma_f32_32x32x16_bf16(a0, qf[ks], sa[0], 0, 0, 0);
                            sa[1] = __builtin_amdgcn_mfma_f32_32x32x16_bf16(a1, qf[ks], sa[1], 0, 0, 0);
                            a0 = n0; a1 = n1;
                        }
                    }
                    if (ownu) {
#pragma unroll
                        for (int kt = 0; kt < 2; ++kt)
#pragma unroll
                            for (int i = 0; i < 16; ++i) { const int key = 64 * hf + 32 * kt + (i & 3) + 8 * (i >> 2) + 4 * hh;
                                float pv = __builtin_amdgcn_exp2f(sa[kt][i]); if (key > qloc) pv = 0.f; sa[kt][i] = pv; lacc += pv; }
                    } else {
#pragma unroll
                        for (int kt = 0; kt < 2; ++kt)
#pragma unroll
                            for (int i = 0; i < 16; ++i) { const float pv = __builtin_amdgcn_exp2f(sa[kt][i]); sa[kt][i] = pv; lacc += pv; }
                    }
                    bf16x8 pb[4];
#pragma unroll
                    for (int st = 0; st < 4; ++st) { const int kt = st >> 1, s2 = st & 1;
                        u32x4 pw; pw.x = pk2(sa[kt][8 * s2 + 0], sa[kt][8 * s2 + 1]); pw.y = pk2(sa[kt][8 * s2 + 2], sa[kt][8 * s2 + 3]);
                        pw.z = pk2(sa[kt][8 * s2 + 4], sa[kt][8 * s2 + 5]); pw.w = pk2(sa[kt][8 * s2 + 6], sa[kt][8 * s2 + 7]);
                        pb[st] = __builtin_bit_cast(bf16x8, pw); }
                    const LAS unsigned char* vp = lds + LDS_VS + (64 * hf + 4 * hh + qq) * KV_PITCH + 32 * blk + 8 * pp;
                    s16x4 cl[4], ch[4];
#pragma unroll
                    for (int dt = 0; dt < 4; ++dt) { cl[dt] = vtr(vp + 64 * dt); ch[dt] = vtr(vp + 8 * KV_PITCH + 64 * dt); }
#pragma unroll
                    for (int st = 0; st < 4; ++st) {
                        s16x4 nl[4], nh[4];
#pragma unroll
                        for (int dt = 0; dt < 4; ++dt) { nl[dt] = cl[dt]; nh[dt] = ch[dt]; }
                        if (st < 3) { const LAS unsigned char* vn = vp + 16 * (st + 1) * KV_PITCH;
#pragma unroll
                            for (int dt = 0; dt < 4; ++dt) { nl[dt] = vtr(vn + 64 * dt); nh[dt] = vtr(vn + 8 * KV_PITCH + 64 * dt); } }
#pragma unroll
                        for (int dt = 0; dt < 4; ++dt) { const bf16x8 vf = __builtin_shufflevector(cl[dt], ch[dt], 0, 1, 2, 3, 4, 5, 6, 7);
                            o[dt] = __builtin_amdgcn_mfma_f32_32x32x16_bf16(vf, pb[st], o[dt], 0, 0, 0); }
#pragma unroll
                        for (int dt = 0; dt < 4; ++dt) { cl[dt] = nl[dt]; ch[dt] = nh[dt]; }
                    }
                }
                lacc += __shfl_xor(lacc, 32);
                u32x4 ow[8];
#pragma unroll
                for (int dt = 0; dt < 4; ++dt)
#pragma unroll
                    for (int gp2 = 0; gp2 < 2; ++gp2) { const int g0 = 2 * gp2, g1 = g0 + 1;
                        unsigned ax = pk2(o[dt][4 * g0], o[dt][4 * g0 + 1]), ay = pk2(o[dt][4 * g0 + 2], o[dt][4 * g0 + 3]);
                        unsigned bxw = pk2(o[dt][4 * g1], o[dt][4 * g1 + 1]), by = pk2(o[dt][4 * g1 + 2], o[dt][4 * g1 + 3]);
                        { const auto rsw = __builtin_amdgcn_permlane32_swap(ax, bxw, false, false); ax = rsw[0]; bxw = rsw[1]; }
                        { const auto rsw = __builtin_amdgcn_permlane32_swap(ay, by, false, false); ay = rsw[0]; by = rsw[1]; }
                        ow[dt * 2 + gp2] = (u32x4){ax, ay, bxw, by}; }
                if (valid) {
                    bf16_t* op = slots + ((size_t)qi * 4 + slot) * 1024 + h * 128 + 8 * hh;
#pragma unroll
                    for (int dt = 0; dt < 4; ++dt)
#pragma unroll
                        for (int gp2 = 0; gp2 < 2; ++gp2) *(u32x4*)(op + 32 * dt + 16 * gp2) = ow[dt * 2 + gp2];
                    if (hh == 0) lsum[((size_t)qi * 4 + slot) * 8 + h] = lacc;
                }
            }
            hj = hj2; li = li2; ent = ent2; nlist = nlist2;
        }
        RELOAD_IDS();
        for (int base = vcu * 8; base < 2048; base += G * 8) {
            const int gI = base >> 9;
            __syncthreads();
#pragma unroll
            for (int i = 0; i < 16; ++i) { const int idx = tid + NTHR * i, row = idx >> 5, c16 = idx & 31;
                *(LAS u32x4*)(lds + row * 528 + c16 * 16) = *(const u32x4*)(Wgt + (size_t)(gI * 256 + row) * 1024 + c16 * 8); }
            __syncthreads();
            const int item = base + wave, s0 = (item & 511) * 32, r = lane & 31, hh = lane >> 5;
            bf16x8 af[16];
            const bf16_t* ap = dbuf + (size_t)(s0 + r) * 1024 + gI * 256 + 8 * hh;
#pragma unroll
            for (int ks = 0; ks < 16; ++ks) af[ks] = *(const bf16x8*)(ap + 16 * ks);
#pragma unroll 1
            for (int nt = 0; nt < 8; nt += 2) {
                f32x16 ac[2];
#pragma unroll
                for (int i = 0; i < 16; ++i) { ac[0][i] = 0.f; ac[1][i] = 0.f; }
                const LAS unsigned char* bp = lds + (nt * 32 + r) * 528 + 16 * hh;
#pragma unroll
                for (int ks = 0; ks < 16; ++ks) { const bf16x8 b0 = *(const LAS bf16x8*)(bp + 32 * ks), b1 = *(const LAS bf16x8*)(bp + 32 * 528 + 32 * ks);
                    ac[0] = __builtin_amdgcn_mfma_f32_32x32x16_bf16(b0, af[ks], ac[0], 0, 0, 0); ac[1] = __builtin_amdgcn_mfma_f32_32x32x16_bf16(b1, af[ks], ac[1], 0, 0, 0); }
                f32x4 lsv[2][4];
#pragma unroll
                for (int t2 = 0; t2 < 2; ++t2)
#pragma unroll
                    for (int q4 = 0; q4 < 4; ++q4) lsv[t2][q4] = *(const f32x4*)(pscale + gI * 256 + (nt + t2) * 32 + 8 * q4 + 4 * hh);
#pragma unroll
                for (int t2 = 0; t2 < 2; ++t2) {
                    bf16_t* op = am + (size_t)(s0 + r) * 2048 + 1024 + gI * 256 + (nt + t2) * 32 + 4 * hh;
#pragma unroll
                    for (int q4 = 0; q4 < 4; ++q4) { const f32x4 lv = lsv[t2][q4];
                        u32x2 w; w.x = pk2(ac[t2][4 * q4] * lv[0], ac[t2][4 * q4 + 1] * lv[1]); w.y = pk2(ac[t2][4 * q4 + 2] * lv[2], ac[t2][4 * q4 + 3] * lv[3]); *(u32x2*)(op + 8 * q4) = w; }
                }
            }
        }
    }
    xcd_barrier(xbar);
    RELOAD_IDS();

#endif
#if PHMASK & 32
    {
    }
    RELOAD_IDS();
#pragma unroll 2
    for (int idx = vcu * NTHR + tid; idx < S * 128; idx += G * NTHR) {
        const int qi = idx >> 7, c8 = idx & 127, h = c8 >> 4, own = qi >> 8, ns = own < 3 ? own : 3;
        float a[8]; float l = 0.f;
#pragma unroll
        for (int i = 0; i < 8; ++i) a[i] = 0.f;
#pragma unroll
        for (int s = 0; s < 4; ++s) if (s == 3 || s < ns) { float f[8]; unpack8(*(const u32x4*)(slots + ((size_t)qi * 4 + s) * 1024 + c8 * 8), f);
#pragma unroll
            for (int i = 0; i < 8; ++i) a[i] += f[i];
            l += lsum[((size_t)qi * 4 + s) * 8 + h]; }
        const float inv = 1.0f / l;
        u32x4 w; w.x = pk2(a[0] * inv, a[1] * inv); w.y = pk2(a[2] * inv, a[3] * inv); w.z = pk2(a[4] * inv, a[5] * inv); w.w = pk2(a[6] * inv, a[7] * inv);
        *(u32x4*)(am + (size_t)qi * 2048 + c8 * 8) = w;
    }
    xcd_barrier(xbar);
    RELOAD_IDS();

#endif
#if PHMASK & 64
    { pg8::Gemm g{am, Wyt, 2048, 2048, 1024}; pg8::Sched<1> Sc; Sc.init(S, 2048, G, bx); Epi5 E{gates, merged}; pg8::gemm_phase<Epi5>(lds, g, Sc, E); }
    xcd_barrier(xbar);
    RELOAD_IDS();

#endif
#if PHMASK & 128
    { pg8::Gemm g{merged, Wot, 2048, 2048, 2048}; pg8::Sched<0> Sc; Sc.init(S, 2048, G, bx); Epi6 E{xin, outp, xg, modf, nfg, rowss}; pg8::gemm_phase<Epi6>(lds, g, Sc, E); }
    xcd_barrier(xbar);
    RELOAD_IDS();

#endif
#if PHMASK & 256
    for (int row = vcu * NTHR + tid; row < S; row += G * NTHR) { const f32x4* pr = (const f32x4*)(rowss + (size_t)row * 32); f32x4 sm = pr[0];
#pragma unroll
        for (int j = 1; j < 8; ++j) sm += pr[j];
        rsb[row] = __builtin_amdgcn_rsqf(((sm[0] + sm[1]) + (sm[2] + sm[3])) * (1.0f / 2048.0f) + EPS); }
    xcd_barrier(xbar);
    RELOAD_IDS();
    { pg8::Gemm g{xg, Wut, 2048, 2048, 2048}; pg8::Sched<0> Sc; Sc.init(S, NUP, G, bx); Epi7 E{rsb, biasup, conv_w, conv_b, act, edge}; pg8::gemm_phase_drain<Epi7>(lds, g, Sc, E); }
    xcd_barrier(xbar);
    RELOAD_IDS();

#endif
#if PHMASK & 512
    {
        pg8::Sched<0> Sf; Sf.init(S, 2048, G, bx);
        int lastpm = -1;
        for (int ui = 0;; ++ui) {
            Unit uf; if (!Sf.next(ui, uf)) break;
            const int tl = uf.pm; if (tl == lastpm) continue; lastpm = tl;
            for (int idx = tid; idx < DFF / 4; idx += NTHR) {
                const int c = idx * 4;
                f32x4 r0[2], r1[2];
#pragma unroll
                for (int bj = 0; bj < 2; ++bj) {
                    const int lc = bj * DFF + c;
                    const f32x4 z = (f32x4){0.f, 0.f, 0.f, 0.f};
                    const f32x4 pm2 = tl > 0 ? *(const f32x4*)(edge + ((size_t)((tl - 1) * 4 + 2)) * NUP + lc) : z;
                    const f32x4 pm1 = tl > 0 ? *(const f32x4*)(edge + ((size_t)((tl - 1) * 4 + 3)) * NUP + lc) : z;
                    const f32x4 e0 = *(const f32x4*)(edge + ((size_t)(tl * 4 + 0)) * NUP + lc), e1 = *(const f32x4*)(edge + ((size_t)(tl * 4 + 1)) * NUP + lc);
                    const f32x4 w0 = *(const f32x4*)(conv_w + lc), w1 = *(const f32x4*)(conv_w + NUP + lc), w2 = *(const f32x4*)(conv_w + 2 * NUP + lc), cbv = *(const f32x4*)(conv_b + lc);
                    r0[bj] = cbv + w0 * pm2 + w1 * pm1 + w2 * e0;
                    r1[bj] = cbv + w0 * pm1 + w1 * e0 + w2 * e1;
                }
                u32x2 o0, o1; float t0[4], t1[4];
#pragma unroll
                for (int i = 0; i < 4; ++i) { t0[i] = r0[0][i] * sigmoidf_(r0[0][i]) * r0[1][i]; t1[i] = r1[0][i] * sigmoidf_(r1[0][i]) * r1[1][i]; }
                o0.x = pk2(t0[0], t0[1]); o0.y = pk2(t0[2], t0[3]); o1.x = pk2(t1[0], t1[1]); o1.y = pk2(t1[2], t1[3]);
                *(u32x2*)(act + (size_t)(tl * 256) * DFF + c) = o0; *(u32x2*)(act + (size_t)(tl * 256 + 1) * DFF + c) = o1;
            }
        }
        asm volatile("s_waitcnt vmcnt(0)" ::: "memory");
        __syncthreads();
        RELOAD_IDS();
    }
    { pg8::Gemm g{act, Wdt, DFF, DFF, DFF}; pg8::Sched<0> Sc; Sc.init(S, 2048, G, bx); Epi9 E{outp, modf}; pg8::gemm_phase<Epi9>(lds, g, Sc, E); }
#endif
}

extern "C" void kernel_launch(void* const* d_in, const int* in_sizes, int n_in, void* d_out, int out_size, void* d_ws, size_t ws_size, hipStream_t stream) {
    static int grid_blocks = 0;
    if (grid_blocks == 0) {
        if (n_in != 20 || out_size != S * DM || ws_size < WS_END) { fprintf(stderr, "kernel_launch: unexpected shapes (n_in %d out %d ws %zu)\n", n_in, out_size, ws_size); grid_blocks = -1; return; }
        int dev = 0, cus = 0, per_cu = 0;
        hipGetDevice(&dev);
        hipDeviceGetAttribute(&cus, hipDeviceAttributeMultiprocessorCount, dev);
        hipFuncSetAttribute((const void*)fwd_megakernel, hipFuncAttributeMaxDynamicSharedMemorySize, LDS_BYTES);
        hipOccupancyMaxActiveBlocksPerMultiprocessor(&per_cu, (const void*)fwd_megakernel, NTHR, LDS_BYTES);
        if (per_cu < 1) { fprintf(stderr, "kernel_launch: occupancy query reports %d blocks per CU\n", per_cu); grid_blocks = -1; return; }
        if (per_cu > 1) per_cu = 1;
        grid_blocks = cus * per_cu;
        if (grid_blocks > 256) grid_blocks = 256;
    }
    if (grid_blocks < 0) return;
    Params p{};
    for (int i = 0; i < 20; ++i) p.in[i] = (const float*)d_in[i];
    p.out = (float*)d_out; p.ws = (unsigned char*)d_ws;
    void* args[] = {&p};
    hipError_t e = hipLaunchCooperativeKernel((const void*)fwd_megakernel, dim3(grid_blocks), dim3(NTHR), args, LDS_BYTES, stream);
    if (e != hipSuccess) fprintf(stderr, "cooperative launch failed: %s (grid %d)\n", hipGetErrorString(e), grid_blocks);
}
```
